# Optimizing an MI355X kernel written in HIP

```python
import math
import jax, jax.numpy as jnp
from jax import lax
import numpy as np

D_MODEL = 2048
BATCH = 2
SEQ = 4096
DEPTH = 4

GRID_W = 64
CTX_LEN = 256
HEAD_DIM = 128
A_HEADS = 6
A_KV = 2
WINDOW = 128
WB = 128
B_HEADS = 6
B_KV = 2
QB = 128
C_HEADS = 4
C_Q_LORA = 512
C_KV_LORA = 256
C_NOPE = 128
C_ROPE = 64
C_V = 128
D_MIX = A_HEADS * HEAD_DIM + B_HEADS * HEAD_DIM + C_HEADS * C_V
IN_WIDTHS = (A_HEADS * HEAD_DIM, A_KV * HEAD_DIM, A_KV * HEAD_DIM,
             B_HEADS * HEAD_DIM, B_KV * HEAD_DIM, B_KV * HEAD_DIM,
             C_Q_LORA, C_KV_LORA, C_ROPE)
D_IN = sum(IN_WIDTHS)
D_FF = ((8 * D_MODEL // 3 + 255) // 256) * 256
ROPE_THETA = 10000.0
EPS = 1e-6
NEG = -1e30

kernel_name = "hybrid_parallel_heads_dit_trunk"


def rmsnorm(x, g):
    xf = x.astype(jnp.float32)
    y = xf * lax.rsqrt(jnp.mean(xf * xf, axis=-1, keepdims=True) + EPS)
    return (y * g.astype(jnp.float32)).astype(x.dtype)


def modulate(h, shift, scale):
    return h * (1 + scale) + shift


def heads(t, n):
    return t.reshape(*t.shape[:-1], n, t.shape[-1] // n)


def _rot_half(x, pos):
    n = x.shape[-1] // 2
    freqs = jnp.power(jnp.float32(ROPE_THETA), -jnp.arange(n, dtype=jnp.float32) / n)
    ang = pos.astype(jnp.float32)[:, None] * freqs[None, :]
    cos = jnp.cos(ang)[:, None, :]
    sin = jnp.sin(ang)[:, None, :]
    x1, x2 = x[..., :n], x[..., n:]
    return jnp.concatenate([x1 * cos - x2 * sin, x2 * cos + x1 * sin], axis=-1).astype(x.dtype)


def axial_rope(x, row, col):
    half = x.shape[-1] // 2
    return jnp.concatenate([_rot_half(x[..., :half], row), _rot_half(x[..., half:], col)], axis=-1)


def ctx_attn(q, k, v, scale, sink=None):
    B, L, H, dk = q.shape
    G = k.shape[2]
    R = H // G
    qg = q.reshape(B, L, G, R, dk)
    s = jnp.einsum('bqgrd,bkgd->bgrqk', qg, k).astype(jnp.float32) * scale
    if sink is not None:
        sk = jnp.broadcast_to(sink.astype(jnp.float32).reshape(G, R)[None, :, :, None, None], (B, G, R, L, 1))
        s = jnp.concatenate([s, sk], axis=-1)
    p = jax.nn.softmax(s, axis=-1)[..., :L]
    o = jnp.einsum('bgrqk,bkgd->bqgrd', p.astype(v.dtype), v)
    return o.reshape(B, L, H, v.shape[-1])


def window_attn(q, k, v, kc, vc, sink, scale):
    B, S, H, d = q.shape
    G = k.shape[2]
    R = H // G
    nb = S // WB
    pad = ((0, 0), (WB, WB), (0, 0), (0, 0))
    kp = jnp.pad(k, pad).reshape(B, nb + 2, WB, G, d)
    vp = jnp.pad(v, pad).reshape(B, nb + 2, WB, G, v.shape[-1])
    kband = jnp.concatenate([kp[:, :-2], kp[:, 1:-1], kp[:, 2:]], axis=2)
    vband = jnp.concatenate([vp[:, :-2], vp[:, 1:-1], vp[:, 2:]], axis=2)
    qb = q.reshape(B, nb, WB, G, R, d)
    s_band = jnp.einsum('bnqgrd,bnkgd->bngrqk', qb, kband).astype(jnp.float32) * scale
    qpos = jnp.arange(S).reshape(nb, WB)
    kpos = (jnp.arange(nb) * WB - WB)[:, None] + jnp.arange(3 * WB)[None, :]
    diff = kpos[:, None, :] - qpos[:, :, None]
    valid = (jnp.abs(diff) <= WINDOW) & (kpos >= 0)[:, None, :] & (kpos < S)[:, None, :]
    s_band = jnp.where(valid[None, :, None, None], s_band, NEG)
    s_ctx = jnp.einsum('bnqgrd,bkgd->bngrqk', qb, kc).astype(jnp.float32) * scale
    L = kc.shape[1]
    s_sink = jnp.broadcast_to(sink.astype(jnp.float32).reshape(G, R)[None, None, :, :, None, None],
                              (B, nb, G, R, WB, 1))
    p = jax.nn.softmax(jnp.concatenate([s_band, s_ctx, s_sink], axis=-1), axis=-1)
    p_band = p[..., :3 * WB].astype(v.dtype)
    p_ctx = p[..., 3 * WB:3 * WB + L].astype(v.dtype)
    o = (jnp.einsum('bngrqk,bnkgd->bnqgrd', p_band, vband)
         + jnp.einsum('bngrqk,bkgd->bnqgrd', p_ctx, vc))
    return o.reshape(B, S, H, v.shape[-1])


def dense_attn_blocks(q, k, v, kc, vc, scale):
    B, S, H, dk = q.shape
    G = k.shape[2]
    R = H // G
    dv = v.shape[-1]
    kk = jnp.concatenate([kc, k], axis=1)
    vv = jnp.concatenate([vc, v], axis=1)
    qb = q.reshape(B, S // QB, QB, G, R, dk).transpose(1, 0, 2, 3, 4, 5)

    def one_block(qblk):
        s = jnp.einsum('bqgrd,bkgd->bgrqk', qblk, kk).astype(jnp.float32) * scale
        p = jax.nn.softmax(s, axis=-1)
        return jnp.einsum('bgrqk,bkgd->bqgrd', p.astype(vv.dtype), vv)

    o = lax.map(one_block, qb)
    return o.transpose(1, 0, 2, 3, 4, 5).reshape(B, S, H, dv)


def split_cols(p):
    offs = []
    acc = 0
    for w in IN_WIDTHS[:-1]:
        acc += w
        offs.append(acc)
    return jnp.split(p, offs, axis=-1)


def mla_qkv(cq, ckv, ckr, g_cq, w_uq, g_ckv, w_ukv, row, col, rotate):
    q = heads(rmsnorm(cq, g_cq) @ w_uq, C_HEADS)
    q_nope, q_rope = q[..., :C_NOPE], q[..., C_NOPE:]
    kv = heads(rmsnorm(ckv, g_ckv) @ w_ukv, C_HEADS)
    k_nope, v = kv[..., :C_NOPE], kv[..., C_NOPE:]
    k_rope = ckr[..., None, :]
    if rotate:
        q_rope = axial_rope(q_rope, row, col)
        k_rope = axial_rope(k_rope, row, col)
    k_rope = jnp.broadcast_to(k_rope, (*k_nope.shape[:-1], C_ROPE))
    return (jnp.concatenate([q_nope, q_rope], axis=-1),
            jnp.concatenate([k_nope, k_rope], axis=-1), v)


def token_mixers(h, hc, row, col, w_in, sink_a, g_qn_b, g_kn_b, g_cq, w_uq, g_ckv, w_ukv, w_out, with_ctx):
    B, S, _ = h.shape
    L = hc.shape[1]
    aq, ak, av, bq, bk, bv, cq, ckv, ckr = split_cols(h @ w_in)
    aqc, akc, avc, bqc, bkc, bvc, cqc, ckvc, ckrc = split_cols(hc @ w_in)
    sc_ab = 1.0 / math.sqrt(HEAD_DIM)
    sc_c = 1.0 / math.sqrt(C_NOPE + C_ROPE)

    qa = axial_rope(heads(aq, A_HEADS), row, col)
    ka = axial_rope(heads(ak, A_KV), row, col)
    va = heads(av, A_KV)
    kac, vac = heads(akc, A_KV), heads(avc, A_KV)
    oa = window_attn(qa, ka, va, kac, vac, sink_a, sc_ab)

    qb = axial_rope(rmsnorm(heads(bq, B_HEADS), g_qn_b), row, col)
    kb = axial_rope(rmsnorm(heads(bk, B_KV), g_kn_b), row, col)
    vb = heads(bv, B_KV)
    kbc, vbc = rmsnorm(heads(bkc, B_KV), g_kn_b), heads(bvc, B_KV)
    ob = dense_attn_blocks(qb, kb, vb, kbc, vbc, sc_ab)

    qc, kc_, vc_ = mla_qkv(cq, ckv, ckr, g_cq, w_uq, g_ckv, w_ukv, row, col, True)
    qcc, kcc, vcc = mla_qkv(cqc, ckvc, ckrc, g_cq, w_uq, g_ckv, w_ukv, row, col, False)
    oc = dense_attn_blocks(qc, kc_, vc_, kcc, vcc, sc_c)

    out = jnp.concatenate([oa.reshape(B, S, -1), ob.reshape(B, S, -1), oc.reshape(B, S, -1)], axis=-1) @ w_out
    if not with_ctx:
        return out, None
    oac = ctx_attn(heads(aqc, A_HEADS), kac, vac, sc_ab, sink_a)
    obc = ctx_attn(rmsnorm(heads(bqc, B_HEADS), g_qn_b), kbc, vbc, sc_ab)
    occ = ctx_attn(qcc, kcc, vcc, sc_c)
    out_c = jnp.concatenate([oac.reshape(B, L, -1), obc.reshape(B, L, -1), occ.reshape(B, L, -1)], axis=-1) @ w_out
    return out, out_c


def swiglu(h, w1, w3, w2):
    return (jax.nn.silu(h @ w1) * (h @ w3)) @ w2


def setup_inputs(seed: int = 0) -> dict:
    key = jax.random.key(seed)
    ks = jax.random.split(key, 24)
    f32 = jnp.float32

    def nrm(k, shape, scale):
        return jax.random.normal(k, shape, f32) * scale

    def gain(k, shape):
        return 1.0 + 0.05 * jax.random.normal(k, shape, f32)

    D = D_MODEL
    return {
        "x": nrm(ks[0], (BATCH, SEQ, D), 1.0),
        "c": nrm(ks[1], (BATCH, D), 1.0),
        "ctx": nrm(ks[2], (BATCH, CTX_LEN, D), 1.0),
        "c_ctx": nrm(ks[3], (D,), 1.0),
        "w_mod": nrm(ks[4], (DEPTH, D, 6 * D), 0.5 * D ** -0.5),
        "b_mod": nrm(ks[5], (DEPTH, 6 * D), 0.02),
        "g_mix_pre": gain(ks[6], (DEPTH, D)),
        "g_mix_post": gain(ks[7], (DEPTH, D)),
        "g_ffn_pre": gain(ks[8], (DEPTH, D)),
        "g_ffn_post": gain(ks[9], (DEPTH, D)),
        "w_in": nrm(ks[10], (DEPTH, D, D_IN), D ** -0.5),
        "sink_a": nrm(ks[11], (DEPTH, A_HEADS), 0.5),
        "g_qn_b": gain(ks[12], (DEPTH, HEAD_DIM)),
        "g_kn_b": gain(ks[13], (DEPTH, HEAD_DIM)),
        "g_cq": gain(ks[14], (DEPTH, C_Q_LORA)),
        "w_uq": nrm(ks[15], (DEPTH, C_Q_LORA, C_HEADS * (C_NOPE + C_ROPE)), C_Q_LORA ** -0.5),
        "g_ckv": gain(ks[16], (DEPTH, C_KV_LORA)),
        "w_ukv": nrm(ks[17], (DEPTH, C_KV_LORA, C_HEADS * (C_NOPE + C_V)), C_KV_LORA ** -0.5),
        "w_out": nrm(ks[18], (DEPTH, D_MIX, D), D_MIX ** -0.5),
        "w_ffn1": nrm(ks[19], (DEPTH, D, D_FF), D ** -0.5),
        "w_ffn3": nrm(ks[20], (DEPTH, D, D_FF), D ** -0.5),
        "w_ffn2": nrm(ks[21], (DEPTH, D_FF, D), D_FF ** -0.5),
    }


def reference(x, c, ctx, c_ctx, w_mod, b_mod, g_mix_pre, g_mix_post, g_ffn_pre, g_ffn_post,
              w_in, sink_a, g_qn_b, g_kn_b, g_cq, w_uq, g_ckv, w_ukv, w_out, w_ffn1, w_ffn3, w_ffn2):
    B, S, D = x.shape
    rows = S // GRID_W
    row = jnp.repeat(jnp.arange(rows, dtype=jnp.int32), GRID_W)
    col = jnp.tile(jnp.arange(GRID_W, dtype=jnp.int32), rows)
    xc = ctx
    sc_in = jax.nn.silu(c)
    scc_in = jax.nn.silu(c_ctx)
    for l in range(DEPTH):
        last = l == DEPTH - 1
        mod = (sc_in @ w_mod[l] + b_mod[l]).reshape(B, 6, D)[:, :, None, :]
        modc = (scc_in @ w_mod[l] + b_mod[l]).reshape(6, D)
        h = modulate(rmsnorm(x, g_mix_pre[l]), mod[:, 0], mod[:, 1])
        hc = modulate(rmsnorm(xc, g_mix_pre[l]), modc[0], modc[1])
        o, oc = token_mixers(h, hc, row, col, w_in[l], sink_a[l], g_qn_b[l], g_kn_b[l],
                             g_cq[l], w_uq[l], g_ckv[l], w_ukv[l], w_out[l], not last)
        x = x + mod[:, 2] * rmsnorm(o, g_mix_post[l])
        h = modulate(rmsnorm(x, g_ffn_pre[l]), mod[:, 3], mod[:, 4])
        x = x + mod[:, 5] * rmsnorm(swiglu(h, w_ffn1[l], w_ffn3[l], w_ffn2[l]), g_ffn_post[l])
        if not last:
            xc = xc + modc[2] * rmsnorm(oc, g_mix_post[l])
            hc = modulate(rmsnorm(xc, g_ffn_pre[l]), modc[3], modc[4])
            xc = xc + modc[5] * rmsnorm(swiglu(hc, w_ffn1[l], w_ffn3[l], w_ffn2[l]), g_ffn_post[l])
    return x
```

```cpp
#include <hip/hip_runtime.h>
#include <stdint.h>
#include <stdio.h>

namespace nv {
constexpr int D = 2048, NB = 2, S = 4096, L = 256, DEPTH = 4;
constexpr int NL = NB * S, NC = NB * L, NR = NL + NC;
constexpr int DIN = 3392, DFF = 5632;
constexpr int O_AQ = 0, O_AK = 768, O_AV = 1024, O_BQ = 1280, O_BK = 2048, O_BV = 2304, O_CQ = 2560, O_CKV = 3072, O_CKR = 3328;
constexpr float EPS = 1e-6f;

__device__ __forceinline__ float block_sum256(float v, float* red) {
    for (int o = 32; o > 0; o >>= 1) v += __shfl_xor(v, o);
    const int w = threadIdx.x >> 6;
    __syncthreads();
    if ((threadIdx.x & 63) == 0) red[w] = v;
    __syncthreads();
    return red[0] + red[1] + red[2] + red[3];
}
__device__ __forceinline__ int row_s(int r) { return r < NL ? r / S : 2; }

__global__ __launch_bounds__(256) void k_mod(const float* c, const float* cctx, const float* w_mod, const float* b_mod, float* modv) {
    __shared__ float sc[3][D];
    const int l = blockIdx.y, n = blockIdx.x * 256 + threadIdx.x;
    for (int i = threadIdx.x; i < 3 * D; i += 256) { const int s = i / D, k = i % D; const float v = s < 2 ? c[s * D + k] : cctx[k]; sc[s][k] = v / (1.f + expf(-v)); }
    __syncthreads();
    const float* w = w_mod + (size_t)l * D * 6 * D + n;
    float a0 = 0.f, a1 = 0.f, a2 = 0.f;
    for (int k = 0; k < D; ++k) { const float wv = w[(size_t)k * 6 * D]; a0 += sc[0][k] * wv; a1 += sc[1][k] * wv; a2 += sc[2][k] * wv; }
    const float bb = b_mod[l * 6 * D + n];
    float* o = modv + (size_t)l * 3 * 6 * D + n;
    o[0] = a0 + bb; o[6 * D] = a1 + bb; o[2 * 6 * D] = a2 + bb;
}
__global__ __launch_bounds__(256) void k_norm_mod(const float* X, const float* g, const float* modl, int ish, int isc, float* H) {
    __shared__ float red[4];
    const int r = blockIdx.x, s = row_s(r);
    const float* x = X + (size_t)r * D; float v[8]; float ss = 0.f;
    for (int i = 0; i < 8; ++i) { v[i] = x[threadIdx.x + i * 256]; ss += v[i] * v[i]; }
    const float rstd = rsqrtf(block_sum256(ss, red) / D + EPS);
    const float* ms = modl + (size_t)s * 6 * D;
    for (int i = 0; i < 8; ++i) { const int cidx = threadIdx.x + i * 256; H[(size_t)r * D + cidx] = v[i] * rstd * g[cidx] * (1.f + ms[isc * D + cidx]) + ms[ish * D + cidx]; }
}
__global__ __launch_bounds__(256) void k_resid(float* X, const float* O, const float* g, const float* modl, int ig) {
    __shared__ float red[4];
    const int r = blockIdx.x, s = row_s(r);
    const float* o = O + (size_t)r * D; float v[8]; float ss = 0.f;
    for (int i = 0; i < 8; ++i) { v[i] = o[threadIdx.x + i * 256]; ss += v[i] * v[i]; }
    const float rstd = rsqrtf(block_sum256(ss, red) / D + EPS);
    const float* ms = modl + (size_t)s * 6 * D + ig * D;
    for (int i = 0; i < 8; ++i) { const int cidx = threadIdx.x + i * 256; X[(size_t)r * D + cidx] += ms[cidx] * (v[i] * rstd * g[cidx]); }
}
__global__ __launch_bounds__(256) void k_gemm(const float* A, int lda, const float* W, int ldw, float* C, int ldc, int K) {
    __shared__ float As[16][132]; __shared__ float Ws[16][68];
    const int tid = threadIdx.x, tx = tid & 15, ty = tid >> 4, m0 = blockIdx.y * 128, n0 = blockIdx.x * 64;
    float acc[8][4];
    for (int i = 0; i < 8; ++i) for (int j = 0; j < 4; ++j) acc[i][j] = 0.f;
    for (int k0 = 0; k0 < K; k0 += 16) {
        for (int h = 0; h < 2; ++h) { const int r = (tid >> 2) + 64 * h, kk = (tid & 3) * 4; const float4 a = *(const float4*)(A + (size_t)(m0 + r) * lda + k0 + kk);
            As[kk + 0][r] = a.x; As[kk + 1][r] = a.y; As[kk + 2][r] = a.z; As[kk + 3][r] = a.w; }
        { const int kk = tid >> 4, cc = (tid & 15) * 4; *(float4*)&Ws[kk][cc] = *(const float4*)(W + (size_t)(k0 + kk) * ldw + n0 + cc); }
        __syncthreads();
#pragma unroll
        for (int kk = 0; kk < 16; ++kk) {
            const float4 a0 = *(const float4*)&As[kk][ty * 8], a1 = *(const float4*)&As[kk][ty * 8 + 4], b = *(const float4*)&Ws[kk][tx * 4];
            const float av[8] = {a0.x, a0.y, a0.z, a0.w, a1.x, a1.y, a1.z, a1.w}, bv[4] = {b.x, b.y, b.z, b.w};
#pragma unroll
            for (int i = 0; i < 8; ++i)
#pragma unroll
                for (int j = 0; j < 4; ++j) acc[i][j] += av[i] * bv[j];
        }
        __syncthreads();
    }
    for (int i = 0; i < 8; ++i) *(float4*)(C + (size_t)(m0 + ty * 8 + i) * ldc + n0 + tx * 4) = make_float4(acc[i][0], acc[i][1], acc[i][2], acc[i][3]);
}
__device__ __forceinline__ float rope_elem(const float* src, int d, int i, int prow, int pcol) {
    const int half = d / 2, n = d / 4, hh = i / half, j = i % half, jj = j % n; const int pos = hh == 0 ? prow : pcol;
    const float freq = powf(10000.f, -(float)jj / (float)n), ang = (float)pos * freq, cs = cosf(ang), sn = sinf(ang);
    const float x1 = src[hh * half + jj], x2 = src[hh * half + n + jj];
    return j < n ? x1 * cs - x2 * sn : x2 * cs + x1 * sn;
}
__global__ __launch_bounds__(256) void k_post1(const float* P, const float* g_qn, const float* g_kn, const float* g_cq, const float* g_ckv,
                                               float* QA, float* KA, float* VA, float* QB, float* KB, float* VB, float* CQn, float* CKVn) {
    __shared__ float p[DIN]; __shared__ float red[4];
    const int r = blockIdx.x, tid = threadIdx.x; const bool lat = r < NL; const int t = r % S, prow = t / 64, pcol = t % 64;
    for (int i = tid; i < DIN; i += 256) p[i] = P[(size_t)r * DIN + i];
    __syncthreads();
    for (int i = tid; i < 768; i += 256) { const int h = i / 128, d = i % 128; QA[(size_t)r * 768 + i] = lat ? rope_elem(p + O_AQ + h * 128, 128, d, prow, pcol) : p[O_AQ + i]; }
    for (int i = tid; i < 256; i += 256) { const int h = i / 128, d = i % 128; KA[(size_t)r * 256 + i] = lat ? rope_elem(p + O_AK + h * 128, 128, d, prow, pcol) : p[O_AK + i]; VA[(size_t)r * 256 + i] = p[O_AV + i]; }
    __syncthreads();
    for (int h = tid >> 6; h < 8; h += 4) {
        const int off = h < 6 ? O_BQ + h * 128 : O_BK + (h - 6) * 128; const float* g = h < 6 ? g_qn : g_kn; const int ln = tid & 63;
        const float a = p[off + ln], b = p[off + 64 + ln]; float ss = a * a + b * b;
        for (int o = 32; o > 0; o >>= 1) ss += __shfl_xor(ss, o);
        const float rstd = rsqrtf(ss / 128.f + EPS);
        p[off + ln] = a * rstd * g[ln]; p[off + 64 + ln] = b * rstd * g[64 + ln];
    }
    __syncthreads();
    for (int i = tid; i < 768; i += 256) { const int h = i / 128, d = i % 128; QB[(size_t)r * 768 + i] = lat ? rope_elem(p + O_BQ + h * 128, 128, d, prow, pcol) : p[O_BQ + i]; }
    for (int i = tid; i < 256; i += 256) { const int h = i / 128, d = i % 128; KB[(size_t)r * 256 + i] = lat ? rope_elem(p + O_BK + h * 128, 128, d, prow, pcol) : p[O_BK + i]; VB[(size_t)r * 256 + i] = p[O_BV + i]; }
    { float ss = 0.f; for (int i = tid; i < 512; i += 256) ss += p[O_CQ + i] * p[O_CQ + i];
      const float rstd = rsqrtf(block_sum256(ss, red) / 512.f + EPS);
      for (int i = tid; i < 512; i += 256) CQn[(size_t)r * 512 + i] = p[O_CQ + i] * rstd * g_cq[i]; }
    { const float v = p[O_CKV + tid]; const float rstd = rsqrtf(block_sum256(v * v, red) / 256.f + EPS); CKVn[(size_t)r * 256 + tid] = v * rstd * g_ckv[tid]; }
}
__global__ __launch_bounds__(256) void k_post2(const float* P, const float* QCraw, const float* KVraw, float* QC, float* KC, float* VC) {
    __shared__ float q[768]; __shared__ float kr[64];
    const int r = blockIdx.x, tid = threadIdx.x; const bool lat = r < NL; const int t = r % S, prow = t / 64, pcol = t % 64;
    for (int i = tid; i < 768; i += 256) q[i] = QCraw[(size_t)r * 768 + i];
    if (tid < 64) kr[tid] = P[(size_t)r * DIN + O_CKR + tid];
    __syncthreads();
    for (int i = tid; i < 768; i += 256) { const int h = i / 192, d = i % 192;
        QC[(size_t)r * 768 + i] = (d < 128 || !lat) ? q[i] : rope_elem(q + h * 192 + 128, 64, d - 128, prow, pcol);
        KC[(size_t)r * 768 + i] = d < 128 ? KVraw[(size_t)r * 1024 + h * 256 + d] : (lat ? rope_elem(kr, 64, d - 128, prow, pcol) : kr[d - 128]); }
    for (int i = tid; i < 512; i += 256) { const int h = i / 128, d = i % 128; VC[(size_t)r * 512 + i] = KVraw[(size_t)r * 1024 + h * 256 + 128 + d]; }
}
template <int DK, int KT>
__global__ __launch_bounds__(256) void k_attn(const float* Q, int ldq, const float* K, int ldk, const float* V, int ldv, float* O, int ocol0,
                                              int group, const float* sink, float scale, int window, int q_ctx) {
    constexpr int KPT = KT / 8;
    __shared__ float Qs[32][DK + 1]; __shared__ float Ks[KT][DK + 1]; __shared__ float Vs[KT][128]; __shared__ float Ss[32][KT + 1];
    const int tid = threadIdx.x, tq = tid >> 3, tk = tid & 7, h = blockIdx.y, kvh = h / group;
    const int q0 = blockIdx.x * 32;
    const int b = q_ctx ? q0 / L : q0 / S, t0 = q_ctx ? 0 : q0 % S;
    const int qrow0 = q_ctx ? NL + q0 : q0;
    for (int i = tid; i < 32 * DK; i += 256) { const int rr = i / DK, cc = i % DK; Qs[rr][cc] = Q[(size_t)(qrow0 + rr) * ldq + h * DK + cc]; }
    int lo = 0, hi = 0;
    if (!q_ctx) { if (window) { lo = t0 - 128 < 0 ? 0 : t0 - 128; hi = t0 + 160 > S ? S : t0 + 160; } else { lo = 0; hi = S; } }
    const int ntile = L / KT + (hi - lo) / KT;
    float m = -1e30f, l = 0.f, o[16];
    for (int i = 0; i < 16; ++i) o[i] = 0.f;
    for (int it = 0; it < ntile; ++it) {
        const bool isctx = it < L / KT; const int kpos0 = isctx ? it * KT : lo + (it - L / KT) * KT;
        const int krow0 = isctx ? NL + b * L + kpos0 : b * S + kpos0;
        __syncthreads();
        for (int i = tid; i < KT * DK; i += 256) { const int rr = i / DK, cc = i % DK; Ks[rr][cc] = K[(size_t)(krow0 + rr) * ldk + kvh * DK + cc]; }
        for (int i = tid; i < KT * 128; i += 256) { const int rr = i / 128, cc = i % 128; Vs[rr][cc] = V[(size_t)(krow0 + rr) * ldv + kvh * 128 + cc]; }
        __syncthreads();
        float s4[KPT];
        for (int i = 0; i < KPT; ++i) s4[i] = 0.f;
        for (int d = 0; d < DK; ++d) { const float qv = Qs[tq][d];
#pragma unroll
            for (int i = 0; i < KPT; ++i) s4[i] += qv * Ks[tk * KPT + i][d]; }
        for (int i = 0; i < KPT; ++i) { float sv = s4[i] * scale;
            if (window && !isctx) { const int df = (kpos0 + tk * KPT + i) - (t0 + tq); if (df > 128 || df < -128) sv = -1e30f; }
            Ss[tq][tk * KPT + i] = sv; }
        __syncthreads();
        float mx = m;
        for (int k = 0; k < KT; ++k) mx = fmaxf(mx, Ss[tq][k]);
        const float alpha = expf(m - mx); m = mx; l *= alpha;
        for (int i = 0; i < 16; ++i) o[i] *= alpha;
        for (int k = 0; k < KT; ++k) { const float pk = expf(Ss[tq][k] - m); l += pk;
#pragma unroll
            for (int i = 0; i < 16; ++i) o[i] += pk * Vs[k][tk * 16 + i]; }
    }
    if (sink) l += expf(sink[h] - m);
    const float rl = 1.f / l;
    for (int i = 0; i < 16; ++i) O[(size_t)(qrow0 + tq) * D + ocol0 + h * 128 + tk * 16 + i] = o[i] * rl;
}
__global__ __launch_bounds__(256) void k_swiglu(float* G1, const float* G3, size_t n) {
    for (size_t i = (size_t)blockIdx.x * 256 + threadIdx.x; i < n; i += (size_t)gridDim.x * 256) { const float a = G1[i]; G1[i] = a / (1.f + expf(-a)) * G3[i]; }
}
__global__ __launch_bounds__(256) void k_initx(const float* x, const float* ctx, float* X) {
    const size_t n = (size_t)NR * D;
    for (size_t i = (size_t)blockIdx.x * 256 + threadIdx.x; i < n; i += (size_t)gridDim.x * 256) X[i] = i < (size_t)NL * D ? x[i] : ctx[i - (size_t)NL * D];
}

struct Bufs { float *modv, *X, *H, *P, *QA, *KA, *VA, *QB, *KB, *VB, *CQn, *CKVn, *QCraw, *KVraw, *QC, *KC, *VC, *CAT, *O, *G1, *G3; };
inline size_t carve(Bufs& b, char* base) {
    size_t off = 0; auto take = [&](size_t nfl) { float* p = (float*)(base + off); off += (nfl * 4 + 255) / 256 * 256; return p; };
    b.modv = take((size_t)DEPTH * 3 * 6 * D); b.X = take((size_t)NR * D); b.H = take((size_t)NR * D);
    const size_t r0 = off;
    b.P = take((size_t)NR * DIN); b.QA = take((size_t)NR * 768); b.KA = take((size_t)NR * 256); b.VA = take((size_t)NR * 256);
    b.QB = take((size_t)NR * 768); b.KB = take((size_t)NR * 256); b.VB = take((size_t)NR * 256);
    b.CQn = take((size_t)NR * 512); b.CKVn = take((size_t)NR * 256); b.QCraw = take((size_t)NR * 768); b.KVraw = take((size_t)NR * 1024);
    b.QC = take((size_t)NR * 768); b.KC = take((size_t)NR * 768); b.VC = take((size_t)NR * 512); b.CAT = take((size_t)NR * D);
    const size_t r1 = off; off = r0;
    b.O = nullptr; b.G1 = take((size_t)NR * DFF); b.G3 = take((size_t)NR * DFF);
    if (off < r1) off = r1;
    b.O = take((size_t)NR * D);
    return off;
}
inline void gemm(hipStream_t st, const float* A, int lda, const float* W, int ldw, float* C, int ldc, int M, int N, int K) {
    hipLaunchKernelGGL(k_gemm, dim3(N / 64, M / 128), dim3(256), 0, st, A, lda, W, ldw, C, ldc, K);
}
inline void forward(void* const* d_in, float* d_out, char* ws, hipStream_t st) {
    Bufs b; carve(b, ws);
    const float *x = (const float*)d_in[0], *c = (const float*)d_in[1], *ctx = (const float*)d_in[2], *cctx = (const float*)d_in[3], *w_mod = (const float*)d_in[4], *b_mod = (const float*)d_in[5];
    const float *g_mix_pre = (const float*)d_in[6], *g_mix_post = (const float*)d_in[7], *g_ffn_pre = (const float*)d_in[8], *g_ffn_post = (const float*)d_in[9];
    const float *w_in = (const float*)d_in[10], *sink_a = (const float*)d_in[11], *g_qn = (const float*)d_in[12], *g_kn = (const float*)d_in[13], *g_cq = (const float*)d_in[14], *w_uq = (const float*)d_in[15];
    const float *g_ckv = (const float*)d_in[16], *w_ukv = (const float*)d_in[17], *w_out = (const float*)d_in[18], *w1 = (const float*)d_in[19], *w3 = (const float*)d_in[20], *w2 = (const float*)d_in[21];
    hipLaunchKernelGGL(k_mod, dim3(6 * D / 256, DEPTH), dim3(256), 0, st, c, cctx, w_mod, b_mod, b.modv);
    hipLaunchKernelGGL(k_initx, dim3(4096), dim3(256), 0, st, x, ctx, b.X);
    const float sc_ab = 0.08838834764831845f, sc_c = 0.07216878364870323f;
    for (int l = 0; l < DEPTH; ++l) {
        const float* modl = b.modv + (size_t)l * 3 * 6 * D;
        hipLaunchKernelGGL(k_norm_mod, dim3(NR), dim3(256), 0, st, b.X, g_mix_pre + l * D, modl, 0, 1, b.H);
        gemm(st, b.H, D, w_in + (size_t)l * D * DIN, DIN, b.P, DIN, NR, DIN, D);
        hipLaunchKernelGGL(k_post1, dim3(NR), dim3(256), 0, st, b.P, g_qn + l * 128, g_kn + l * 128, g_cq + l * 512, g_ckv + l * 256, b.QA, b.KA, b.VA, b.QB, b.KB, b.VB, b.CQn, b.CKVn);
        gemm(st, b.CQn, 512, w_uq + (size_t)l * 512 * 768, 768, b.QCraw, 768, NR, 768, 512);
        gemm(st, b.CKVn, 256, w_ukv + (size_t)l * 256 * 1024, 1024, b.KVraw, 1024, NR, 1024, 256);
        hipLaunchKernelGGL(k_post2, dim3(NR), dim3(256), 0, st, b.P, b.QCraw, b.KVraw, b.QC, b.KC, b.VC);
        hipLaunchKernelGGL((k_attn<128, 32>), dim3(NL / 32, 6), dim3(256), 0, st, b.QA, 768, b.KA, 256, b.VA, 256, b.CAT, 0, 3, sink_a + l * 6, sc_ab, 1, 0);
        hipLaunchKernelGGL((k_attn<128, 32>), dim3(NL / 32, 6), dim3(256), 0, st, b.QB, 768, b.KB, 256, b.VB, 256, b.CAT, 768, 3, (const float*)nullptr, sc_ab, 0, 0);
        hipLaunchKernelGGL((k_attn<192, 16>), dim3(NL / 32, 4), dim3(256), 0, st, b.QC, 768, b.KC, 768, b.VC, 512, b.CAT, 1536, 1, (const float*)nullptr, sc_c, 0, 0);
        hipLaunchKernelGGL((k_attn<128, 32>), dim3(NC / 32, 6), dim3(256), 0, st, b.QA, 768, b.KA, 256, b.VA, 256, b.CAT, 0, 3, sink_a + l * 6, sc_ab, 0, 1);
        hipLaunchKernelGGL((k_attn<128, 32>), dim3(NC / 32, 6), dim3(256), 0, st, b.QB, 768, b.KB, 256, b.VB, 256, b.CAT, 768, 3, (const float*)nullptr, sc_ab, 0, 1);
        hipLaunchKernelGGL((k_attn<192, 16>), dim3(NC / 32, 4), dim3(256), 0, st, b.QC, 768, b.KC, 768, b.VC, 512, b.CAT, 1536, 1, (const float*)nullptr, sc_c, 0, 1);
        gemm(st, b.CAT, D, w_out + (size_t)l * D * D, D, b.O, D, NR, D, D);
        hipLaunchKernelGGL(k_resid, dim3(NR), dim3(256), 0, st, b.X, b.O, g_mix_post + l * D, modl, 2);
        hipLaunchKernelGGL(k_norm_mod, dim3(NR), dim3(256), 0, st, b.X, g_ffn_pre + l * D, modl, 3, 4, b.H);
        gemm(st, b.H, D, w1 + (size_t)l * D * DFF, DFF, b.G1, DFF, NR, DFF, D);
        gemm(st, b.H, D, w3 + (size_t)l * D * DFF, DFF, b.G3, DFF, NR, DFF, D);
        hipLaunchKernelGGL(k_swiglu, dim3(8192), dim3(256), 0, st, b.G1, b.G3, (size_t)NR * DFF);
        gemm(st, b.G1, DFF, w2 + (size_t)l * DFF * D, D, b.O, D, NR, D, DFF);
        hipLaunchKernelGGL(k_resid, dim3(NR), dim3(256), 0, st, b.X, b.O, g_ffn_post + l * D, modl, 5);
    }
    hipMemcpyAsync(d_out, b.X, (size_t)NL * D * 4, hipMemcpyDeviceToDevice, st);
}
}

extern "C" void kernel_launch(void* const* d_in, const int* in_sizes, int n_in, void* d_out, int out_size, void* d_ws, size_t ws_size, hipStream_t stream) {
    nv::Bufs b; const size_t need = nv::carve(b, (char*)d_ws);
    if (n_in != 22 || ws_size < need) { fprintf(stderr, "kernel_launch: n_in %d ws %zu need %zu\n", n_in, ws_size, need); return; }
    nv::forward(d_in, (float*)d_out, (char*)d_ws, stream);
}
```

```cpp
#include <hip/hip_runtime.h>
#include <stdint.h>
#include <stdio.h>
#include <cstdint>
#include <cmath>

namespace nv {
constexpr int D = 2048, NB = 2, S = 4096, L = 256, DEPTH = 4;
constexpr int NL = NB * S, NC = NB * L, NR = NL + NC;
constexpr int DIN = 3392, DFF = 5632;
constexpr int O_AQ = 0, O_AK = 768, O_AV = 1024, O_BQ = 1280, O_BK = 2048, O_BV = 2304, O_CQ = 2560, O_CKV = 3072, O_CKR = 3328;
constexpr float EPS = 1e-6f;

__device__ __forceinline__ float block_sum256(float v, float* red) {
    for (int o = 32; o > 0; o >>= 1) v += __shfl_xor(v, o);
    const int w = threadIdx.x >> 6;
    __syncthreads();
    if ((threadIdx.x & 63) == 0) red[w] = v;
    __syncthreads();
    return red[0] + red[1] + red[2] + red[3];
}
__device__ __forceinline__ int row_s(int r) { return r < NL ? r / S : 2; }

__global__ __launch_bounds__(256) void k_mod(const float* c, const float* cctx, const float* w_mod, const float* b_mod, float* modv) {
    __shared__ float sc[3][D];
    const int l = blockIdx.y, n = blockIdx.x * 256 + threadIdx.x;
    for (int i = threadIdx.x; i < 3 * D; i += 256) { const int s = i / D, k = i % D; const float v = s < 2 ? c[s * D + k] : cctx[k]; sc[s][k] = v / (1.f + expf(-v)); }
    __syncthreads();
    const float* w = w_mod + (size_t)l * D * 6 * D + n;
    float a0 = 0.f, a1 = 0.f, a2 = 0.f;
    for (int k = 0; k < D; ++k) { const float wv = w[(size_t)k * 6 * D]; a0 += sc[0][k] * wv; a1 += sc[1][k] * wv; a2 += sc[2][k] * wv; }
    const float bb = b_mod[l * 6 * D + n];
    float* o = modv + (size_t)l * 3 * 6 * D + n;
    o[0] = a0 + bb; o[6 * D] = a1 + bb; o[2 * 6 * D] = a2 + bb;
}
__global__ __launch_bounds__(256) void k_norm_mod(const float* X, const float* g, const float* modl, int ish, int isc, float* H) {
    __shared__ float red[4];
    const int r = blockIdx.x, s = row_s(r);
    const float* x = X + (size_t)r * D; float v[8]; float ss = 0.f;
    for (int i = 0; i < 8; ++i) { v[i] = x[threadIdx.x + i * 256]; ss += v[i] * v[i]; }
    const float rstd = rsqrtf(block_sum256(ss, red) / D + EPS);
    const float* ms = modl + (size_t)s * 6 * D;
    for (int i = 0; i < 8; ++i) { const int cidx = threadIdx.x + i * 256; H[(size_t)r * D + cidx] = v[i] * rstd * g[cidx] * (1.f + ms[isc * D + cidx]) + ms[ish * D + cidx]; }
}
__global__ __launch_bounds__(256) void k_resid(float* X, const float* O, const float* g, const float* modl, int ig) {
    __shared__ float red[4];
    const int r = blockIdx.x, s = row_s(r);
    const float* o = O + (size_t)r * D; float v[8]; float ss = 0.f;
    for (int i = 0; i < 8; ++i) { v[i] = o[threadIdx.x + i * 256]; ss += v[i] * v[i]; }
    const float rstd = rsqrtf(block_sum256(ss, red) / D + EPS);
    const float* ms = modl + (size_t)s * 6 * D + ig * D;
    for (int i = 0; i < 8; ++i) { const int cidx = threadIdx.x + i * 256; X[(size_t)r * D + cidx] += ms[cidx] * (v[i] * rstd * g[cidx]); }
}
__global__ __launch_bounds__(256) void k_gemm(const float* A, int lda, const float* W, int ldw, float* C, int ldc, int K) {
    __shared__ float As[16][132]; __shared__ float Ws[16][68];
    const int tid = threadIdx.x, tx = tid & 15, ty = tid >> 4, m0 = blockIdx.y * 128, n0 = blockIdx.x * 64;
    float acc[8][4];
    for (int i = 0; i < 8; ++i) for (int j = 0; j < 4; ++j) acc[i][j] = 0.f;
    for (int k0 = 0; k0 < K; k0 += 16) {
        for (int h = 0; h < 2; ++h) { const int r = (tid >> 2) + 64 * h, kk = (tid & 3) * 4; const float4 a = *(const float4*)(A + (size_t)(m0 + r) * lda + k0 + kk);
            As[kk + 0][r] = a.x; As[kk + 1][r] = a.y; As[kk + 2][r] = a.z; As[kk + 3][r] = a.w; }
        { const int kk = tid >> 4, cc = (tid & 15) * 4; *(float4*)&Ws[kk][cc] = *(const float4*)(W + (size_t)(k0 + kk) * ldw + n0 + cc); }
        __syncthreads();
#pragma unroll
        for (int kk = 0; kk < 16; ++kk) {
            const float4 a0 = *(const float4*)&As[kk][ty * 8], a1 = *(const float4*)&As[kk][ty * 8 + 4], b = *(const float4*)&Ws[kk][tx * 4];
            const float av[8] = {a0.x, a0.y, a0.z, a0.w, a1.x, a1.y, a1.z, a1.w}, bv[4] = {b.x, b.y, b.z, b.w};
#pragma unroll
            for (int i = 0; i < 8; ++i)
#pragma unroll
                for (int j = 0; j < 4; ++j) acc[i][j] += av[i] * bv[j];
        }
        __syncthreads();
    }
    for (int i = 0; i < 8; ++i) *(float4*)(C + (size_t)(m0 + ty * 8 + i) * ldc + n0 + tx * 4) = make_float4(acc[i][0], acc[i][1], acc[i][2], acc[i][3]);
}
__device__ __forceinline__ float rope_elem(const float* src, int d, int i, int prow, int pcol) {
    const int half = d / 2, n = d / 4, hh = i / half, j = i % half, jj = j % n; const int pos = hh == 0 ? prow : pcol;
    const float freq = powf(10000.f, -(float)jj / (float)n), ang = (float)pos * freq, cs = cosf(ang), sn = sinf(ang);
    const float x1 = src[hh * half + jj], x2 = src[hh * half + n + jj];
    return j < n ? x1 * cs - x2 * sn : x2 * cs + x1 * sn;
}
__global__ __launch_bounds__(256) void k_post1(const float* P, const float* g_qn, const float* g_kn, const float* g_cq, const float* g_ckv,
                                               float* QA, float* KA, float* VA, float* QB, float* KB, float* VB, float* CQn, float* CKVn) {
    __shared__ float p[DIN]; __shared__ float red[4];
    const int r = blockIdx.x, tid = threadIdx.x; const bool lat = r < NL; const int t = r % S, prow = t / 64, pcol = t % 64;
    for (int i = tid; i < DIN; i += 256) p[i] = P[(size_t)r * DIN + i];
    __syncthreads();
    for (int i = tid; i < 768; i += 256) { const int h = i / 128, d = i % 128; QA[(size_t)r * 768 + i] = lat ? rope_elem(p + O_AQ + h * 128, 128, d, prow, pcol) : p[O_AQ + i]; }
    for (int i = tid; i < 256; i += 256) { const int h = i / 128, d = i % 128; KA[(size_t)r * 256 + i] = lat ? rope_elem(p + O_AK + h * 128, 128, d, prow, pcol) : p[O_AK + i]; VA[(size_t)r * 256 + i] = p[O_AV + i]; }
    __syncthreads();
    for (int h = tid >> 6; h < 8; h += 4) {
        const int off = h < 6 ? O_BQ + h * 128 : O_BK + (h - 6) * 128; const float* g = h < 6 ? g_qn : g_kn; const int ln = tid & 63;
        const float a = p[off + ln], b = p[off + 64 + ln]; float ss = a * a + b * b;
        for (int o = 32; o > 0; o >>= 1) ss += __shfl_xor(ss, o);
        const float rstd = rsqrtf(ss / 128.f + EPS);
        p[off + ln] = a * rstd * g[ln]; p[off + 64 + ln] = b * rstd * g[64 + ln];
    }
    __syncthreads();
    for (int i = tid; i < 768; i += 256) { const int h = i / 128, d = i % 128; QB[(size_t)r * 768 + i] = lat ? rope_elem(p + O_BQ + h * 128, 128, d, prow, pcol) : p[O_BQ + i]; }
    for (int i = tid; i < 256; i += 256) { const int h = i / 128, d = i % 128; KB[(size_t)r * 256 + i] = lat ? rope_elem(p + O_BK + h * 128, 128, d, prow, pcol) : p[O_BK + i]; VB[(size_t)r * 256 + i] = p[O_BV + i]; }
    { float ss = 0.f; for (int i = tid; i < 512; i += 256) ss += p[O_CQ + i] * p[O_CQ + i];
      const float rstd = rsqrtf(block_sum256(ss, red) / 512.f + EPS);
      for (int i = tid; i < 512; i += 256) CQn[(size_t)r * 512 + i] = p[O_CQ + i] * rstd * g_cq[i]; }
    { const float v = p[O_CKV + tid]; const float rstd = rsqrtf(block_sum256(v * v, red) / 256.f + EPS); CKVn[(size_t)r * 256 + tid] = v * rstd * g_ckv[tid]; }
}
__global__ __launch_bounds__(256) void k_post2(const float* P, const float* QCraw, const float* KVraw, float* QC, float* KC, float* VC) {
    __shared__ float q[768]; __shared__ float kr[64];
    const int r = blockIdx.x, tid = threadIdx.x; const bool lat = r < NL; const int t = r % S, prow = t / 64, pcol = t % 64;
    for (int i = tid; i < 768; i += 256) q[i] = QCraw[(size_t)r * 768 + i];
    if (tid < 64) kr[tid] = P[(size_t)r * DIN + O_CKR + tid];
    __syncthreads();
    for (int i = tid; i < 768; i += 256) { const int h = i / 192, d = i % 192;
        QC[(size_t)r * 768 + i] = (d < 128 || !lat) ? q[i] : rope_elem(q + h * 192 + 128, 64, d - 128, prow, pcol);
        KC[(size_t)r * 768 + i] = d < 128 ? KVraw[(size_t)r * 1024 + h * 256 + d] : (lat ? rope_elem(kr, 64, d - 128, prow, pcol) : kr[d - 128]); }
    for (int i = tid; i < 512; i += 256) { const int h = i / 128, d = i % 128; VC[(size_t)r * 512 + i] = KVraw[(size_t)r * 1024 + h * 256 + 128 + d]; }
}
template <int DK, int KT>
__global__ __launch_bounds__(256) void k_attn(const float* Q, int ldq, const float* K, int ldk, const float* V, int ldv, float* O, int ocol0,
                                              int group, const float* sink, float scale, int window, int q_ctx) {
    constexpr int KPT = KT / 8;
    __shared__ float Qs[32][DK + 1]; __shared__ float Ks[KT][DK + 1]; __shared__ float Vs[KT][128]; __shared__ float Ss[32][KT + 1];
    const int tid = threadIdx.x, tq = tid >> 3, tk = tid & 7, h = blockIdx.y, kvh = h / group;
    const int q0 = blockIdx.x * 32;
    const int b = q_ctx ? q0 / L : q0 / S, t0 = q_ctx ? 0 : q0 % S;
    const int qrow0 = q_ctx ? NL + q0 : q0;
    for (int i = tid; i < 32 * DK; i += 256) { const int rr = i / DK, cc = i % DK; Qs[rr][cc] = Q[(size_t)(qrow0 + rr) * ldq + h * DK + cc]; }
    int lo = 0, hi = 0;
    if (!q_ctx) { if (window) { lo = t0 - 128 < 0 ? 0 : t0 - 128; hi = t0 + 160 > S ? S : t0 + 160; } else { lo = 0; hi = S; } }
    const int ntile = L / KT + (hi - lo) / KT;
    float m = -1e30f, l = 0.f, o[16];
    for (int i = 0; i < 16; ++i) o[i] = 0.f;
    for (int it = 0; it < ntile; ++it) {
        const bool isctx = it < L / KT; const int kpos0 = isctx ? it * KT : lo + (it - L / KT) * KT;
        const int krow0 = isctx ? NL + b * L + kpos0 : b * S + kpos0;
        __syncthreads();
        for (int i = tid; i < KT * DK; i += 256) { const int rr = i / DK, cc = i % DK; Ks[rr][cc] = K[(size_t)(krow0 + rr) * ldk + kvh * DK + cc]; }
        for (int i = tid; i < KT * 128; i += 256) { const int rr = i / 128, cc = i % 128; Vs[rr][cc] = V[(size_t)(krow0 + rr) * ldv + kvh * 128 + cc]; }
        __syncthreads();
        float s4[KPT];
        for (int i = 0; i < KPT; ++i) s4[i] = 0.f;
        for (int d = 0; d < DK; ++d) { const float qv = Qs[tq][d];
#pragma unroll
            for (int i = 0; i < KPT; ++i) s4[i] += qv * Ks[tk * KPT + i][d]; }
        for (int i = 0; i < KPT; ++i) { float sv = s4[i] * scale;
            if (window && !isctx) { const int df = (kpos0 + tk * KPT + i) - (t0 + tq); if (df > 128 || df < -128) sv = -1e30f; }
            Ss[tq][tk * KPT + i] = sv; }
        __syncthreads();
        float mx = m;
        for (int k = 0; k < KT; ++k) mx = fmaxf(mx, Ss[tq][k]);
        const float alpha = expf(m - mx); m = mx; l *= alpha;
        for (int i = 0; i < 16; ++i) o[i] *= alpha;
        for (int k = 0; k < KT; ++k) { const float pk = expf(Ss[tq][k] - m); l += pk;
#pragma unroll
            for (int i = 0; i < 16; ++i) o[i] += pk * Vs[k][tk * 16 + i]; }
    }
    if (sink) l += expf(sink[h] - m);
    const float rl = 1.f / l;
    for (int i = 0; i < 16; ++i) O[(size_t)(qrow0 + tq) * D + ocol0 + h * 128 + tk * 16 + i] = o[i] * rl;
}
__global__ __launch_bounds__(256) void k_swiglu(float* G1, const float* G3, size_t n) {
    for (size_t i = (size_t)blockIdx.x * 256 + threadIdx.x; i < n; i += (size_t)gridDim.x * 256) { const float a = G1[i]; G1[i] = a / (1.f + expf(-a)) * G3[i]; }
}
__global__ __launch_bounds__(256) void k_initx(const float* x, const float* ctx, float* X) {
    const size_t n = (size_t)NR * D;
    for (size_t i = (size_t)blockIdx.x * 256 + threadIdx.x; i < n; i += (size_t)gridDim.x * 256) X[i] = i < (size_t)NL * D ? x[i] : ctx[i - (size_t)NL * D];
}

struct Bufs { float *modv, *X, *H, *P, *QA, *KA, *VA, *QB, *KB, *VB, *CQn, *CKVn, *QCraw, *KVraw, *QC, *KC, *VC, *CAT, *O, *G1, *G3; };
inline size_t carve(Bufs& b, char* base) {
    size_t off = 0; auto take = [&](size_t nfl) { float* p = (float*)(base + off); off += (nfl * 4 + 255) / 256 * 256; return p; };
    b.modv = take((size_t)DEPTH * 3 * 6 * D); b.X = take((size_t)NR * D); b.H = take((size_t)NR * D);
    const size_t r0 = off;
    b.P = take((size_t)NR * DIN); b.QA = take((size_t)NR * 768); b.KA = take((size_t)NR * 256); b.VA = take((size_t)NR * 256);
    b.QB = take((size_t)NR * 768); b.KB = take((size_t)NR * 256); b.VB = take((size_t)NR * 256);
    b.CQn = take((size_t)NR * 512); b.CKVn = take((size_t)NR * 256); b.QCraw = take((size_t)NR * 768); b.KVraw = take((size_t)NR * 1024);
    b.QC = take((size_t)NR * 768); b.KC = take((size_t)NR * 768); b.VC = take((size_t)NR * 512); b.CAT = take((size_t)NR * D);
    const size_t r1 = off; off = r0;
    b.O = nullptr; b.G1 = take((size_t)NR * DFF); b.G3 = take((size_t)NR * DFF);
    if (off < r1) off = r1;
    b.O = take((size_t)NR * D);
    return off;
}
inline void gemm(hipStream_t st, const float* A, int lda, const float* W, int ldw, float* C, int ldc, int M, int N, int K) {
    hipLaunchKernelGGL(k_gemm, dim3(N / 64, M / 128), dim3(256), 0, st, A, lda, W, ldw, C, ldc, K);
}
inline void forward(void* const* d_in, float* d_out, char* ws, hipStream_t st) {
    Bufs b; carve(b, ws);
    const float *x = (const float*)d_in[0], *c = (const float*)d_in[1], *ctx = (const float*)d_in[2], *cctx = (const float*)d_in[3], *w_mod = (const float*)d_in[4], *b_mod = (const float*)d_in[5];
    const float *g_mix_pre = (const float*)d_in[6], *g_mix_post = (const float*)d_in[7], *g_ffn_pre = (const float*)d_in[8], *g_ffn_post = (const float*)d_in[9];
    const float *w_in = (const float*)d_in[10], *sink_a = (const float*)d_in[11], *g_qn = (const float*)d_in[12], *g_kn = (const float*)d_in[13], *g_cq = (const float*)d_in[14], *w_uq = (const float*)d_in[15];
    const float *g_ckv = (const float*)d_in[16], *w_ukv = (const float*)d_in[17], *w_out = (const float*)d_in[18], *w1 = (const float*)d_in[19], *w3 = (const float*)d_in[20], *w2 = (const float*)d_in[21];
    hipLaunchKernelGGL(k_mod, dim3(6 * D / 256, DEPTH), dim3(256), 0, st, c, cctx, w_mod, b_mod, b.modv);
    hipLaunchKernelGGL(k_initx, dim3(4096), dim3(256), 0, st, x, ctx, b.X);
    const float sc_ab = 0.08838834764831845f, sc_c = 0.07216878364870323f;
    for (int l = 0; l < DEPTH; ++l) {
        const float* modl = b.modv + (size_t)l * 3 * 6 * D;
        hipLaunchKernelGGL(k_norm_mod, dim3(NR), dim3(256), 0, st, b.X, g_mix_pre + l * D, modl, 0, 1, b.H);
        gemm(st, b.H, D, w_in + (size_t)l * D * DIN, DIN, b.P, DIN, NR, DIN, D);
        hipLaunchKernelGGL(k_post1, dim3(NR), dim3(256), 0, st, b.P, g_qn + l * 128, g_kn + l * 128, g_cq + l * 512, g_ckv + l * 256, b.QA, b.KA, b.VA, b.QB, b.KB, b.VB, b.CQn, b.CKVn);
        gemm(st, b.CQn, 512, w_uq + (size_t)l * 512 * 768, 768, b.QCraw, 768, NR, 768, 512);
        gemm(st, b.CKVn, 256, w_ukv + (size_t)l * 256 * 1024, 1024, b.KVraw, 1024, NR, 1024, 256);
        hipLaunchKernelGGL(k_post2, dim3(NR), dim3(256), 0, st, b.P, b.QCraw, b.KVraw, b.QC, b.KC, b.VC);
        hipLaunchKernelGGL((k_attn<128, 32>), dim3(NL / 32, 6), dim3(256), 0, st, b.QA, 768, b.KA, 256, b.VA, 256, b.CAT, 0, 3, sink_a + l * 6, sc_ab, 1, 0);
        hipLaunchKernelGGL((k_attn<128, 32>), dim3(NL / 32, 6), dim3(256), 0, st, b.QB, 768, b.KB, 256, b.VB, 256, b.CAT, 768, 3, (const float*)nullptr, sc_ab, 0, 0);
        hipLaunchKernelGGL((k_attn<192, 16>), dim3(NL / 32, 4), dim3(256), 0, st, b.QC, 768, b.KC, 768, b.VC, 512, b.CAT, 1536, 1, (const float*)nullptr, sc_c, 0, 0);
        hipLaunchKernelGGL((k_attn<128, 32>), dim3(NC / 32, 6), dim3(256), 0, st, b.QA, 768, b.KA, 256, b.VA, 256, b.CAT, 0, 3, sink_a + l * 6, sc_ab, 0, 1);
        hipLaunchKernelGGL((k_attn<128, 32>), dim3(NC / 32, 6), dim3(256), 0, st, b.QB, 768, b.KB, 256, b.VB, 256, b.CAT, 768, 3, (const float*)nullptr, sc_ab, 0, 1);
        hipLaunchKernelGGL((k_attn<192, 16>), dim3(NC / 32, 4), dim3(256), 0, st, b.QC, 768, b.KC, 768, b.VC, 512, b.CAT, 1536, 1, (const float*)nullptr, sc_c, 0, 1);
        gemm(st, b.CAT, D, w_out + (size_t)l * D * D, D, b.O, D, NR, D, D);
        hipLaunchKernelGGL(k_resid, dim3(NR), dim3(256), 0, st, b.X, b.O, g_mix_post + l * D, modl, 2);
        hipLaunchKernelGGL(k_norm_mod, dim3(NR), dim3(256), 0, st, b.X, g_ffn_pre + l * D, modl, 3, 4, b.H);
        gemm(st, b.H, D, w1 + (size_t)l * D * DFF, DFF, b.G1, DFF, NR, DFF, D);
        gemm(st, b.H, D, w3 + (size_t)l * D * DFF, DFF, b.G3, DFF, NR, DFF, D);
        hipLaunchKernelGGL(k_swiglu, dim3(8192), dim3(256), 0, st, b.G1, b.G3, (size_t)NR * DFF);
        gemm(st, b.G1, DFF, w2 + (size_t)l * DFF * D, D, b.O, D, NR, D, DFF);
        hipLaunchKernelGGL(k_resid, dim3(NR), dim3(256), 0, st, b.X, b.O, g_ffn_post + l * D, modl, 5);
    }
    if (d_out) (void)hipMemcpyAsync(d_out, b.X, (size_t)NL * D * 4, hipMemcpyDeviceToDevice, st);
}
}

namespace pg8 {
#define PG8_LAS __attribute__((address_space(3)))
typedef unsigned short bf16_t;
typedef short bf16x8 __attribute__((ext_vector_type(8)));
typedef float f32x4 __attribute__((ext_vector_type(4)));
typedef float f32x2 __attribute__((ext_vector_type(2)));
typedef unsigned u32x4 __attribute__((ext_vector_type(4)));
typedef unsigned u32x2 __attribute__((ext_vector_type(2)));
constexpr int BM = 256, BK = 64, HALF = 128, HTB = HALF * BK * 2  , STAGE_BYTES = 8 * HTB, NXCD = 8, WGM = 8;

__host__ __device__ __forceinline__ int lds_byte(int r, int c) { const int st = (r >> 4) * 2 + (c >> 5), rr = r & 15, cc = c & 31, ob = rr * 64 + cc * 2; return st * 1024 + (ob ^ (((ob >> 9) & 1) << 5)); }
__host__ __device__ __forceinline__ void stage_rc(int b, int& R, int& C) { const int st = b / 1024, sb = b % 1024, swz = sb ^ (((sb >> 9) & 1) << 5); R = (st >> 1) * 16 + swz / 64; C = (st & 1) * 32 + (swz % 64) / 2; }
__host__ __device__ __forceinline__ int perm32(int rho) { const int n = rho >> 4, i = rho & 15; return 8 * (i >> 2) + 4 * n + (i & 3); }

struct Unit { int pm, pn; };
struct Gemm { const bf16_t* A; const bf16_t* Bt; int M, N, K, lda; };

struct StaticOrder {
    int nM, nN, nwg, G, c;
    __host__ __device__ void init(int M, int N, int G_, int c_) { nM = M / BM; nN = N / BM; nwg = nM * nN; G = G_; c = c_; }
    __host__ __device__ bool next(int i, Unit& u) const {
        const long L = (long)i * G + c; if (L >= nwg) return false;
        int wgid = (int)L; { const int q = nwg / NXCD, r = nwg % NXCD, xcd = wgid % NXCD, off = wgid / NXCD; wgid = (xcd < r ? xcd * (q + 1) : r * (q + 1) + (xcd - r) * q) + off; }
        const int nig = WGM * nN, gid = wgid / nig, fm = gid * WGM, gsz = (nM - fm) < WGM ? (nM - fm) : WGM;
        u.pm = fm + ((wgid % nig) % gsz); u.pn = (wgid % nig) / gsz; return true;
    }
    __device__ __forceinline__ void a_ready(const Unit&) const {}
    __device__ __forceinline__ void done(const Unit&) const {}
};
struct OffsetOrder {
    int nN, nwg, L;
    __host__ __device__ void init(int M, int N, int c, int off) { nN = N / BM; nwg = (M / BM) * nN; L = c - off; }
    __host__ __device__ bool has() const { return L >= 0 && L < nwg; }
    __host__ __device__ bool next(int i, Unit& u) const { if (i != 0 || !has()) return false; u.pm = L / nN; u.pn = L % nN; return true; }
    __device__ __forceinline__ void a_ready(const Unit&) const {}
    __device__ __forceinline__ void done(const Unit&) const {}
};

__device__ __forceinline__ unsigned cvt_pk_bf16(float lo, float hi) { unsigned r; asm volatile("v_cvt_pk_bf16_f32 %0, %1, %2" : "=v"(r) : "v"(lo), "v"(hi)); return r; }
__device__ __forceinline__ u32x4 pack8(const f32x4 v0, const f32x4 v1) { u32x4 w; w.x = cvt_pk_bf16(v0[0], v0[1]); w.y = cvt_pk_bf16(v0[2], v0[3]); w.z = cvt_pk_bf16(v1[0], v1[1]); w.w = cvt_pk_bf16(v1[2], v1[3]); return w; }

struct EpiPlain {
    static constexpr bool PERM = true;
    bf16_t* O; int ldc;
    __device__ __forceinline__ void operator()(const f32x4 (&acc)[2][2][4][2], const Unit& u, int wr, int wc, int fr, int fq) const {
        const int row0 = u.pm * BM + wr * 64 + fr, col0 = u.pn * BM + wc * 32 + 8 * fq;
#pragma unroll
        for (int ai = 0; ai < 2; ++ai)
#pragma unroll
            for (int m = 0; m < 4; ++m) { bf16_t* rowp = O + (size_t)(row0 + ai * HALF + m * 16) * ldc + col0;
#pragma unroll
                for (int bj = 0; bj < 2; ++bj) *(u32x4*)(rowp + bj * HALF) = pack8(acc[ai][bj][m][0], acc[ai][bj][m][1]); }
    }
};
struct EpiIn {
    static constexpr bool PERM = true;
    bf16_t* O; int ldc; float* ssq;
    __device__ __forceinline__ void operator()(const f32x4 (&acc)[2][2][4][2], const Unit& u, int wr, int wc, int fr, int fq) const {
        const int row0 = u.pm * BM + wr * 64 + fr, col0 = u.pn * BM + wc * 32 + 8 * fq;
#pragma unroll
        for (int ai = 0; ai < 2; ++ai)
#pragma unroll
            for (int m = 0; m < 4; ++m) { bf16_t* rowp = O + (size_t)(row0 + ai * HALF + m * 16) * ldc + col0;
#pragma unroll
                for (int bj = 0; bj < 2; ++bj) *(u32x4*)(rowp + bj * HALF) = pack8(acc[ai][bj][m][0], acc[ai][bj][m][1]); }
        if (u.pn >= 10 && u.pn <= 12) {
#pragma unroll
            for (int ai = 0; ai < 2; ++ai)
#pragma unroll
                for (int m = 0; m < 4; ++m) { float s = 0.f;
#pragma unroll
                    for (int bj = 0; bj < 2; ++bj)
#pragma unroll
                        for (int n = 0; n < 2; ++n) { const f32x4 x = acc[ai][bj][m][n]; s += (x[0] * x[0] + x[1] * x[1]) + (x[2] * x[2] + x[3] * x[3]); }
                    s += __shfl_xor(s, 16); s += __shfl_xor(s, 32);
                    if (fq == 0) ssq[(size_t)(row0 + ai * HALF + m * 16) * 12 + (u.pn - 10) * 4 + wc] = s; }
        }
    }
};
struct EpiUq {
    static constexpr bool PERM = false;
    bf16_t* O; const float* ssq; const float* tab64;
    __device__ __forceinline__ void operator()(const f32x4 (&acc)[2][2][4][2], const Unit& u, int wr, int wc, int fr, int fq) const {
        float rs[2][4];
#pragma unroll
        for (int ai = 0; ai < 2; ++ai)
#pragma unroll
            for (int m = 0; m < 4; ++m) { const int row = u.pm * BM + ai * HALF + wr * 64 + m * 16 + fr;
                const f32x4 q0 = *(const f32x4*)(ssq + (size_t)row * 12), q1 = *(const f32x4*)(ssq + (size_t)row * 12 + 4);
                rs[ai][m] = rsqrtf(((q0[0] + q0[1]) + (q0[2] + q0[3]) + (q1[0] + q1[1]) + (q1[2] + q1[3])) * (1.f / 512.f) + 1e-6f);
                if (m & 1) asm volatile("" ::: "memory"); }
#pragma unroll
        for (int ai = 0; ai < 2; ++ai)
#pragma unroll
            for (int m = 0; m < 4; ++m) {
                const int row = u.pm * BM + ai * HALF + wr * 64 + m * 16 + fr; const float rstd = rs[ai][m];
                const bool lat = row < 8192; const int t = row & 4095, prow = t >> 6, pcol = t & 63;
#pragma unroll
                for (int bj = 0; bj < 2; ++bj) {
                    const int g6 = (8 * u.pn + 4 * bj + wc) % 6;
                    f32x4 v0 = acc[ai][bj][m][0] * rstd, v1 = acc[ai][bj][m][1] * rstd;
                    if (g6 >= 4 && lat) {
                        const int pos = g6 == 4 ? prow : pcol;
                        const f32x4 t0 = *(const f32x4*)(tab64 + (size_t)(pos * 16 + 4 * fq) * 2), t1 = *(const f32x4*)(tab64 + (size_t)(pos * 16 + 4 * fq) * 2 + 4);
                        const f32x4 cs = {t0[0], t0[2], t1[0], t1[2]}, sn = {t0[1], t0[3], t1[1], t1[3]};
                        const f32x4 o0 = v0 * cs - v1 * sn, o1 = v1 * cs + v0 * sn; v0 = o0; v1 = o1;
                    }
                    bf16_t* p = O + (size_t)row * 768 + u.pn * BM + bj * HALF + wc * 32 + 4 * fq;
                    u32x2 w0, w1; w0.x = cvt_pk_bf16(v0[0], v0[1]); w0.y = cvt_pk_bf16(v0[2], v0[3]); w1.x = cvt_pk_bf16(v1[0], v1[1]); w1.y = cvt_pk_bf16(v1[2], v1[3]);
                    *(u32x2*)p = w0; *(u32x2*)(p + 16) = w1;
                }
                asm volatile("" ::: "memory");
            }
    }
};
struct EpiUkv {
    static constexpr bool PERM = true;
    bf16_t* O; const float* ssq;
    __device__ __forceinline__ void operator()(const f32x4 (&acc)[2][2][4][2], const Unit& u, int wr, int wc, int fr, int fq) const {
        const int row0 = u.pm * BM + wr * 64 + fr, col0 = u.pn * BM + wc * 32 + 8 * fq;
        float rs[2][4];
#pragma unroll
        for (int ai = 0; ai < 2; ++ai)
#pragma unroll
            for (int m = 0; m < 4; ++m) { const int row = row0 + ai * HALF + m * 16;
                const f32x4 q0 = *(const f32x4*)(ssq + (size_t)row * 12 + 8);
                rs[ai][m] = rsqrtf(((q0[0] + q0[1]) + (q0[2] + q0[3])) * (1.f / 256.f) + 1e-6f);
                if (m & 1) asm volatile("" ::: "memory"); }
#pragma unroll
        for (int ai = 0; ai < 2; ++ai)
#pragma unroll
            for (int m = 0; m < 4; ++m) { const int row = row0 + ai * HALF + m * 16; const float rstd = rs[ai][m];
                bf16_t* rowp = O + (size_t)row * 1024 + col0;
#pragma unroll
                for (int bj = 0; bj < 2; ++bj) *(u32x4*)(rowp + bj * HALF) = pack8(acc[ai][bj][m][0] * rstd, acc[ai][bj][m][1] * rstd); }
    }
};
struct EpiSwiglu {
    static constexpr bool PERM = true;
    bf16_t* O; int ldc;
    __device__ __forceinline__ void operator()(const f32x4 (&acc)[2][2][4][2], const Unit& u, int wr, int wc, int fr, int fq) const {
        const int row0 = u.pm * BM + wr * 64 + fr, col0 = u.pn * HALF + wc * 32 + 8 * fq;
#pragma unroll
        for (int ai = 0; ai < 2; ++ai)
#pragma unroll
            for (int m = 0; m < 4; ++m) { f32x4 r[2];
#pragma unroll
                for (int n = 0; n < 2; ++n) { const f32x4 g = acc[ai][0][m][n], up = acc[ai][1][m][n];
#pragma unroll
                    for (int j = 0; j < 4; ++j) { const float e = __builtin_amdgcn_exp2f(g[j] * -1.4426950408889634f); r[n][j] = g[j] * __builtin_amdgcn_rcpf(1.f + e) * up[j]; } }
                *(u32x4*)(O + (size_t)(row0 + ai * HALF + m * 16) * ldc + col0) = pack8(r[0], r[1]); }
    }
};

template <class Epi, class Sched, bool ALIGN_EPI>
__device__ __forceinline__ void gemm_phase(PG8_LAS unsigned char* lds, const Gemm g, const Sched& S, const Epi& E) {
    int tid_ = threadIdx.x; asm volatile("" : "+v"(tid_));
    const int tid = tid_, wid = __builtin_amdgcn_readfirstlane(tid >> 6), lane = tid & 63, wr = wid >> 2, wc = wid & 3, fr = lane & 15, fq = lane >> 4;
    int K_ = g.K; asm volatile("" : "+s"(K_));
    const int K = K_, nt = K / BK, lda = g.lda;
    unsigned voffA[2], voffB[2];
#pragma unroll
    for (int i = 0; i < 2; ++i) { int R, C; stage_rc(tid * 16 + i * 8192, R, C); const int Rb = Epi::PERM ? ((R & ~31) + perm32(R & 31)) : R;
        voffA[i] = (unsigned)(R * lda + C) * 2u; voffB[i] = (unsigned)(Rb * K + C) * 2u; }
    const size_t kstep = (size_t)(BK * 2);
    const size_t hstepA = (size_t)HALF * lda * 2, tstepA = 2 * hstepA, hstepB = (size_t)HALF * K * 2, tstepB = 2 * hstepB;
    const unsigned ldsw = (unsigned)wid * 1024u;
    const int aoff = lds_byte(wr * 64 + fr, fq * 8), boff = lds_byte(wc * 32 + fr, fq * 8);
#define PG8_SA(b, h) (((b) * 2 + (h)) * HTB)
#define PG8_SB(b, h) ((4 + (b) * 2 + (h)) * HTB)
#define PG8_STAGE(bufoff, gbase, voff) do { _Pragma("unroll") for (int _i = 0; _i < 2; ++_i) \
        __builtin_amdgcn_global_load_lds((const unsigned*)((const char*)(gbase) + (voff)[_i]), (PG8_LAS unsigned*)(lds + (bufoff) + ldsw + _i * 8192), 16, 0, 0); } while (0)
#define PG8_LDA(dst, b, h) do { _Pragma("unroll") for (int m = 0; m < 4; ++m) _Pragma("unroll") for (int k = 0; k < 2; ++k) dst[m][k] = *(const PG8_LAS bf16x8*)(lds + PG8_SA(b, h) + aoff + m * 2048 + k * 1024); } while (0)
#define PG8_LDB(dst, b, h) do { _Pragma("unroll") for (int n = 0; n < 2; ++n) _Pragma("unroll") for (int k = 0; k < 2; ++k) dst[n][k] = *(const PG8_LAS bf16x8*)(lds + PG8_SB(b, h) + boff + n * 2048 + k * 1024); } while (0)
#define PG8_MMA(ai, bj, At, Bt) do { __builtin_amdgcn_s_setprio(1); _Pragma("unroll") for (int m = 0; m < 4; ++m) _Pragma("unroll") for (int n = 0; n < 2; ++n) _Pragma("unroll") for (int k = 0; k < 2; ++k) \
        acc[ai][bj][m][n] = __builtin_amdgcn_mfma_f32_16x16x32_bf16(Bt[n][k], At[m][k], acc[ai][bj][m][n], 0, 0, 0); __builtin_amdgcn_s_setprio(0); } while (0)
#define PG8_WAIT_V(n) asm volatile("s_waitcnt vmcnt(" #n ")" ::: "memory")
#define PG8_WAIT_L(n) asm volatile("s_waitcnt lgkmcnt(" #n ")" ::: "memory")
#define PG8_BAR __builtin_amdgcn_s_barrier()
#define PG8_SCHED __builtin_amdgcn_sched_barrier(0)
    Unit cur, nxt; int ui = 0;
    if (!S.next(0, cur)) return;
    f32x4 acc[2][2][4][2];
#pragma unroll
    for (int a = 0; a < 2; ++a)
#pragma unroll
        for (int b = 0; b < 2; ++b)
#pragma unroll
            for (int m = 0; m < 4; ++m)
#pragma unroll
                for (int n = 0; n < 2; ++n) acc[a][b][m][n] = (f32x4){0.f, 0.f, 0.f, 0.f};
    bf16x8 At[4][2], B0[2][2], B1[2][2];
    const char* cA = (const char*)g.A + (size_t)cur.pm * tstepA; const char* cB = (const char*)g.Bt + (size_t)cur.pn * tstepB;
    S.a_ready(cur);
    PG8_STAGE(PG8_SB(0, 0), cB, voffB); PG8_STAGE(PG8_SB(0, 1), cB + hstepB, voffB); PG8_STAGE(PG8_SA(0, 0), cA, voffA); PG8_STAGE(PG8_SA(0, 1), cA + hstepA, voffA);
    if (wr == 1) PG8_BAR;
    PG8_WAIT_V(2); PG8_BAR;
    PG8_STAGE(PG8_SB(1, 0), cB + kstep, voffB); PG8_STAGE(PG8_SA(1, 0), cA + kstep, voffA); PG8_STAGE(PG8_SB(1, 1), cB + hstepB + kstep, voffB);
    PG8_WAIT_V(6); PG8_BAR;
    for (;;) {
        const bool has_next = S.next(ui + 1, nxt);
        const char* nA = has_next ? (const char*)g.A + (size_t)nxt.pm * tstepA : cA; const char* nB = has_next ? (const char*)g.Bt + (size_t)nxt.pn * tstepB : cB;
        for (int t = 0; t < nt; t += 2) {
            const bool last = (t == nt - 2);
            const char* a1 = cA + (size_t)(t + 1) * kstep;
            const char* a2 = last ? nA : cA + (size_t)(t + 2) * kstep; const char* b2 = last ? nB : cB + (size_t)(t + 2) * kstep;
            const char* a3 = a2 + kstep; const char* b3 = b2 + kstep;
            if (last && has_next) S.a_ready(nxt);
            PG8_LDB(B0, 0, 0); PG8_LDB(B1, 0, 1); PG8_SCHED; PG8_LDA(At, 0, 0); PG8_STAGE(PG8_SA(1, 1), a1 + hstepA, voffA);
            PG8_WAIT_V(8); PG8_WAIT_L(0); PG8_BAR; PG8_MMA(0, 0, At, B0); PG8_MMA(0, 1, At, B1); PG8_BAR; PG8_SCHED;
            PG8_LDA(At, 0, 1); PG8_STAGE(PG8_SB(0, 0), b2, voffB); PG8_STAGE(PG8_SB(0, 1), b2 + hstepB, voffB); PG8_STAGE(PG8_SA(0, 0), a2, voffA);
            PG8_WAIT_V(8); PG8_WAIT_L(0); PG8_BAR; PG8_MMA(1, 0, At, B0); PG8_MMA(1, 1, At, B1); PG8_BAR; PG8_SCHED;
            PG8_LDB(B0, 1, 0); PG8_LDB(B1, 1, 1); PG8_SCHED; PG8_LDA(At, 1, 0); PG8_STAGE(PG8_SA(0, 1), a2 + hstepA, voffA);
            PG8_WAIT_V(8); PG8_WAIT_L(0); PG8_BAR; PG8_MMA(0, 0, At, B0); PG8_MMA(0, 1, At, B1); PG8_BAR; PG8_SCHED;
            PG8_LDA(At, 1, 1); PG8_STAGE(PG8_SB(1, 0), b3, voffB); PG8_STAGE(PG8_SB(1, 1), b3 + hstepB, voffB); PG8_STAGE(PG8_SA(1, 0), a3, voffA);
            PG8_WAIT_V(8); PG8_WAIT_L(0); PG8_BAR; PG8_MMA(1, 0, At, B0); PG8_MMA(1, 1, At, B1); PG8_BAR; PG8_SCHED;
        }
        if constexpr (ALIGN_EPI) { if (wr == 0) PG8_BAR; }
        E(acc, cur, wr, wc, fr, fq); S.done(cur);
        if (!has_next) break;
#pragma unroll
        for (int a = 0; a < 2; ++a)
#pragma unroll
            for (int b = 0; b < 2; ++b)
#pragma unroll
                for (int m = 0; m < 4; ++m)
#pragma unroll
                    for (int n = 0; n < 2; ++n) acc[a][b][m][n] = (f32x4){0.f, 0.f, 0.f, 0.f};
        cur = nxt; cA = nA; cB = nB; ++ui;
        if constexpr (ALIGN_EPI) { if (wr == 1) PG8_BAR; }
    }
    PG8_WAIT_V(0);
    if constexpr (!ALIGN_EPI) { if (wr == 0) PG8_BAR; }
    PG8_BAR;
#undef PG8_SA
#undef PG8_SB
#undef PG8_STAGE
#undef PG8_LDA
#undef PG8_LDB
#undef PG8_MMA
#undef PG8_WAIT_V
#undef PG8_WAIT_L
#undef PG8_BAR
#undef PG8_SCHED
}
}

namespace at {
using bf16_t = unsigned short;
using bf16x8 = __attribute__((ext_vector_type(8))) short;
using s16x4  = __attribute__((ext_vector_type(4))) short;
using f32x16 = __attribute__((ext_vector_type(16))) float;
using u32x4  = __attribute__((ext_vector_type(4))) unsigned;
constexpr int NW = 8, QBLK = 32, KVBLK = 64;
constexpr int SHM_V = 16384, SHM_K = 16384, SHM_K2 = 8192;
constexpr int OFF_V = 0, OFF_K = 2 * SHM_V, OFF_K2 = OFF_K + 2 * SHM_K, OFF_WS = OFF_K2 + 2 * SHM_K2, OFF_Q2 = OFF_WS + NW * 64 * 4, ATT_LDS = OFF_Q2 + NW * 4096;
constexpr float THR = 8.f;
#define KSWZ(row, colB) ((row) * 256 + ((colB) ^ (((row) & 7) << 4)))
#define KSWZ2(row, colB) ((row) * 128 + ((colB) ^ (((row) & 7) << 4)))
#define SBAR() __builtin_amdgcn_sched_barrier(0)
__device__ __forceinline__ int crow(int r, int hi) { return (r & 3) + 8 * (r >> 2) + 4 * hi; }
__device__ __forceinline__ unsigned cvtpk(float lo, float hi) { unsigned r; asm volatile("v_cvt_pk_bf16_f32 %0, %1, %2" : "=v"(r) : "v"(lo), "v"(hi)); return r; }

struct AUnit {
    const bf16_t* Q; const bf16_t* KV; const bf16_t* K2; bf16_t* O;
    long kc, kl, vc, vl, k2c, k2l;
    int ldq, ldk, ldv, ldk2, ldo;
    int ntl;
    int qk_off;
    float sink;
};

template <int DK>
__device__ __forceinline__ void partialSM(f32x16& p0, f32x16& p1, float& m_reg, float& mn, float& alpha) {
    constexpr float SCALE = DK == 128 ? 0.08838834764831845f : 0.07216878364870323f, C = SCALE * 1.4426950408889634f;
    float pmax = p0[0];
#pragma unroll
    for (int r = 1; r < 16; ++r) pmax = fmaxf(pmax, p0[r]);
#pragma unroll
    for (int r = 0; r < 16; ++r) pmax = fmaxf(pmax, p1[r]);
    { auto rr = __builtin_amdgcn_permlane32_swap(__float_as_uint(pmax), __float_as_uint(pmax), false, false);
      pmax = fmaxf(__uint_as_float(rr[0]), __uint_as_float(rr[1])); }
    if (__builtin_expect(__all(pmax - m_reg <= THR / SCALE), 1)) { mn = m_reg; alpha = 1.f; }
    else { mn = fmaxf(m_reg, pmax); alpha = __builtin_amdgcn_exp2f((m_reg - mn) * C); m_reg = mn; }
    const float mnC = -mn * C;
#pragma unroll
    for (int r = 0; r < 16; ++r) p0[r] = fmaf(p0[r], C, mnC);
#pragma unroll
    for (int r = 0; r < 16; ++r) p1[r] = fmaf(p1[r], C, mnC);
#pragma unroll
    for (int r = 0; r < 16; ++r) p0[r] = __builtin_amdgcn_exp2f(p0[r]);
}
__device__ __forceinline__ void finishSM(f32x16& p0, f32x16& p1, float alpha, float& l_reg, bf16x8& pa0, bf16x8& pa1, bf16x8& pa2, bf16x8& pa3) {
#pragma unroll
    for (int r = 0; r < 16; ++r) p1[r] = __builtin_amdgcn_exp2f(p1[r]);
    float ps = 0;
#pragma unroll
    for (int r = 0; r < 16; ++r) ps += p0[r];
#pragma unroll
    for (int r = 0; r < 16; ++r) ps += p1[r];
    { auto rr = __builtin_amdgcn_permlane32_swap(__float_as_uint(ps), __float_as_uint(ps), false, false);
      ps = __uint_as_float(rr[0]) + __uint_as_float(rr[1]); }
    l_reg = l_reg * alpha + ps;
#define PK4(P, BASE, OUT) do { unsigned a0 = cvtpk(P[BASE + 0], P[BASE + 1]), a1 = cvtpk(P[BASE + 2], P[BASE + 3]);   \
    unsigned b0 = cvtpk(P[BASE + 4], P[BASE + 5]), b1 = cvtpk(P[BASE + 6], P[BASE + 7]);                              \
    auto r0 = __builtin_amdgcn_permlane32_swap(a0, b0, false, false); auto r1 = __builtin_amdgcn_permlane32_swap(a1, b1, false, false); \
    u32x4 w = {r0[0], r1[0], r0[1], r1[1]}; OUT = *reinterpret_cast<bf16x8*>(&w); } while (0)
    PK4(p0, 0, pa0); PK4(p0, 8, pa1); PK4(p1, 0, pa2); PK4(p1, 8, pa3);
#undef PK4
}
template <int DK>
__device__ __forceinline__ void qkt(f32x16& p0, f32x16& p1, const char* Ks, const char* K2s, const bf16x8* qr, const char* q2, int r32, int hi) {
    p0 = f32x16{}; p1 = f32x16{};
#pragma unroll
    for (int d0 = 0; d0 < 8; ++d0) { const int cb = (d0 * 16 + hi * 8) * 2;
        const bf16x8 b0 = *reinterpret_cast<const bf16x8*>(Ks + KSWZ(r32, cb));
        const bf16x8 b1 = *reinterpret_cast<const bf16x8*>(Ks + KSWZ(32 + r32, cb));
        p0 = __builtin_amdgcn_mfma_f32_32x32x16_bf16(b0, qr[d0], p0, 0, 0, 0);
        p1 = __builtin_amdgcn_mfma_f32_32x32x16_bf16(b1, qr[d0], p1, 0, 0, 0); }
    if constexpr (DK == 192) {
#pragma unroll
        for (int d0 = 0; d0 < 4; ++d0) { const int cb = (d0 * 16 + hi * 8) * 2;
            const bf16x8 b0 = *reinterpret_cast<const bf16x8*>(K2s + KSWZ2(r32, cb));
            const bf16x8 b1 = *reinterpret_cast<const bf16x8*>(K2s + KSWZ2(32 + r32, cb));
            const bf16x8 qf = *reinterpret_cast<const bf16x8*>(q2 + d0 * 1024);
            p0 = __builtin_amdgcn_mfma_f32_32x32x16_bf16(b0, qf, p0, 0, 0, 0);
            p1 = __builtin_amdgcn_mfma_f32_32x32x16_bf16(b1, qf, p1, 0, 0, 0); }
    }
}
__device__ __forceinline__ int v_st(int k, int c) { const int kk = (k & ~0xC) | ((k & 4) << 1) | ((k & 8) >> 1); return ((kk >> 3) * 4 + (c >> 5)) * 512 + ((kk & 7) * 32 + (c & 31)) * 2; }
__device__ __forceinline__ int v_rd_base(int lane) { return ((lane & 3) << 3) | (((lane >> 2) & 3) << 6) | (((lane >> 4) & 1) << 5) | (((lane >> 5) & 1) << 8); }
constexpr int v_rd_off(int d0, int ks, int half) { return d0 * 512 + ks * 4096 + half * 2048; }
template <int OFF> __device__ __forceinline__ s16x4 tr_read(int vb) {
    s16x4 r; asm volatile("ds_read_b64_tr_b16 %0, %1 offset:%2" : "=&v"(r) : "v"(vb), "i"(OFF) : "memory"); return r;
}
template <int D0> __device__ __forceinline__ void pv_one(f32x16& od, int vb, bf16x8 pa0, bf16x8 pa1, bf16x8 pa2, bf16x8 pa3) {
    const s16x4 l0 = tr_read<v_rd_off(D0, 0, 0)>(vb), h0 = tr_read<v_rd_off(D0, 0, 1)>(vb), l1 = tr_read<v_rd_off(D0, 1, 0)>(vb), h1 = tr_read<v_rd_off(D0, 1, 1)>(vb);
    const s16x4 l2 = tr_read<v_rd_off(D0, 2, 0)>(vb), h2 = tr_read<v_rd_off(D0, 2, 1)>(vb), l3 = tr_read<v_rd_off(D0, 3, 0)>(vb), h3 = tr_read<v_rd_off(D0, 3, 1)>(vb);
    asm volatile("s_waitcnt lgkmcnt(0)" ::: "memory"); SBAR();
#define PK(L, H) (bf16x8){L[0], L[1], L[2], L[3], H[0], H[1], H[2], H[3]}
    od = __builtin_amdgcn_mfma_f32_32x32x16_bf16(pa0, PK(l0, h0), od, 0, 0, 0);
    od = __builtin_amdgcn_mfma_f32_32x32x16_bf16(pa1, PK(l1, h1), od, 0, 0, 0);
    od = __builtin_amdgcn_mfma_f32_32x32x16_bf16(pa2, PK(l2, h2), od, 0, 0, 0);
    od = __builtin_amdgcn_mfma_f32_32x32x16_bf16(pa3, PK(l3, h3), od, 0, 0, 0);
#undef PK
}
__device__ __forceinline__ void pv_d0(f32x16* o, int vb, bf16x8 pa0, bf16x8 pa1, bf16x8 pa2, bf16x8 pa3) {
    pv_one<0>(o[0], vb, pa0, pa1, pa2, pa3); pv_one<1>(o[1], vb, pa0, pa1, pa2, pa3); pv_one<2>(o[2], vb, pa0, pa1, pa2, pa3); pv_one<3>(o[3], vb, pa0, pa1, pa2, pa3);
}
__device__ __forceinline__ void wmask(f32x16& p0, f32x16& p1, int base, int hi) {
#pragma unroll
    for (int r = 0; r < 16; ++r) { const int d0 = base + (r & 3) + 8 * (r >> 2) + 4 * hi, d1 = d0 + 32;
        if (d0 > 128 || d0 < -128) p0[r] = -1e30f; if (d1 > 128 || d1 < -128) p1[r] = -1e30f; }
}

template <int DK, bool WINDOW>
__device__ __forceinline__ void attn_unit(const AUnit U, char* lds) {
    constexpr int ND0 = DK / 16;
    constexpr float SCALE = DK == 128 ? 0.08838834764831845f : 0.07216878364870323f, C = SCALE * 1.4426950408889634f;
    int tid_ = threadIdx.x; asm volatile("" : "+v"(tid_));
    const int tid = tid_, wid = __builtin_amdgcn_readfirstlane(tid >> 6), lane = tid & 63, r32 = lane & 31, hi = lane >> 5;
    char* V_lds = lds + OFF_V; char* K_lds = lds + OFF_K; char* K2_lds = lds + OFF_K2;
    float* ws = (float*)(lds + OFF_WS) + wid * 64; float* li_l = ws; float* al_l = ws + 32;
    float m_reg = -1e30f, l_reg = 0; f32x16 o[4] = {}; bf16x8 qr[8];
    char* q2 = lds + OFF_Q2 + wid * 4096 + lane * 16;
    const bf16_t* Qw = U.Q + (size_t)(wid * QBLK + r32) * U.ldq + hi * 8;
#pragma unroll
    for (int d0 = 0; d0 < 8; ++d0) qr[d0] = *reinterpret_cast<const bf16x8*>(Qw + d0 * 16);
    if constexpr (DK == 192) {
#pragma unroll
        for (int d0 = 0; d0 < 4; ++d0) *reinterpret_cast<bf16x8*>(q2 + d0 * 1024) = *reinterpret_cast<const bf16x8*>(Qw + (8 + d0) * 16);
    }
    const int sr = tid >> 4, sc = (tid & 15) * 8, vst0 = v_st(sr, sc), vst1 = v_st(32 + sr, sc);
    const int sr2 = tid >> 3, sc2 = (tid & 7) * 8;
    const int vb0 = (int)(uintptr_t)V_lds + v_rd_base(lane);
    bf16x8 vs0, vs1, ks0, ks1, k2s;
    const int NT = 4 + U.ntl;
#define SLOAD(t) do { const int t_ = (t); const bool cx_ = t_ < 4; const long ro_ = (long)((cx_ ? t_ : t_ - 4) * KVBLK); \
    const bf16_t* kb_ = U.KV + ((cx_ ? U.kc : U.kl) + ro_ * U.ldk); const bf16_t* vb_ = U.KV + ((cx_ ? U.vc : U.vl) + ro_ * U.ldv); \
    vs0 = *reinterpret_cast<const bf16x8*>(vb_ + (long)sr * U.ldv + sc); vs1 = *reinterpret_cast<const bf16x8*>(vb_ + (long)(32 + sr) * U.ldv + sc); \
    ks0 = *reinterpret_cast<const bf16x8*>(kb_ + (long)sr * U.ldk + sc); ks1 = *reinterpret_cast<const bf16x8*>(kb_ + (long)(32 + sr) * U.ldk + sc); \
    if constexpr (DK == 192) { const bf16_t* k2_ = U.K2 + ((cx_ ? U.k2c : U.k2l) + ro_ * U.ldk2); k2s = *reinterpret_cast<const bf16x8*>(k2_ + (long)sr2 * U.ldk2 + sc2); } } while (0)
#define SWRITE(b) do { *(bf16x8*)(V_lds + (b) * SHM_V + vst0) = vs0; *(bf16x8*)(V_lds + (b) * SHM_V + vst1) = vs1; const int kc_ = sc * 2; \
    *(bf16x8*)(K_lds + (b) * SHM_K + KSWZ(sr, kc_)) = ks0; *(bf16x8*)(K_lds + (b) * SHM_K + KSWZ(32 + sr, kc_)) = ks1; \
    if constexpr (DK == 192) { *(bf16x8*)(K2_lds + (b) * SHM_K2 + KSWZ2(sr2, sc2 * 2)) = k2s; } } while (0)
#define RESC(a) do { if (__any((a) < 1.f)) { if (hi == 0) al_l[r32] = (a); asm volatile("s_waitcnt lgkmcnt(0)" ::: "memory"); \
    _Pragma("unroll") for (int d = 0; d < 4; ++d) _Pragma("unroll") for (int r = 0; r < 16; ++r) o[d][r] *= al_l[crow(r, hi)]; } } while (0)
#define WMASK(P0, P1, t) do { if constexpr (WINDOW) { if ((t) >= 4) wmask(P0, P1, U.qk_off + ((t) - 4) * KVBLK - wid * QBLK - r32, hi); } } while (0)
    f32x16 pA0, pA1, pB0, pB1; float mnA, mnB, alA, alB; bf16x8 pa0, pa1, pa2, pa3;
    SLOAD(0); asm volatile("s_waitcnt vmcnt(0)" ::: "memory"); SWRITE(0); __syncthreads();
    qkt<DK>(pA0, pA1, K_lds, K2_lds, qr, q2, r32, hi); partialSM<DK>(pA0, pA1, m_reg, mnA, alA);
    SLOAD(1);
    asm volatile("s_waitcnt vmcnt(0)" ::: "memory"); SWRITE(1); __syncthreads();
    for (int j = 1; j + 1 < NT; j += 2) {
        SBAR(); qkt<DK>(pB0, pB1, K_lds + SHM_K, K2_lds + SHM_K2, qr, q2, r32, hi); WMASK(pB0, pB1, j);
        finishSM(pA0, pA1, alA, l_reg, pa0, pa1, pa2, pa3); SBAR();
        SLOAD(j + 1); SBAR();
        pv_d0(o, vb0, pa0, pa1, pa2, pa3); partialSM<DK>(pB0, pB1, m_reg, mnB, alB);
        __syncthreads(); asm volatile("s_waitcnt vmcnt(0)" ::: "memory"); SWRITE(0);
        RESC(alB); __syncthreads();
        SBAR(); qkt<DK>(pA0, pA1, K_lds, K2_lds, qr, q2, r32, hi); WMASK(pA0, pA1, j + 1);
        finishSM(pB0, pB1, alB, l_reg, pa0, pa1, pa2, pa3); SBAR();
        SLOAD(j + 2); SBAR();
        pv_d0(o, vb0 + SHM_V, pa0, pa1, pa2, pa3); partialSM<DK>(pA0, pA1, m_reg, mnA, alA);
        __syncthreads(); asm volatile("s_waitcnt vmcnt(0)" ::: "memory"); SWRITE(1);
        RESC(alA); __syncthreads();
    }
    SBAR(); qkt<DK>(pB0, pB1, K_lds + SHM_K, K2_lds + SHM_K2, qr, q2, r32, hi); WMASK(pB0, pB1, NT - 1);
    finishSM(pA0, pA1, alA, l_reg, pa0, pa1, pa2, pa3); SBAR();
    pv_d0(o, vb0, pa0, pa1, pa2, pa3); partialSM<DK>(pB0, pB1, m_reg, mnB, alB);
    __syncthreads(); RESC(alB);
    finishSM(pB0, pB1, alB, l_reg, pa0, pa1, pa2, pa3); SBAR();
    pv_d0(o, vb0 + SHM_V, pa0, pa1, pa2, pa3);
    l_reg += __builtin_amdgcn_exp2f(U.sink * 1.4426950408889634f - m_reg * C);
    if (hi == 0) li_l[r32] = l_reg; asm volatile("s_waitcnt lgkmcnt(0)" ::: "memory");
    float rli[16];
#pragma unroll
    for (int r = 0; r < 16; ++r) rli[r] = __builtin_amdgcn_rcpf(li_l[crow(r, hi)]);
    __syncthreads();
    bf16_t* stg = (bf16_t*)(lds + wid * 8192);
#pragma unroll
    for (int r = 0; r < 16; ++r) { const int orow = crow(r, hi);
#pragma unroll
        for (int d0 = 0; d0 < 4; ++d0) { const float v = o[d0][r] * rli[r]; stg[orow * 128 + d0 * 32 + r32] = (bf16_t)(cvtpk(v, v) & 0xffffu); } }
    asm volatile("s_waitcnt lgkmcnt(0)" ::: "memory");
    bf16_t* Ow = U.O + (size_t)(wid * QBLK) * U.ldo;
#pragma unroll
    for (int i = 0; i < 8; ++i) { const int row = i * 4 + (lane >> 4), ch = lane & 15; const u32x4 v = *(const u32x4*)(stg + row * 128 + ch * 8); *(u32x4*)(Ow + (size_t)row * U.ldo + ch * 8) = v; }
    __syncthreads();
#undef SLOAD
#undef SWRITE
#undef RESC
#undef WMASK
}
#undef KSWZ
#undef KSWZ2
#undef SBAR
}

namespace mk {
constexpr int NWAVES = 8;
constexpr int D = 2048, SEQ = 4096, LCTX = 256, NL = 8192, NC = 512, NR = 8704, DEPTH = 4;
constexpr int DIN = 3392, NIN = 3584  , DFF = 5632;
constexpr int O_AQ = 0, O_AK = 768, O_AV = 1024, O_BQ = 1280, O_BK = 2048, O_BV = 2304, O_CQ = 2560, O_CKV = 3072, O_CKR = 3328;
constexpr float EPS = 1e-6f;
typedef unsigned short bf16;
typedef float f32x4 __attribute__((ext_vector_type(4)));
typedef float f32x2 __attribute__((ext_vector_type(2)));
typedef unsigned u32x4v __attribute__((ext_vector_type(4)));
typedef unsigned u32x2v __attribute__((ext_vector_type(2)));

constexpr size_t MiB = 1u << 20;
constexpr size_t WS_CTL = 0, CTL_ZERO_BYTES = 1 * MiB;
constexpr size_t WS_MODV = 2 * MiB;
constexpr size_t WS_COMB = 3 * MiB;
constexpr size_t WS_TAB128 = 4 * MiB, WS_TAB64 = 4 * MiB + 16384;
constexpr size_t WS_SSQ = 5 * MiB;
constexpr size_t WS_W = 8 * MiB;
constexpr size_t W_IN = 0, W_UQ = W_IN + (size_t)NIN * D * 2, W_UKV = W_UQ + (size_t)768 * 512 * 2, W_OUT = W_UKV + (size_t)1024 * 256 * 2,
                 W_13 = W_OUT + (size_t)D * D * 2, W_2 = W_13 + (size_t)2 * DFF * D * 2, W_LAYER = W_2 + (size_t)D * DFF * 2;
constexpr size_t WS_X = WS_W + DEPTH * W_LAYER;
constexpr size_t WS_H = WS_X + (size_t)NR * D * 4;
constexpr size_t WS_P = WS_H + (size_t)NR * D * 2;
constexpr size_t WS_QC = WS_P + (size_t)NR * NIN * 2;
constexpr size_t WS_KVC = WS_QC + (size_t)NR * 768 * 2;
constexpr size_t WS_CAT = WS_KVC + (size_t)NR * 1024 * 2;
constexpr size_t WS_OF = WS_CAT + (size_t)NR * D * 2;
constexpr size_t WS_U = WS_OF + (size_t)NR * D * 2;
constexpr size_t WS_END = WS_U + (size_t)NR * DFF * 2;
static_assert(W_LAYER % 256 == 0 && WS_X % 256 == 0, "alignment");
constexpr int CW_BAR = 4096;
constexpr int CW_CONVQ = 8192;
constexpr int CW_ATTQ = 8192 + 64;

constexpr int RING_BYTES = 131072, LDSCTL_OFF = RING_BYTES, MISC_OFF = LDSCTL_OFF + 320, LDS_BYTES = 147456;

#define GAS __attribute__((address_space(1)))
#define LAS __attribute__((address_space(3)))
#define LDS_WAIT() asm volatile("s_waitcnt lgkmcnt(0)" ::: "memory")
#define VM_WAIT() asm volatile("s_waitcnt vmcnt(0)" ::: "memory")
__device__ __forceinline__ unsigned cvtpk(float lo, float hi) { unsigned r; asm volatile("v_cvt_pk_bf16_f32 %0, %1, %2" : "=v"(r) : "v"(lo), "v"(hi)); return r; }
__device__ __forceinline__ float bf_lo(unsigned w) { return __uint_as_float(w << 16); }
__device__ __forceinline__ float bf_hi(unsigned w) { return __uint_as_float(w & 0xffff0000u); }

#define XB_TMO      128
#define XB_XCNT(j)  (256  + 64 * (j))
#define XB_XSUB(j)  (1280 + 64 * (j))
#define XB_XGEN(j)  (2304 + 64 * (j))
#define XB_TOP      3328
#define XB_TOPGEN   3392
#define XCD_BAR_WORDS 3456
#define XB_SPIN_CAP (1u << 18)
__device__ __forceinline__ unsigned xb_ld(unsigned* p)              { return __hip_atomic_load(p, __ATOMIC_RELAXED, __HIP_MEMORY_SCOPE_AGENT); }
__device__ __forceinline__ unsigned xb_add(unsigned* p, unsigned v) { return __hip_atomic_fetch_add(p, v, __ATOMIC_RELAXED, __HIP_MEMORY_SCOPE_AGENT); }
__device__ __forceinline__ unsigned xb_xcc_id() { return (unsigned)__builtin_amdgcn_s_getreg((3 << 11) | 20) & 0xFu; }
#define XB_SPIN(cond, bar) do { unsigned _sp = 0; while (cond) { __builtin_amdgcn_s_sleep(1); \
    if ((++_sp & 255u) == 0u) { if (xb_ld(&(bar)[XB_TMO])) break; if (_sp > XB_SPIN_CAP) { atomicAdd(&(bar)[XB_TMO], 1u); break; } } } } while (0)
struct XcdBarrier { unsigned* bar; unsigned x; volatile LAS unsigned* st; };
__device__ __forceinline__ XcdBarrier xcd_barrier_post(unsigned* bar, volatile LAS unsigned* st) {
    XcdBarrier b; b.bar = bar; b.x = xb_xcc_id(); b.st = st;
    if (threadIdx.x == 0) (void)xb_add(&bar[XB_XCNT(b.x)], 1u);
    return b;
}
__device__ __forceinline__ void xcd_barrier_complete(unsigned* bar, unsigned x, unsigned& nloc, unsigned& nx) {
    const unsigned G = gridDim.x * gridDim.y * gridDim.z;
    unsigned sum, cnt, mine, sp = 0u;
    for (;;) {
        sum = 0u; cnt = 0u; mine = 0u;
#pragma unroll
        for (unsigned j = 0; j < 16; ++j) { const unsigned c = xb_ld(&bar[XB_XCNT(j)]); sum += c; cnt += (c > 0u) ? 1u : 0u; mine = (j == x) ? c : mine; }
        if (sum == G) break;
        __builtin_amdgcn_s_sleep(1);
        if ((++sp & 255u) == 0u) { if (xb_ld(&bar[XB_TMO])) break; if (sp > XB_SPIN_CAP) { atomicAdd(&bar[XB_TMO], 1u); break; } }
    }
    nloc = mine > 0u ? mine : 1u; nx = cnt > 0u ? cnt : 1u;
}
__device__ __forceinline__ void xcd_barrier(const XcdBarrier& b) {
    asm volatile("s_waitcnt vmcnt(0)" ::: "memory");
    __syncthreads();
    if (threadIdx.x == 0) {
        unsigned* bar = b.bar;
        __builtin_amdgcn_s_waitcnt(0);
        unsigned nloc = b.st[0], nx = b.st[1];
        if (nloc == 0u) { xcd_barrier_complete(bar, b.x, nloc, nx); b.st[0] = nloc; b.st[1] = nx; }
        const unsigned old = xb_add(&bar[XB_XSUB(b.x)], 1u);
        const unsigned gen = old / nloc;
        if (old + 1u == (gen + 1u) * nloc) {
            __builtin_amdgcn_fence(__ATOMIC_RELEASE, "agent");
            asm volatile("s_waitcnt vmcnt(0)" ::: "memory");
            const unsigned og = xb_add(&bar[XB_TOP], 1u);
            const unsigned tg = og / nx;
            if (og + 1u == (tg + 1u) * nx) xb_add(&bar[XB_TOPGEN], 1u);
            else XB_SPIN(xb_ld(&bar[XB_TOPGEN]) == tg, bar);
            __builtin_amdgcn_fence(__ATOMIC_ACQUIRE, "agent");
            xb_add(&bar[XB_XGEN(b.x)], 1u);
            asm volatile("s_waitcnt vmcnt(0)" ::: "memory");
        } else {
            XB_SPIN(xb_ld(&bar[XB_XGEN(b.x)]) == gen, bar);
            __builtin_amdgcn_fence(__ATOMIC_ACQUIRE, "agent");
            asm volatile("s_waitcnt vmcnt(0)" ::: "memory");
        }
    }
    __syncthreads();
}

struct Args { const float* in[22]; float* out; unsigned char* ws; int ph_lo, ph_hi; };
enum { I_X = 0, I_C, I_CTX, I_CCTX, I_WMOD, I_BMOD, I_GMIXPRE, I_GMIXPOST, I_GFFNPRE, I_GFFNPOST, I_WIN, I_SINK, I_GQN, I_GKN, I_GCQ, I_WUQ, I_GCKV, I_WUKV, I_WOUT, I_W1, I_W3, I_W2 };

__device__ __forceinline__ float wave_sum(float v) {
#pragma unroll
    for (int o = 1; o < 64; o <<= 1) v += __shfl_xor(v, o);
    return v;
}
__device__ __forceinline__ int row_s(int r) { return r < NL ? (r >> 12) : 2; }

__device__ __forceinline__ void transpose_item(const float* W, int N, int k0, int n0, bf16* WTrow0, int ldt, const float* kgain, LAS float* scr, int lane) {
#pragma unroll 8
    for (int i = 0; i < 32; ++i) { const int kk = 2 * i + (lane >> 5); float v = W[(size_t)(k0 + kk) * N + n0 + (lane & 31)]; if (kgain) v *= kgain[k0 + kk]; scr[kk * 33 + (lane & 31)] = v; }
    LDS_WAIT(); asm volatile("" ::: "memory");
    const int c = lane & 7;
#pragma unroll
    for (int j = 0; j < 4; ++j) { const int n = (lane >> 3) + 8 * j; const LAS float* s = scr + (8 * c) * 33 + n;
        u32x4v o; o.x = cvtpk(s[0 * 33], s[1 * 33]); o.y = cvtpk(s[2 * 33], s[3 * 33]); o.z = cvtpk(s[4 * 33], s[5 * 33]); o.w = cvtpk(s[6 * 33], s[7 * 33]);
        *(u32x4v*)(WTrow0 + (size_t)n * ldt + k0 + 8 * c) = o; }
    LDS_WAIT(); asm volatile("" ::: "memory");
}
constexpr int IT_IN = (D / 64) * (DIN / 32), IT_UQ = (512 / 64) * (768 / 32), IT_UKV = (256 / 64) * (1024 / 32), IT_OUT = (D / 64) * (D / 32), IT_1 = (D / 64) * (DFF / 32), IT_2 = (DFF / 64) * (D / 32);
constexpr int IT_LAYER = IT_IN + IT_UQ + IT_UKV + IT_OUT + 2 * IT_1 + IT_2, IT_ALL = DEPTH * IT_LAYER;
__device__ __forceinline__ void conv_item(const Args& a, int it, LAS float* scr, int lane) {
    const int l = it / IT_LAYER; int r = it % IT_LAYER;
    unsigned char* wl = a.ws + WS_W + (size_t)l * W_LAYER;
    if (r < IT_IN)  { const int nb = DIN / 32, kb = r / nb, n0 = (r % nb) * 32; transpose_item(a.in[I_WIN] + (size_t)l * D * DIN, DIN, kb * 64, n0, (bf16*)(wl + W_IN) + (size_t)n0 * D, D, nullptr, scr, lane); return; } r -= IT_IN;
    if (r < IT_UQ)  { const int nb = 768 / 32, kb = r / nb, n0 = (r % nb) * 32; transpose_item(a.in[I_WUQ] + (size_t)l * 512 * 768, 768, kb * 64, n0, (bf16*)(wl + W_UQ) + (size_t)n0 * 512, 512, a.in[I_GCQ] + l * 512, scr, lane); return; } r -= IT_UQ;
    if (r < IT_UKV) { const int nb = 1024 / 32, kb = r / nb, n0 = (r % nb) * 32; transpose_item(a.in[I_WUKV] + (size_t)l * 256 * 1024, 1024, kb * 64, n0, (bf16*)(wl + W_UKV) + (size_t)n0 * 256, 256, a.in[I_GCKV] + l * 256, scr, lane); return; } r -= IT_UKV;
    if (r < IT_OUT) { const int nb = D / 32, kb = r / nb, n0 = (r % nb) * 32; transpose_item(a.in[I_WOUT] + (size_t)l * D * D, D, kb * 64, n0, (bf16*)(wl + W_OUT) + (size_t)n0 * D, D, nullptr, scr, lane); return; } r -= IT_OUT;
    if (r < 2 * IT_1) { const int which = r / IT_1; r %= IT_1; const int nb = DFF / 32, kb = r / nb, n0 = (r % nb) * 32;
        const int drow = (n0 / 128) * 256 + which * 128 + (n0 % 128);
        transpose_item(a.in[which ? I_W3 : I_W1] + (size_t)l * D * DFF, DFF, kb * 64, n0, (bf16*)(wl + W_13) + (size_t)drow * D, D, nullptr, scr, lane); return; } r -= 2 * IT_1;
    { const int nb = D / 32, kb = r / nb, n0 = (r % nb) * 32; transpose_item(a.in[I_W2] + (size_t)l * DFF * D, D, kb * 64, n0, (bf16*)(wl + W_2) + (size_t)n0 * DFF, DFF, nullptr, scr, lane); }
}
__device__ __forceinline__ void mod_unit(const Args& a, int u, LAS unsigned char* lds, int tid, int wave, int lane) {
    const int l = u / 48, nc = u % 48;
    LAS float* sc = (LAS float*)lds;
    LAS float* red = (LAS float*)(lds + 24576);
    for (int i = tid; i < 3 * D; i += NWAVES * 64) { const int s = i / D, k = i % D; const float v = s < 2 ? a.in[I_C][s * D + k] : a.in[I_CCTX][k]; sc[i] = v / (1.f + expf(-v)); }
    LDS_WAIT(); __syncthreads();
    const float* w = a.in[I_WMOD] + (size_t)l * D * 6 * D + (size_t)(wave * 256) * 6 * D + nc * 256 + lane * 4;
    f32x4 a0 = {0.f, 0.f, 0.f, 0.f}, a1 = a0, a2 = a0;
    for (int k = 0; k < 256; k += 8) {
        f32x4 wv[8];
#pragma unroll
        for (int j = 0; j < 8; ++j) wv[j] = *(const f32x4*)(w + (size_t)(k + j) * 6 * D);
#pragma unroll
        for (int j = 0; j < 8; ++j) { const int kk = wave * 256 + k + j; a0 += wv[j] * sc[kk]; a1 += wv[j] * sc[D + kk]; a2 += wv[j] * sc[2 * D + kk]; }
    }
    *(LAS f32x4*)(red + (wave * 3 + 0) * 256 + lane * 4) = a0; *(LAS f32x4*)(red + (wave * 3 + 1) * 256 + lane * 4) = a1; *(LAS f32x4*)(red + (wave * 3 + 2) * 256 + lane * 4) = a2;
    LDS_WAIT(); __syncthreads();
    for (int i = tid; i < 768; i += NWAVES * 64) { const int s = i >> 8, cidx = i & 255; float v = 0.f;
#pragma unroll
        for (int wv = 0; wv < 8; ++wv) v += red[(wv * 3 + s) * 256 + cidx];
        ((float*)(a.ws + WS_MODV))[(size_t)(l * 3 + s) * 6 * D + nc * 256 + cidx] = v + a.in[I_BMOD][l * 6 * D + nc * 256 + cidx]; }
    LDS_WAIT(); __syncthreads();
}

struct RowF { f32x4 v[8]; };
__device__ __forceinline__ void ld_row_f32(RowF& r, const float* p, int lane) {
#pragma unroll
    for (int j = 0; j < 8; ++j) r.v[j] = *(const f32x4*)(p + 4 * lane + 256 * j);
}
__device__ __forceinline__ void ld_row_bf16(RowF& r, const bf16* p, int lane) {
#pragma unroll
    for (int j = 0; j < 8; ++j) { const u32x2v w = *(const u32x2v*)(p + 4 * lane + 256 * j); r.v[j] = (f32x4){bf_lo(w.x), bf_hi(w.x), bf_lo(w.y), bf_hi(w.y)}; }
}
__device__ __forceinline__ float row_ssq(const RowF& r) {
    float s = 0.f;
#pragma unroll
    for (int j = 0; j < 8; ++j) s += (r.v[j][0] * r.v[j][0] + r.v[j][1] * r.v[j][1]) + (r.v[j][2] * r.v[j][2] + r.v[j][3] * r.v[j][3]);
    return wave_sum(s);
}
__device__ __forceinline__ void st_row_bf16(bf16* p, const RowF& r, int lane) {
#pragma unroll
    for (int j = 0; j < 8; ++j) { u32x2v w; w.x = cvtpk(r.v[j][0], r.v[j][1]); w.y = cvtpk(r.v[j][2], r.v[j][3]); *(u32x2v*)(p + 4 * lane + 256 * j) = w; }
}
__device__ __forceinline__ void st_row_f32(float* p, const RowF& r, int lane) {
#pragma unroll
    for (int j = 0; j < 8; ++j) *(f32x4*)(p + 4 * lane + 256 * j) = r.v[j];
}
__device__ __forceinline__ const float* comb_vec(const Args& a, int l, int s, int q) { return (const float*)(a.ws + WS_COMB) + ((size_t)(l * 3 + s) * 6 + q) * D; }

__device__ __forceinline__ void resid_norm_row(const float* xin, float* xout, const bf16* y, const float* G, const float* A, const float* Bv, bf16* h, int lane) {
    RowF x, t; ld_row_f32(x, xin, lane); ld_row_bf16(t, y, lane);
    const float rstd_y = rsqrtf(row_ssq(t) * (1.f / D) + EPS);
    RowF g; ld_row_f32(g, G, lane);
#pragma unroll
    for (int j = 0; j < 8; ++j) x.v[j] += g.v[j] * (t.v[j] * rstd_y);
    st_row_f32(xout, x, lane);
    if (h) {
        const float rstd_x = rsqrtf(row_ssq(x) * (1.f / D) + EPS);
        ld_row_f32(g, A, lane); ld_row_f32(t, Bv, lane);
#pragma unroll
        for (int j = 0; j < 8; ++j) x.v[j] = (x.v[j] * rstd_x) * g.v[j] + t.v[j];
        st_row_bf16(h, x, lane);
    }
}

__device__ __forceinline__ void post_row(bf16* prow_, int r, const float* tab128, const float* tab64, const f32x4 gq, const f32x4 gk, int lane) {
    const bool lat = r < NL; const int t = r & 4095, pr = t >> 6, pc = t & 63;
    const int hl = lane & 31, half = hl >> 4, q = hl & 15, i0 = 4 * (q & 7);
    const int pos = half ? pc : pr;
    f32x4 cs = {1.f, 1.f, 1.f, 1.f}, sn = {0.f, 0.f, 0.f, 0.f};
    if (lat) { const f32x4 t0 = *(const f32x4*)(tab128 + (size_t)(pos * 32 + i0) * 2), t1 = *(const f32x4*)(tab128 + (size_t)(pos * 32 + i0) * 2 + 4);
        cs = (f32x4){t0[0], t0[2], t1[0], t1[2]}; sn = (f32x4){t0[1], t0[3], t1[1], t1[3]}; }
    const bool first = q < 8;
#pragma unroll
    for (int sgi = 0; sgi < 8; ++sgi) {
        const int col = sgi < 3 ? O_AQ + 256 * sgi : sgi == 3 ? O_AK : sgi < 7 ? O_BQ + 256 * (sgi - 4) : O_BK;
        const bool isB = sgi >= 4; const f32x4 gg = sgi == 7 ? gk : gq;
        bf16* p = prow_ + col + 4 * lane;
        const u32x2v w = *(const u32x2v*)p;
        f32x4 v = {bf_lo(w.x), bf_hi(w.x), bf_lo(w.y), bf_hi(w.y)};
        if (isB) { float ss = (v[0] * v[0] + v[1] * v[1]) + (v[2] * v[2] + v[3] * v[3]);
            ss += __shfl_xor(ss, 1); ss += __shfl_xor(ss, 2); ss += __shfl_xor(ss, 4); ss += __shfl_xor(ss, 8); ss += __shfl_xor(ss, 16);
            v = v * rsqrtf(ss * (1.f / 128.f) + EPS) * gg; }
        f32x4 pv; pv[0] = __shfl_xor(v[0], 8); pv[1] = __shfl_xor(v[1], 8); pv[2] = __shfl_xor(v[2], 8); pv[3] = __shfl_xor(v[3], 8);
        const f32x4 o = first ? v * cs - pv * sn : v * cs + pv * sn;
        u32x2v ow; ow.x = cvtpk(o[0], o[1]); ow.y = cvtpk(o[2], o[3]);
        if (lat || isB) *(u32x2v*)p = ow;
    }
    if (lat) {
        const int l16 = lane & 15, h2 = l16 >> 3, q2 = l16 & 7, j0 = 4 * (q2 & 3); const int pos2 = h2 ? pc : pr;
        const f32x4 t0 = *(const f32x4*)(tab64 + (size_t)(pos2 * 16 + j0) * 2), t1 = *(const f32x4*)(tab64 + (size_t)(pos2 * 16 + j0) * 2 + 4);
        const f32x4 c2 = {t0[0], t0[2], t1[0], t1[2]}, s2 = {t0[1], t0[3], t1[1], t1[3]};
        bf16* p = prow_ + O_CKR + 4 * l16;
        const u32x2v w = *(const u32x2v*)p;
        const f32x4 v = {bf_lo(w.x), bf_hi(w.x), bf_lo(w.y), bf_hi(w.y)};
        f32x4 pv; pv[0] = __shfl_xor(v[0], 4); pv[1] = __shfl_xor(v[1], 4); pv[2] = __shfl_xor(v[2], 4); pv[3] = __shfl_xor(v[3], 4);
        const f32x4 o = (q2 < 4) ? v * c2 - pv * s2 : v * c2 + pv * s2;
        u32x2v ow; ow.x = cvtpk(o[0], o[1]); ow.y = cvtpk(o[2], o[3]);
        if (lane < 16) *(u32x2v*)p = ow;
    }
}

constexpr int AI_C = 128, AI_B = 192, AI_A = 192, AI_LAT = AI_C + AI_B + AI_A, AI_CC = 8, AI_BC = 12, AI_AC = 12, AI_ALL = AI_LAT + AI_CC + AI_BC + AI_AC;
__device__ __forceinline__ at::AUnit attn_item_unit(int it, int& body, const Args& a, const float* sink) {
    const bf16* P = (const bf16*)(a.ws + WS_P); const bf16* QC = (const bf16*)(a.ws + WS_QC); const bf16* KVC = (const bf16*)(a.ws + WS_KVC); bf16* CAT = (bf16*)(a.ws + WS_CAT);
    const int seg = it < AI_C ? 0 : it < AI_C + AI_B ? 1 : it < AI_LAT ? 2 : it < AI_LAT + AI_CC ? 3 : it < AI_LAT + AI_CC + AI_BC ? 4 : 5;
    const int j = it - (seg == 0 ? 0 : seg == 1 ? AI_C : seg == 2 ? AI_C + AI_B : seg == 3 ? AI_LAT : seg == 4 ? AI_LAT + AI_CC : AI_LAT + AI_CC + AI_BC);
    const int kind = (seg == 0 || seg == 3) ? 2 : (seg == 1 || seg == 4) ? 1 : 0; const bool cq = seg >= 3;
    const int nh = kind == 2 ? 4 : 6;
    const int b = cq ? j / nh : j / (16 * nh), h = cq ? j % nh : (j / 16) % nh, qb = cq ? 0 : (j & 15);
    const long qrow = cq ? (long)(NL + b * LCTX) : (long)(b * SEQ + qb * 256), crow0 = (long)(NL + b * LCTX), lrow0 = (long)b * SEQ;
    const bool win = kind == 0 && !cq;
    int wlo = qb * 256 - 128, whi = qb * 256 + 384; wlo = wlo < 0 ? 0 : wlo; whi = whi > SEQ ? SEQ : whi;
    const long llo = win ? (long)wlo : 0;
    const int g = h / 3, oq = kind == 0 ? O_AQ : O_BQ, ok = kind == 0 ? O_AK : O_BK, ov = kind == 0 ? O_AV : O_BV;
    at::AUnit U;
    U.Q = kind == 2 ? QC + qrow * 768 + h * 192 : P + qrow * NIN + oq + h * 128; U.ldq = kind == 2 ? 768 : NIN;
    U.KV = kind == 2 ? KVC : P; U.K2 = P;
    U.ldk = kind == 2 ? 1024 : NIN; U.ldv = U.ldk; U.ldk2 = NIN; U.ldo = D;
    U.kc = kind == 2 ? crow0 * 1024 + h * 256 : crow0 * NIN + ok + g * 128;
    U.kl = kind == 2 ? lrow0 * 1024 + h * 256 : (lrow0 + llo) * NIN + ok + g * 128;
    U.vc = kind == 2 ? U.kc + 128 : crow0 * NIN + ov + g * 128;
    U.vl = kind == 2 ? U.kl + 128 : (lrow0 + llo) * NIN + ov + g * 128;
    U.k2c = crow0 * NIN + O_CKR; U.k2l = lrow0 * NIN + O_CKR;
    U.O = CAT + qrow * D + (kind == 0 ? 0 : kind == 1 ? 768 : 1536) + h * 128;
    U.ntl = cq ? 0 : win ? (whi - wlo) / 64 : SEQ / 64;
    U.qk_off = win ? wlo - qb * 256 : 0;
    U.sink = kind == 0 ? sink[h] : -__builtin_inff();
    body = kind == 2 ? 2 : win ? 1 : 0;
    return U;
}

constexpr int N_PHASES = 2 + 8 * DEPTH;
#ifndef PHMASK
#define PHMASK 0x3ff
#endif
#define PHON(j) ((PHMASK >> (j)) & 1)
#ifndef SUBSEL
#define SUBSEL 7
#endif
__global__ void __launch_bounds__(NWAVES * 64, 2) fwd(Args args) {
    extern __shared__ __attribute__((aligned(16))) unsigned char lds[];
    LAS unsigned char* L = (LAS unsigned char*)lds;
    volatile LAS unsigned* MISC = (volatile LAS unsigned*)(L + MISC_OFF);
    const int tid = threadIdx.x, lane = tid & 63, wave = __builtin_amdgcn_readfirstlane(tid >> 6);
    const int G = gridDim.x, bx = blockIdx.x, vcu = (G % 8 == 0) ? (bx % 8) * (G / 8) + bx / 8 : bx;
    const int gw = vcu * NWAVES + wave, NGW = G * NWAVES;
    unsigned* ctl = (unsigned*)(args.ws + WS_CTL);
    for (int u = tid; u < (LDS_BYTES - LDSCTL_OFF) / 4; u += NWAVES * 64) ((LAS unsigned*)(L + LDSCTL_OFF))[u] = 0u;
    __syncthreads();
    const int lo = args.ph_lo, hi = args.ph_hi;
    const bool multi = hi - lo > 1;
    XcdBarrier bar; bar.bar = ctl + CW_BAR; bar.x = 0; bar.st = nullptr;
    if (multi) bar = xcd_barrier_post(ctl + CW_BAR, MISC + 8);
#define IN(k) (lo <= (k) && (k) < hi)
#define SEAM(k) do { if (IN(k) && IN((k) + 1)) xcd_barrier(bar); } while (0)
    unsigned char* ws = args.ws;
    float* X = (float*)(ws + WS_X); bf16* H = (bf16*)(ws + WS_H); bf16* P = (bf16*)(ws + WS_P); bf16* QC = (bf16*)(ws + WS_QC); bf16* KVC = (bf16*)(ws + WS_KVC);
    bf16* CAT = (bf16*)(ws + WS_CAT); bf16* OF = (bf16*)(ws + WS_OF); bf16* U = (bf16*)(ws + WS_U); float* SSQ = (float*)(ws + WS_SSQ);
    const float* tab128 = (const float*)(ws + WS_TAB128); const float* tab64 = (const float*)(ws + WS_TAB64);

    if (PHON(0) && IN(0)) {
        { const int gid = bx * NWAVES * 64 + tid;
          if (gid < 64 * 32) { const int pos = gid >> 5, i = gid & 31; const float ang = (float)pos * powf(10000.f, -(float)i / 32.f); ((float*)(ws + WS_TAB128))[2 * gid] = cosf(ang); ((float*)(ws + WS_TAB128))[2 * gid + 1] = sinf(ang); }
          else if (gid < 64 * 32 + 64 * 16) { const int e = gid - 64 * 32, pos = e >> 4, i = e & 15; const float ang = (float)pos * powf(10000.f, -(float)i / 16.f); ((float*)(ws + WS_TAB64))[2 * e] = cosf(ang); ((float*)(ws + WS_TAB64))[2 * e + 1] = sinf(ang); } }
        for (int i = gw * 64 + lane; i < DEPTH * (NIN - DIN) * D / 8; i += NGW * 64) { const int l = i / ((NIN - DIN) * D / 8), e = i % ((NIN - DIN) * D / 8);
            *(u32x4v*)((bf16*)(ws + WS_W + (size_t)l * W_LAYER + W_IN) + (size_t)DIN * D + (size_t)e * 8) = (u32x4v){0u, 0u, 0u, 0u}; }
        for (int u = bx; u < 192; u += G) mod_unit(args, u, L, tid, wave, lane);
        LAS float* scr = (LAS float*)(L + wave * 16384);
        for (;;) {
            int base = 0; if (lane == 0) base = (int)atomicAdd(ctl + CW_CONVQ, 16u);
            base = __builtin_amdgcn_readfirstlane(base);
            if (base >= IT_ALL) break;
            for (int it = base; it < base + 16 && it < IT_ALL; ++it) conv_item(args, it, scr, lane);
        }
    }
    SEAM(0);
    if (PHON(1) && IN(1)) {
        const float* modv = (const float*)(ws + WS_MODV); float* comb = (float*)(ws + WS_COMB);
        for (int i = bx * NWAVES * 64 + tid; i < DEPTH * 3 * D; i += G * NWAVES * 64) { const int l = i / (3 * D), s = (i / D) % 3, c = i % D;
            const float* m = modv + (size_t)(l * 3 + s) * 6 * D; float* o = comb + (size_t)(l * 3 + s) * 6 * D + c;
            o[0 * D] = m[2 * D + c] * args.in[I_GMIXPOST][l * D + c]; o[1 * D] = args.in[I_GFFNPRE][l * D + c] * (1.f + m[4 * D + c]); o[2 * D] = m[3 * D + c];
            o[3 * D] = m[5 * D + c] * args.in[I_GFFNPOST][l * D + c]; o[4 * D] = args.in[I_GMIXPRE][l * D + c] * (1.f + m[1 * D + c]); o[5 * D] = m[0 * D + c]; }
        for (int r = gw; r < NR; r += NGW) { const int s = row_s(r);
            const float* xin = r < NL ? args.in[I_X] + (size_t)r * D : args.in[I_CTX] + (size_t)(r - NL) * D;
            RowF x; ld_row_f32(x, xin, lane);
            const float rstd = rsqrtf(row_ssq(x) * (1.f / D) + EPS);
            const float* m = modv + (size_t)s * 6 * D;
            RowF g, sc, sh; ld_row_f32(g, args.in[I_GMIXPRE], lane); ld_row_f32(sc, m + D, lane); ld_row_f32(sh, m, lane);
#pragma unroll
            for (int j = 0; j < 8; ++j) x.v[j] = (x.v[j] * rstd) * g.v[j] * (1.f + sc.v[j]) + sh.v[j];
            st_row_bf16(H + (size_t)r * D, x, lane); }
    }
    SEAM(1);
    for (int l = 0; l < DEPTH; ++l) {
        const int pb = 2 + 8 * l; const bool last = l == DEPTH - 1;
        const unsigned char* wl = ws + WS_W + (size_t)l * W_LAYER;
        const int Mrows = last ? NL : NR;
        if (PHON(2) && IN(pb + 0)) {
            pg8::Gemm g{H, (const bf16*)(wl + W_IN), NR, NIN, D, D}; pg8::StaticOrder S; S.init(NR, NIN, G, bx);
            pg8::EpiIn E{P, NIN, SSQ};
            pg8::gemm_phase<pg8::EpiIn, pg8::StaticOrder, true>(L, g, S, E);
        }
        SEAM(pb + 0);
        if (PHON(3) && IN(pb + 1)) {
            { pg8::OffsetOrder S; S.init(NR, 768, bx, 0);
              if ((SUBSEL & 1) && S.has()) { pg8::Gemm g{P + O_CQ, (const bf16*)(wl + W_UQ), NR, 768, 512, NIN}; pg8::EpiUq E{QC, SSQ, tab64}; pg8::gemm_phase<pg8::EpiUq, pg8::OffsetOrder, false>(L, g, S, E); } }
            { pg8::OffsetOrder S; S.init(NR, 1024, bx, 102);
              if ((SUBSEL & 2) && S.has()) { pg8::Gemm g{P + O_CKV, (const bf16*)(wl + W_UKV), NR, 1024, 256, NIN}; pg8::EpiUkv E{KVC, SSQ}; pg8::gemm_phase<pg8::EpiUkv, pg8::OffsetOrder, false>(L, g, S, E); } }
            int ln = threadIdx.x; asm volatile("" : "+v"(ln)); ln &= 63;
            const f32x4 gq = *(const f32x4*)(args.in[I_GQN] + l * 128 + 4 * (ln & 31)), gk = *(const f32x4*)(args.in[I_GKN] + l * 128 + 4 * (ln & 31));
            if (SUBSEL & 4) for (int r = gw; r < NR; r += NGW) post_row(P + (size_t)r * NIN, r, tab128, tab64, gq, gk, ln);
        }
        SEAM(pb + 1);
        if (PHON(4) && IN(pb + 2)) {
            const int nitems = last ? AI_LAT : AI_ALL;
            for (;;) {
                __syncthreads();
                if (tid == 0) MISC[0] = atomicAdd(ctl + CW_ATTQ + 64 * l, 1u);
                __syncthreads();
                const int it = (int)MISC[0];
                if (it >= nitems) break;
                int kind; const at::AUnit AU = attn_item_unit(it, kind, args, args.in[I_SINK] + l * 6);
                if (kind == 2) { if (SUBSEL & 1) at::attn_unit<192, false>(AU, (char*)lds); }
                else if (kind == 1) { if (SUBSEL & 2) at::attn_unit<128, true>(AU, (char*)lds); }
                else { if (SUBSEL & 4) at::attn_unit<128, false>(AU, (char*)lds); }
            }
        }
        SEAM(pb + 2);
        if (PHON(5) && IN(pb + 3)) {
            pg8::Gemm g{CAT, (const bf16*)(wl + W_OUT), Mrows, D, D, D}; pg8::StaticOrder S; S.init(Mrows, D, G, bx);
            pg8::EpiPlain E{OF, D};
            pg8::gemm_phase<pg8::EpiPlain, pg8::StaticOrder, true>(L, g, S, E);
        }
        SEAM(pb + 3);
        if (PHON(6) && IN(pb + 4)) {
            int ln = threadIdx.x; asm volatile("" : "+v"(ln)); ln &= 63;
            for (int r = gw; r < Mrows; r += NGW) { const int s = row_s(r);
                const float* xin = l == 0 ? (r < NL ? args.in[I_X] + (size_t)r * D : args.in[I_CTX] + (size_t)(r - NL) * D) : X + (size_t)r * D;
                resid_norm_row(xin, X + (size_t)r * D, OF + (size_t)r * D, comb_vec(args, l, s, 0), comb_vec(args, l, s, 1), comb_vec(args, l, s, 2), H + (size_t)r * D, ln); }
        }
        SEAM(pb + 4);
        if (PHON(7) && IN(pb + 5)) {
            pg8::Gemm g{H, (const bf16*)(wl + W_13), Mrows, 2 * DFF, D, D}; pg8::StaticOrder S; S.init(Mrows, 2 * DFF, G, bx);
            pg8::EpiSwiglu E{U, DFF};
            pg8::gemm_phase<pg8::EpiSwiglu, pg8::StaticOrder, true>(L, g, S, E);
        }
        SEAM(pb + 5);
        if (PHON(8) && IN(pb + 6)) {
            pg8::Gemm g{U, (const bf16*)(wl + W_2), Mrows, D, DFF, DFF}; pg8::StaticOrder S; S.init(Mrows, D, G, bx);
            pg8::EpiPlain E{OF, D};
            pg8::gemm_phase<pg8::EpiPlain, pg8::StaticOrder, true>(L, g, S, E);
        }
        SEAM(pb + 6);
        if (PHON(9) && IN(pb + 7)) {
            int ln = threadIdx.x; asm volatile("" : "+v"(ln)); ln &= 63;
            for (int r = gw; r < Mrows; r += NGW) { const int s = row_s(r);
                float* xo = last ? args.out + (size_t)r * D : X + (size_t)r * D;
                resid_norm_row(X + (size_t)r * D, xo, OF + (size_t)r * D, comb_vec(args, l, s, 3), last ? nullptr : comb_vec(args, l + 1, s, 4), last ? nullptr : comb_vec(args, l + 1, s, 5),
                               last ? nullptr : H + (size_t)r * D, ln); }
        }
        SEAM(pb + 7);
    }
#undef IN
#undef SEAM
}

inline int setup() {
    static int grid = 0;
    if (grid == 0) {
        int dev = 0, cus = 0, per_cu = 0;
        if (hipGetDevice(&dev) != hipSuccess || hipDeviceGetAttribute(&cus, hipDeviceAttributeMultiprocessorCount, dev) != hipSuccess) { fprintf(stderr, "mk: device query failed\n"); grid = -1; return -1; }
        if (hipFuncSetAttribute((const void*)fwd, hipFuncAttributeMaxDynamicSharedMemorySize, LDS_BYTES) != hipSuccess) { fprintf(stderr, "mk: hipFuncSetAttribute failed\n"); grid = -1; return -1; }
        if (hipOccupancyMaxActiveBlocksPerMultiprocessor(&per_cu, (const void*)fwd, NWAVES * 64, LDS_BYTES) != hipSuccess || per_cu < 1) fprintf(stderr, "mk: occupancy query says %d\n", per_cu);
        (void)hipGetLastError();
        grid = cus;
    }
    return grid;
}
inline void prep(unsigned char* ws, hipStream_t stream) { (void)hipMemsetAsync(ws + WS_CTL, 0, CTL_ZERO_BYTES, stream); }
inline void run(void* const* d_in, float* d_out, unsigned char* ws, hipStream_t stream, int lo, int hi) {
    const int grid = setup(); if (grid <= 0) return;
    Args a{};
    for (int i = 0; i < 22; ++i) a.in[i] = (const float*)d_in[i];
    a.out = d_out; a.ws = ws; a.ph_lo = lo; a.ph_hi = hi;
    hipLaunchKernelGGL(fwd, dim3(grid), dim3(NWAVES * 64), LDS_BYTES, stream, a);
    const hipError_t le = hipPeekAtLastError();
    if (le != hipSuccess) fprintf(stderr, "mk: launch failed: %s\n", hipGetErrorName(le));
}
}

namespace dbg {
__global__ __launch_bounds__(256) void k_cmp(const float* ref, int ldr, int rgs, const void* opt, int ldo, int ogs, int opt_is_bf16, int rows, int ngroups, int gwid, unsigned* slot) {
    float mr = 0.f, md = 0.f; const size_t n = (size_t)rows * ngroups * gwid;
    for (size_t i = (size_t)blockIdx.x * 256 + threadIdx.x; i < n; i += (size_t)gridDim.x * 256) {
        const int c = (int)(i % gwid), g = (int)((i / gwid) % ngroups); const size_t r = i / ((size_t)gwid * ngroups);
        const float a = ref[r * ldr + (size_t)g * rgs + c];
        float b; if (opt_is_bf16) b = __uint_as_float((unsigned)((const unsigned short*)opt)[r * ldo + (size_t)g * ogs + c] << 16); else b = ((const float*)opt)[r * ldo + (size_t)g * ogs + c];
        float d = fabsf(a - b); if (!(d == d)) d = 3e38f;
        mr = fmaxf(mr, fabsf(a)); md = fmaxf(md, d);
    }
    for (int o = 32; o > 0; o >>= 1) { mr = fmaxf(mr, __shfl_xor(mr, o)); md = fmaxf(md, __shfl_xor(md, o)); }
    if ((threadIdx.x & 63) == 0) { atomicMax(slot, __float_as_uint(mr)); atomicMax(slot + 1, __float_as_uint(md)); }
}
__global__ __launch_bounds__(256) void k_report(const unsigned* slots, int nst, const float* good, float* out, size_t n, float thr, int report_stage) {
    float code = 0.f;
    if (report_stage > 0) { const float mr = __uint_as_float(slots[2 * report_stage]), md = __uint_as_float(slots[2 * report_stage + 1]); code = 1e5f * (md / fmaxf(mr, 1e-30f)); if (!(code < 1e9f)) code = 1e9f; }
    else for (int s = 1; s < nst; ++s) { const float mr = __uint_as_float(slots[2 * s]), md = __uint_as_float(slots[2 * s + 1]); if (mr > 0.f && md > thr * mr) { code = 1000.f * (float)s; break; } }
    for (size_t i = (size_t)blockIdx.x * 256 + threadIdx.x; i < n; i += (size_t)gridDim.x * 256) out[i] = good[i] + code;
}
struct Cmp {
    hipStream_t st; unsigned* slots;
    void operator()(int stage, const float* ref, int ldr, int rgs, const void* opt, int ldo, int ogs, int isbf, int rows, int ngroups, int gwid) const {
        hipLaunchKernelGGL(k_cmp, dim3(1024), dim3(256), 0, st, ref, ldr, rgs, opt, ldo, ogs, isbf, rows, ngroups, gwid, slots + 2 * stage);
    }
};
}

#ifndef MODE
#define MODE 2
#endif
#ifndef REPORT_STAGE
#define REPORT_STAGE 0
#endif
extern "C" void kernel_launch(void* const* d_in, const int* in_sizes, int n_in, void* d_out, int out_size, void* d_ws, size_t ws_size, hipStream_t stream) {
    unsigned char* ws = (unsigned char*)d_ws;
    const size_t nvbase = (mk::WS_END + 4095) / 4096 * 4096;
    nv::Bufs b; const size_t nvneed = nv::carve(b, (char*)ws + nvbase);
    if (n_in != 22 || ws_size < nvbase + nvneed + (64u << 20) + 4096) { fprintf(stderr, "kernel_launch: n_in %d ws %zu need %zu\n", n_in, ws_size, nvbase + nvneed + (64u << 20) + 4096); return; }
#if MODE == 0
    nv::forward(d_in, (float*)d_out, (char*)ws + nvbase, stream);
#elif MODE == 1
    mk::prep(ws, stream);
    for (int p = 0; p < mk::N_PHASES; ++p) mk::run(d_in, (float*)d_out, ws, stream, p, p + 1);
#elif MODE == 2
    mk::prep(ws, stream);
    mk::run(d_in, (float*)d_out, ws, stream, 0, mk::N_PHASES);
#else
    using namespace nv;
    hipStream_t st = stream;
    unsigned* slots = (unsigned*)(ws + nvbase + nvneed);
    float* optout = (float*)(ws + nvbase + nvneed + 4096);
    (void)hipMemsetAsync(slots, 0, 4096, st);
    dbg::Cmp cmp{st, slots};
    const float *x = (const float*)d_in[0], *c = (const float*)d_in[1], *ctx = (const float*)d_in[2], *cctx = (const float*)d_in[3], *w_mod = (const float*)d_in[4], *b_mod = (const float*)d_in[5];
    const float *g_mix_pre = (const float*)d_in[6], *g_mix_post = (const float*)d_in[7], *g_ffn_pre = (const float*)d_in[8], *g_ffn_post = (const float*)d_in[9];
    const float *w_in = (const float*)d_in[10], *sink_a = (const float*)d_in[11], *g_qn = (const float*)d_in[12], *g_kn = (const float*)d_in[13], *g_cq = (const float*)d_in[14], *w_uq = (const float*)d_in[15];
    const float *g_ckv = (const float*)d_in[16], *w_ukv = (const float*)d_in[17], *w_out = (const float*)d_in[18], *w1 = (const float*)d_in[19], *w3 = (const float*)d_in[20], *w2 = (const float*)d_in[21];
    const float sc_ab = 0.08838834764831845f, sc_c = 0.07216878364870323f;
    const unsigned short* mP = (const unsigned short*)(ws + mk::WS_P); const unsigned short* mH = (const unsigned short*)(ws + mk::WS_H);
    mk::prep(ws, st);
    hipLaunchKernelGGL(k_mod, dim3(6 * D / 256, DEPTH), dim3(256), 0, st, c, cctx, w_mod, b_mod, b.modv);
    hipLaunchKernelGGL(k_initx, dim3(4096), dim3(256), 0, st, x, ctx, b.X);
    const float* modl = b.modv;
    hipLaunchKernelGGL(k_norm_mod, dim3(NR), dim3(256), 0, st, b.X, g_mix_pre, modl, 0, 1, b.H);
    mk::run(d_in, optout, ws, st, 0, 1); mk::run(d_in, optout, ws, st, 1, 2);
    cmp(1, b.modv, 1, 0, ws + mk::WS_MODV, 1, 0, 0, DEPTH * 3 * 6 * D, 1, 1);
    cmp(2, b.H, D, 0, mH, D, 0, 1, NR, 1, D);
    gemm(st, b.H, D, w_in, DIN, b.P, DIN, NR, DIN, D);
    mk::run(d_in, optout, ws, st, 2, 3);
    cmp(3, b.P, DIN, 0, mP, mk::NIN, 0, 1, NR, 1, DIN);
    hipLaunchKernelGGL(k_post1, dim3(NR), dim3(256), 0, st, b.P, g_qn, g_kn, g_cq, g_ckv, b.QA, b.KA, b.VA, b.QB, b.KB, b.VB, b.CQn, b.CKVn);
    gemm(st, b.CQn, 512, w_uq, 768, b.QCraw, 768, NR, 768, 512);
    gemm(st, b.CKVn, 256, w_ukv, 1024, b.KVraw, 1024, NR, 1024, 256);
    hipLaunchKernelGGL(k_post2, dim3(NR), dim3(256), 0, st, b.P, b.QCraw, b.KVraw, b.QC, b.KC, b.VC);
    mk::run(d_in, optout, ws, st, 3, 4);
    cmp(4, b.QA, 768, 0, mP + mk::O_AQ, mk::NIN, 0, 1, NR, 1, 768);
    cmp(5, b.KA, 256, 0, mP + mk::O_AK, mk::NIN, 0, 1, NR, 1, 256);
    cmp(6, b.VA, 256, 0, mP + mk::O_AV, mk::NIN, 0, 1, NR, 1, 256);
    cmp(7, b.QB, 768, 0, mP + mk::O_BQ, mk::NIN, 0, 1, NR, 1, 768);
    cmp(8, b.KB, 256, 0, mP + mk::O_BK, mk::NIN, 0, 1, NR, 1, 256);
    cmp(9, b.VB, 256, 0, mP + mk::O_BV, mk::NIN, 0, 1, NR, 1, 256);
    cmp(10, b.QC, 768, 0, ws + mk::WS_QC, 768, 0, 1, NR, 1, 768);
    cmp(11, b.KC, 768, 192, ws + mk::WS_KVC, 1024, 256, 1, NR, 4, 128);
    cmp(12, b.KC + 128, 768, 0, mP + mk::O_CKR, mk::NIN, 0, 1, NR, 1, 64);
    cmp(13, b.VC, 512, 128, (const unsigned short*)(ws + mk::WS_KVC) + 128, 1024, 256, 1, NR, 4, 128);
    hipLaunchKernelGGL((k_attn<128, 32>), dim3(NL / 32, 6), dim3(256), 0, st, b.QA, 768, b.KA, 256, b.VA, 256, b.CAT, 0, 3, sink_a, sc_ab, 1, 0);
    hipLaunchKernelGGL((k_attn<128, 32>), dim3(NL / 32, 6), dim3(256), 0, st, b.QB, 768, b.KB, 256, b.VB, 256, b.CAT, 768, 3, (const float*)nullptr, sc_ab, 0, 0);
    hipLaunchKernelGGL((k_attn<192, 16>), dim3(NL / 32, 4), dim3(256), 0, st, b.QC, 768, b.KC, 768, b.VC, 512, b.CAT, 1536, 1, (const float*)nullptr, sc_c, 0, 0);
    hipLaunchKernelGGL((k_attn<128, 32>), dim3(NC / 32, 6), dim3(256), 0, st, b.QA, 768, b.KA, 256, b.VA, 256, b.CAT, 0, 3, sink_a, sc_ab, 0, 1);
    hipLaunchKernelGGL((k_attn<128, 32>), dim3(NC / 32, 6), dim3(256), 0, st, b.QB, 768, b.KB, 256, b.VB, 256, b.CAT, 768, 3, (const float*)nullptr, sc_ab, 0, 1);
    hipLaunchKernelGGL((k_attn<192, 16>), dim3(NC / 32, 4), dim3(256), 0, st, b.QC, 768, b.KC, 768, b.VC, 512, b.CAT, 1536, 1, (const float*)nullptr, sc_c, 0, 1);
    mk::run(d_in, optout, ws, st, 4, 5);
    cmp(14, b.CAT, D, 0, ws + mk::WS_CAT, D, 0, 1, NR, 1, 768);
    cmp(15, b.CAT + 768, D, 0, (const unsigned short*)(ws + mk::WS_CAT) + 768, D, 0, 1, NR, 1, 768);
    cmp(16, b.CAT + 1536, D, 0, (const unsigned short*)(ws + mk::WS_CAT) + 1536, D, 0, 1, NR, 1, 512);
    gemm(st, b.CAT, D, w_out, D, b.O, D, NR, D, D);
    mk::run(d_in, optout, ws, st, 5, 6);
    cmp(17, b.O, D, 0, ws + mk::WS_OF, D, 0, 1, NR, 1, D);
    hipLaunchKernelGGL(k_resid, dim3(NR), dim3(256), 0, st, b.X, b.O, g_mix_post, modl, 2);
    hipLaunchKernelGGL(k_norm_mod, dim3(NR), dim3(256), 0, st, b.X, g_ffn_pre, modl, 3, 4, b.H);
    mk::run(d_in, optout, ws, st, 6, 7);
    cmp(18, b.X, D, 0, ws + mk::WS_X, D, 0, 0, NR, 1, D);
    cmp(19, b.H, D, 0, mH, D, 0, 1, NR, 1, D);
    gemm(st, b.H, D, w1, DFF, b.G1, DFF, NR, DFF, D);
    gemm(st, b.H, D, w3, DFF, b.G3, DFF, NR, DFF, D);
    hipLaunchKernelGGL(k_swiglu, dim3(8192), dim3(256), 0, st, b.G1, b.G3, (size_t)NR * DFF);
    mk::run(d_in, optout, ws, st, 7, 8);
    cmp(20, b.G1, DFF, 0, ws + mk::WS_U, DFF, 0, 1, NR, 1, DFF);
    gemm(st, b.G1, DFF, w2, D, b.O, D, NR, D, DFF);
    mk::run(d_in, optout, ws, st, 8, 9);
    cmp(21, b.O, D, 0, ws + mk::WS_OF, D, 0, 1, NR, 1, D);
    hipLaunchKernelGGL(k_resid, dim3(NR), dim3(256), 0, st, b.X, b.O, g_ffn_post, modl, 5);
    hipLaunchKernelGGL(k_norm_mod, dim3(NR), dim3(256), 0, st, b.X, g_mix_pre + D, b.modv + (size_t)3 * 6 * D, 0, 1, b.H);
    mk::run(d_in, optout, ws, st, 9, 10);
    cmp(22, b.X, D, 0, ws + mk::WS_X, D, 0, 0, NR, 1, D);
    cmp(23, b.H, D, 0, mH, D, 0, 1, NR, 1, D);
    for (int p = 10; p < mk::N_PHASES; ++p) mk::run(d_in, optout, ws, st, p, p + 1);
    nv::forward(d_in, nullptr, (char*)ws + nvbase, st);
    cmp(30, b.X, D, 0, optout, D, 0, 0, NL, 1, D);
    hipLaunchKernelGGL(dbg::k_report, dim3(4096), dim3(256), 0, st, slots, 32, b.X, (float*)d_out, (size_t)NL * D, 0.04f, REPORT_STAGE);
#endif
}
```

```cpp
#include <hip/hip_runtime.h>
#include <stdint.h>
#include <stdio.h>
#include <cstdint>
#include <cmath>

#ifndef WT_STORES
#define WT_STORES 0
#endif
typedef unsigned wt_u32x4 __attribute__((ext_vector_type(4)));
typedef unsigned wt_u32x2 __attribute__((ext_vector_type(2)));
__device__ __forceinline__ void gst16(void* p, wt_u32x4 v) {
#if WT_STORES
    asm volatile("global_store_dwordx4 %0, %1, off sc1\n\ts_nop 1" :: "v"(p), "v"(v) : "memory");
#else
    *(wt_u32x4*)p = v;
#endif
}
__device__ __forceinline__ void gst8(void* p, wt_u32x2 v) {
#if WT_STORES
    asm volatile("global_store_dwordx2 %0, %1, off sc1\n\ts_nop 0" :: "v"(p), "v"(v) : "memory");
#else
    *(wt_u32x2*)p = v;
#endif
}
__device__ __forceinline__ void gst16_wt(void* p, wt_u32x4 v) { asm volatile("global_store_dwordx4 %0, %1, off sc1\n\ts_nop 1" :: "v"(p), "v"(v) : "memory"); }
__device__ __forceinline__ void gst8_wt(void* p, wt_u32x2 v) { asm volatile("global_store_dwordx2 %0, %1, off sc1\n\ts_nop 0" :: "v"(p), "v"(v) : "memory"); }
namespace pg8 {
#define PG8_LAS __attribute__((address_space(3)))
typedef unsigned short bf16_t;
typedef short bf16x8 __attribute__((ext_vector_type(8)));
typedef float f32x4 __attribute__((ext_vector_type(4)));
typedef float f32x2 __attribute__((ext_vector_type(2)));
typedef unsigned u32x4 __attribute__((ext_vector_type(4)));
typedef unsigned u32x2 __attribute__((ext_vector_type(2)));
constexpr int BM = 256, BK = 64, HALF = 128, HTB = HALF * BK * 2  , STAGE_BYTES = 8 * HTB, NXCD = 8, WGM = 8;

__host__ __device__ __forceinline__ int lds_byte(int r, int c) { const int st = (r >> 4) * 2 + (c >> 5), rr = r & 15, cc = c & 31, ob = rr * 64 + cc * 2; return st * 1024 + (ob ^ (((ob >> 9) & 1) << 5)); }
__host__ __device__ __forceinline__ void stage_rc(int b, int& R, int& C) { const int st = b / 1024, sb = b % 1024, swz = sb ^ (((sb >> 9) & 1) << 5); R = (st >> 1) * 16 + swz / 64; C = (st & 1) * 32 + (swz % 64) / 2; }
__host__ __device__ __forceinline__ int perm32(int rho) { const int n = rho >> 4, i = rho & 15; return 8 * (i >> 2) + 4 * n + (i & 3); }

struct Unit { int pm, pn, kofs, nt, part; };
struct Gemm { const bf16_t* A; const bf16_t* Bt; int M, N, K, lda; };

struct StaticOrder {
    int nM, nN, nwg, G, c;
    __host__ __device__ __forceinline__ void init(int M, int N, int G_, int c_) { nM = M / BM; nN = N / BM; nwg = nM * nN; G = G_; c = c_; }
    __host__ __device__ __forceinline__ bool next(int i, Unit& u) const { return nextL((long)i * G + c, u); }
    __host__ __device__ __forceinline__ bool nextL(long L, Unit& u) const {
        if (L < 0 || L >= nwg) return false;
        int wgid = (int)L; { const int q = nwg / NXCD, r = nwg % NXCD, xcd = wgid % NXCD, off = wgid / NXCD; wgid = (xcd < r ? xcd * (q + 1) : r * (q + 1) + (xcd - r) * q) + off; }
        const int nig = WGM * nN, gid = wgid / nig, fm = gid * WGM, gsz = (nM - fm) < WGM ? (nM - fm) : WGM;
        u.pm = fm + ((wgid % nig) % gsz); u.pn = (wgid % nig) / gsz; return true;
    }
    __device__ __forceinline__ void a_ready(const Unit&) const {}
    __device__ __forceinline__ void done(const Unit&) const {}
};
struct CountedStatic : StaticOrder {
    const unsigned* ready; unsigned need_lat, need_ctx; unsigned* tmo;
    __device__ __forceinline__ void a_ready(const Unit& u) const {
        if (ready == nullptr) return;
        if (threadIdx.x < 64) {
            const unsigned need = u.pm >= 32 ? need_ctx : need_lat; unsigned polls = 0;
            while ((unsigned)__builtin_amdgcn_readfirstlane(__hip_atomic_load(ready + 64 * u.pm, __ATOMIC_RELAXED, __HIP_MEMORY_SCOPE_AGENT)) < need) {
                __builtin_amdgcn_s_sleep(2);
                if ((++polls & 255u) == 0u) { if (__builtin_amdgcn_readfirstlane(__hip_atomic_load(tmo, __ATOMIC_RELAXED, __HIP_MEMORY_SCOPE_AGENT)) != 0u) break;
                    if (polls > (1u << 18)) { if (threadIdx.x == 0) atomicAdd(tmo, 1u); break; } } }
            __builtin_amdgcn_fence(__ATOMIC_ACQUIRE, "agent");
            asm volatile("s_waitcnt vmcnt(0)" ::: "memory");
        }
        asm volatile("" ::: "memory"); __builtin_amdgcn_s_barrier(); asm volatile("" ::: "memory");
    }
};
struct F13Order {
    StaticOrder base; bool shifted;
    __host__ __device__ __forceinline__ bool next(int i, Unit& u) const {
        const int c = base.c;
        if (!shifted || base.G != 256) return base.next(i, u);
        if (c >= 240) return i < 3 ? base.nextL((long)i * 256 + c, u) : false;
        if (i < 5) return base.nextL((long)i * 256 + c, u);
        if (i == 5) { if (c < 128) return base.nextL(1280 + c, u); if (c < 160) { const int o = c - 128; return base.nextL((long)(3 + o / 16) * 256 + 240 + (o % 16), u); } }
        return false;
    }
    __device__ __forceinline__ void a_ready(const Unit&) const {}
    __device__ __forceinline__ void done(const Unit&) const {}
};
struct SplitTailOrder {
    StaticOrder base; int npieces, piece_nt;
    __host__ __device__ __forceinline__ bool next(int i, Unit& u) const {
        if (i == 0) return base.next(0, u);
        if (i == 1 && npieces > 0 && base.c < 16 * npieces) { const int tile = base.c / npieces, piece = base.c % npieces; u.pm = 32 + tile / 8; u.pn = tile % 8; u.kofs = piece * piece_nt * BK; u.nt = piece_nt; u.part = piece; return true; }
        return false;
    }
    __device__ __forceinline__ void a_ready(const Unit&) const {}
    __device__ __forceinline__ void done(const Unit&) const {}
};
struct InOrder {
    int M, G, c; unsigned* pan;
    __host__ __device__ __forceinline__ void init(int M_, int G_, int c_) { M = M_; G = G_; c = c_; }
    __host__ __device__ __forceinline__ bool next(int i, Unit& u) const {
        const int n1 = (M / BM) * 3; const long L = (long)i * G + c;
        StaticOrder s;
        if (L < n1) { s.init(M, 3 * BM, G, c); s.nextL(L, u); u.pn += 10; return true; }
        s.init(M, 11 * BM, G, c);
        if (!s.nextL(L - n1, u)) return false;
        if (u.pn >= 10) u.pn += 3;
        return true;
    }
    __device__ __forceinline__ void a_ready(const Unit&) const {}
    __device__ __forceinline__ void done(const Unit& u) const {
        if (u.pn >= 10 && u.pn <= 12) {
            asm volatile("s_waitcnt vmcnt(0)" ::: "memory"); __builtin_amdgcn_s_barrier(); asm volatile("" ::: "memory");
            if (threadIdx.x == 0) __hip_atomic_fetch_add(pan + 64 * u.pm, 1u, __ATOMIC_RELAXED, __HIP_MEMORY_SCOPE_AGENT);
        }
    }
};
struct PanelOrder {
    int pm, n;
    __device__ __forceinline__ bool next(int i, Unit& u) const { if (i < 0 || i >= n) return false;
        int p = pm; asm volatile("" : "+s"(p));
        u.pm = p; u.pn = i; return true; }
    __device__ __forceinline__ void a_ready(const Unit&) const {}
    __device__ __forceinline__ void done(const Unit&) const {}
};
struct OffsetOrder {
    int nN, nwg, L;
    __host__ __device__ __forceinline__ void init(int M, int N, int c, int off) { nN = N / BM; nwg = (M / BM) * nN; L = c - off; }
    __host__ __device__ __forceinline__ bool has() const { return L >= 0 && L < nwg; }
    __host__ __device__ __forceinline__ bool next(int i, Unit& u) const { if (i != 0 || !has()) return false; u.pm = L / nN; u.pn = L % nN; return true; }
    __device__ __forceinline__ void a_ready(const Unit&) const {}
    __device__ __forceinline__ void done(const Unit&) const {}
};

__device__ __forceinline__ unsigned cvt_pk_bf16(float lo, float hi) { unsigned r; asm volatile("v_cvt_pk_bf16_f32 %0, %1, %2" : "=v"(r) : "v"(lo), "v"(hi)); return r; }
__device__ __forceinline__ u32x4 pack8(const f32x4 v0, const f32x4 v1) { u32x4 w; w.x = cvt_pk_bf16(v0[0], v0[1]); w.y = cvt_pk_bf16(v0[2], v0[3]); w.z = cvt_pk_bf16(v1[0], v1[1]); w.w = cvt_pk_bf16(v1[2], v1[3]); return w; }

struct EpiPlain {
    static constexpr bool PERM = true;
    bf16_t* O; int ldc; bf16_t* Opart; size_t pstride; int pm_ctx; bool wt;
    __device__ __forceinline__ void operator()(const f32x4 (&acc)[2][2][4][2], const Unit& u, int wr, int wc, int fr, int fq) const {
        const bool cx = Opart != nullptr && u.pm >= pm_ctx;
        bf16_t* base = cx ? Opart + (size_t)u.part * pstride - (size_t)pm_ctx * BM * ldc : O;
        const int row0 = u.pm * BM + wr * 64 + fr, col0 = u.pn * BM + wc * 32 + 8 * fq;
#pragma unroll
        for (int ai = 0; ai < 2; ++ai)
#pragma unroll
            for (int m = 0; m < 4; ++m) { bf16_t* rowp = base + (size_t)(row0 + ai * HALF + m * 16) * ldc + col0;
#pragma unroll
                for (int bj = 0; bj < 2; ++bj) { const u32x4 w = pack8(acc[ai][bj][m][0], acc[ai][bj][m][1]); if (wt) gst16_wt(rowp + bj * HALF, w); else gst16(rowp + bj * HALF, w); } }
    }
};
#ifndef ROPE_EPI_A
#define ROPE_EPI_A 1
#endif
#ifndef ROPE_EPI_B
#define ROPE_EPI_B 1
#endif
#ifndef B_NORM_EPI
#define B_NORM_EPI 1
#endif
#ifndef ROPE_EPI_R
#define ROPE_EPI_R 1
#endif
__host__ __device__ __forceinline__ int perm64(int r) { const int n = r >> 5, i = r & 31; return 32 * (i >> 4) + 8 * ((i >> 2) & 3) + 4 * n + (i & 3); }
struct EpiIn {
    static constexpr bool PERM = true;
    bf16_t* O; int ldc; float* ssq; float* ssqb; const float* tab128; const float* tab64; const float* gq; const float* gk; PG8_LAS float* xs; bool wt;
    __device__ __forceinline__ void operator()(const f32x4 (&acc)[2][2][4][2], const Unit& u, int wr, int wc, int fr, int fq) const {
        const int pn = u.pn, row0 = u.pm * BM + wr * 64 + fr, col0 = pn * BM + wc * 32 + 8 * fq;
        const bool ropeA = ROPE_EPI_A && pn <= 3, normB = ROPE_EPI_B && pn >= 5 && pn <= 8, ropeR = ROPE_EPI_R && pn == 13;
        if (ropeA || normB) {
            const int half = wc >> 1, i0 = 16 * (wc & 1) + 4 * fq;
            f32x4 g0 = {1.f, 1.f, 1.f, 1.f}, g1 = g0;
            if (normB) { const float* g = pn == 8 ? gk : gq; g0 = *(const f32x4*)(g + 64 * half + i0); g1 = *(const f32x4*)(g + 64 * half + i0 + 32); }
            if (normB && B_NORM_EPI) {
#pragma unroll
                for (int ai = 0; ai < 2; ++ai)
#pragma unroll
                    for (int m = 0; m < 4; ++m)
#pragma unroll
                        for (int bj = 0; bj < 2; ++bj) { const f32x4 x1 = acc[ai][bj][m][0], x2 = acc[ai][bj][m][1];
                            float s = ((x1[0] * x1[0] + x1[1] * x1[1]) + (x1[2] * x1[2] + x1[3] * x1[3])) + ((x2[0] * x2[0] + x2[1] * x2[1]) + (x2[2] * x2[2] + x2[3] * x2[3]));
                            s += __shfl_xor(s, 16); s += __shfl_xor(s, 32);
                            if (fq == 0) xs[((ai * HALF + wr * 64 + m * 16 + fr) * 2 + bj) * 4 + wc] = s; }
                asm volatile("s_waitcnt lgkmcnt(0)" ::: "memory"); __builtin_amdgcn_s_barrier(); asm volatile("" ::: "memory");
            }
#pragma unroll
            for (int ai = 0; ai < 2; ++ai)
#pragma unroll
                for (int m = 0; m < 4; ++m) { const int row = row0 + ai * HALF + m * 16; const bool lat = row < 8192; const int t = row & 4095, pos = half ? (t & 63) : (t >> 6);
                    f32x4 cs = {1.f, 1.f, 1.f, 1.f}, sn = {0.f, 0.f, 0.f, 0.f};
                    if (lat) { const f32x4 t0 = *(const f32x4*)(tab128 + (size_t)(pos * 32 + i0) * 2), t1 = *(const f32x4*)(tab128 + (size_t)(pos * 32 + i0) * 2 + 4);
                        cs = (f32x4){t0[0], t0[2], t1[0], t1[2]}; sn = (f32x4){t0[1], t0[3], t1[1], t1[3]}; }
                    bf16_t* rowp = O + (size_t)row * ldc + col0;
#pragma unroll
                    for (int bj = 0; bj < 2; ++bj) { f32x4 x1 = acc[ai][bj][m][0], x2 = acc[ai][bj][m][1];
                        if (normB && B_NORM_EPI) { const f32x4 sq = *(const PG8_LAS f32x4*)(xs + ((ai * HALF + wr * 64 + m * 16 + fr) * 2 + bj) * 4);
                            const float rstd = rsqrtf(((sq[0] + sq[1]) + (sq[2] + sq[3])) * (1.f / 128.f) + 1e-6f);
                            x1 = x1 * g0 * rstd; x2 = x2 * g1 * rstd; }
                        else if (normB) { float s = ((x1[0] * x1[0] + x1[1] * x1[1]) + (x1[2] * x1[2] + x1[3] * x1[3])) + ((x2[0] * x2[0] + x2[1] * x2[1]) + (x2[2] * x2[2] + x2[3] * x2[3]));
                            s += __shfl_xor(s, 16); s += __shfl_xor(s, 32);
                            if (fq == 0) ssqb[(size_t)row * 32 + ((pn - 5) * 2 + bj) * 4 + wc] = s;
                            x1 = x1 * g0; x2 = x2 * g1; }
                        gst16(rowp + bj * HALF, pack8(x1 * cs - x2 * sn, x2 * cs + x1 * sn)); }
                    if (m & 1) asm volatile("" ::: "memory"); }
            return;
        }
#pragma unroll
        for (int ai = 0; ai < 2; ++ai)
#pragma unroll
            for (int m = 0; m < 4; ++m) { const int row = row0 + ai * HALF + m * 16; bf16_t* rowp = O + (size_t)row * ldc + col0;
                f32x4 v0 = acc[ai][0][m][0], v1 = acc[ai][0][m][1];
                if (ropeR && wc < 2) {
                    f32x4 p0, p1;
#pragma unroll
                    for (int j = 0; j < 4; ++j) { p0[j] = __shfl_xor(v0[j], 32); p1[j] = __shfl_xor(v1[j], 32); }
                    if (row < 8192) { const int t = row & 4095, pos = wc ? (t & 63) : (t >> 6), ib = 8 * (fq & 1);
                        const f32x4 a0 = *(const f32x4*)(tab64 + (size_t)(pos * 16 + ib) * 2), a1 = *(const f32x4*)(tab64 + (size_t)(pos * 16 + ib) * 2 + 4), a2 = *(const f32x4*)(tab64 + (size_t)(pos * 16 + ib) * 2 + 8), a3 = *(const f32x4*)(tab64 + (size_t)(pos * 16 + ib) * 2 + 12);
                        const f32x4 c0 = {a0[0], a0[2], a1[0], a1[2]}, s0 = {a0[1], a0[3], a1[1], a1[3]}, c1 = {a2[0], a2[2], a3[0], a3[2]}, s1 = {a2[1], a2[3], a3[1], a3[3]};
                        if (fq < 2) { v0 = v0 * c0 - p0 * s0; v1 = v1 * c1 - p1 * s1; } else { v0 = v0 * c0 + p0 * s0; v1 = v1 * c1 + p1 * s1; } }
                }
                if (wt && pn >= 10 && pn <= 12) { gst16_wt(rowp, pack8(v0, v1)); gst16_wt(rowp + HALF, pack8(acc[ai][1][m][0], acc[ai][1][m][1])); }
                else { gst16(rowp, pack8(v0, v1)); gst16(rowp + HALF, pack8(acc[ai][1][m][0], acc[ai][1][m][1])); } }
        if (pn >= 10 && pn <= 12) {
#pragma unroll
            for (int ai = 0; ai < 2; ++ai)
#pragma unroll
                for (int m = 0; m < 4; ++m) { float s = 0.f;
#pragma unroll
                    for (int bj = 0; bj < 2; ++bj)
#pragma unroll
                        for (int n = 0; n < 2; ++n) { const f32x4 x = acc[ai][bj][m][n]; s += (x[0] * x[0] + x[1] * x[1]) + (x[2] * x[2] + x[3] * x[3]); }
                    s += __shfl_xor(s, 16); s += __shfl_xor(s, 32);
                    if (fq == 0) __hip_atomic_store(ssq + (size_t)(row0 + ai * HALF + m * 16) * 12 + (pn - 10) * 4 + wc, s, __ATOMIC_RELAXED, __HIP_MEMORY_SCOPE_AGENT); }
        }
    }
};
struct EpiUq {
    static constexpr bool PERM = false;
    bf16_t* O; const float* ssq; const float* tab64; int rabs;
    __device__ __forceinline__ void operator()(const f32x4 (&acc)[2][2][4][2], const Unit& u, int wr, int wc, int fr, int fq) const {
        float rs[2][4];
#pragma unroll
        for (int ai = 0; ai < 2; ++ai)
#pragma unroll
            for (int m = 0; m < 4; ++m) { const int row = u.pm * BM + ai * HALF + wr * 64 + m * 16 + fr;
                const f32x4 q0 = *(const f32x4*)(ssq + (size_t)row * 12), q1 = *(const f32x4*)(ssq + (size_t)row * 12 + 4);
                rs[ai][m] = rsqrtf(((q0[0] + q0[1]) + (q0[2] + q0[3]) + (q1[0] + q1[1]) + (q1[2] + q1[3])) * (1.f / 512.f) + 1e-6f);
                if (m & 1) asm volatile("" ::: "memory"); }
#pragma unroll
        for (int ai = 0; ai < 2; ++ai)
#pragma unroll
            for (int m = 0; m < 4; ++m) {
                const int row = u.pm * BM + ai * HALF + wr * 64 + m * 16 + fr; const float rstd = rs[ai][m];
                const bool lat = rabs + row < 8192; const int t = (rabs + row) & 4095, prow = t >> 6, pcol = t & 63;
#pragma unroll
                for (int bj = 0; bj < 2; ++bj) {
                    const int g6 = (8 * u.pn + 4 * bj + wc) % 6;
                    f32x4 v0 = acc[ai][bj][m][0] * rstd, v1 = acc[ai][bj][m][1] * rstd;
                    if (g6 >= 4 && lat) {
                        const int pos = g6 == 4 ? prow : pcol;
                        const f32x4 t0 = *(const f32x4*)(tab64 + (size_t)(pos * 16 + 4 * fq) * 2), t1 = *(const f32x4*)(tab64 + (size_t)(pos * 16 + 4 * fq) * 2 + 4);
                        const f32x4 cs = {t0[0], t0[2], t1[0], t1[2]}, sn = {t0[1], t0[3], t1[1], t1[3]};
                        const f32x4 o0 = v0 * cs - v1 * sn, o1 = v1 * cs + v0 * sn; v0 = o0; v1 = o1;
                    }
                    bf16_t* p = O + (size_t)row * 768 + u.pn * BM + bj * HALF + wc * 32 + 4 * fq;
                    u32x2 w0, w1; w0.x = cvt_pk_bf16(v0[0], v0[1]); w0.y = cvt_pk_bf16(v0[2], v0[3]); w1.x = cvt_pk_bf16(v1[0], v1[1]); w1.y = cvt_pk_bf16(v1[2], v1[3]);
                    gst8(p, w0); gst8(p + 16, w1);
                }
                asm volatile("" ::: "memory");
            }
    }
};
struct EpiUkv {
    static constexpr bool PERM = true;
    bf16_t* O; const float* ssq;
    __device__ __forceinline__ void operator()(const f32x4 (&acc)[2][2][4][2], const Unit& u, int wr, int wc, int fr, int fq) const {
        const int row0 = u.pm * BM + wr * 64 + fr, col0 = u.pn * BM + wc * 32 + 8 * fq;
        float rs[2][4];
#pragma unroll
        for (int ai = 0; ai < 2; ++ai)
#pragma unroll
            for (int m = 0; m < 4; ++m) { const int row = row0 + ai * HALF + m * 16;
                const f32x4 q0 = *(const f32x4*)(ssq + (size_t)row * 12 + 8);
                rs[ai][m] = rsqrtf(((q0[0] + q0[1]) + (q0[2] + q0[3])) * (1.f / 256.f) + 1e-6f);
                if (m & 1) asm volatile("" ::: "memory"); }
#pragma unroll
        for (int ai = 0; ai < 2; ++ai)
#pragma unroll
            for (int m = 0; m < 4; ++m) { const int row = row0 + ai * HALF + m * 16; const float rstd = rs[ai][m];
                bf16_t* rowp = O + (size_t)row * 1024 + col0;
#pragma unroll
                for (int bj = 0; bj < 2; ++bj) gst16(rowp + bj * HALF, pack8(acc[ai][bj][m][0] * rstd, acc[ai][bj][m][1] * rstd)); }
    }
};
struct EpiSwiglu {
    static constexpr bool PERM = true;
    bf16_t* O; int ldc;
    __device__ __forceinline__ void operator()(const f32x4 (&acc)[2][2][4][2], const Unit& u, int wr, int wc, int fr, int fq) const {
        const int row0 = u.pm * BM + wr * 64 + fr, col0 = u.pn * HALF + wc * 32 + 8 * fq;
#pragma unroll
        for (int ai = 0; ai < 2; ++ai)
#pragma unroll
            for (int m = 0; m < 4; ++m) { f32x4 r[2];
#pragma unroll
                for (int n = 0; n < 2; ++n) { const f32x4 g = acc[ai][0][m][n], up = acc[ai][1][m][n];
#pragma unroll
                    for (int j = 0; j < 4; ++j) { const float e = __builtin_amdgcn_exp2f(g[j] * -1.4426950408889634f); r[n][j] = g[j] * __builtin_amdgcn_rcpf(1.f + e) * up[j]; } }
                gst16(O + (size_t)(row0 + ai * HALF + m * 16) * ldc + col0, pack8(r[0], r[1])); }
    }
};

template <class Epi, class Sched, bool ALIGN_EPI>
__device__ __forceinline__ void gemm_phase(PG8_LAS unsigned char* lds, const Gemm g, const Sched& S, const Epi& E) {
    int tid_ = threadIdx.x; asm volatile("" : "+v"(tid_));
    const int tid = tid_, wid = __builtin_amdgcn_readfirstlane(tid >> 6), lane = tid & 63, wr = wid >> 2, wc = wid & 3, fr = lane & 15, fq = lane >> 4;
    int K_ = g.K; asm volatile("" : "+s"(K_));
    const int K = K_, nt = K / BK, lda = g.lda;
    unsigned voffA[2], voffB[2];
#pragma unroll
    for (int i = 0; i < 2; ++i) { int R, C; stage_rc(tid * 16 + i * 8192, R, C); const int Rb = Epi::PERM ? ((R & ~31) + perm32(R & 31)) : R;
        voffA[i] = (unsigned)(R * lda + C) * 2u; voffB[i] = (unsigned)(Rb * K + C) * 2u; }
    const size_t kstep = (size_t)(BK * 2);
    const size_t hstepA = (size_t)HALF * lda * 2, tstepA = 2 * hstepA, hstepB = (size_t)HALF * K * 2, tstepB = 2 * hstepB;
    const unsigned ldsw = (unsigned)wid * 1024u;
    const int aoff = lds_byte(wr * 64 + fr, fq * 8), boff = lds_byte(wc * 32 + fr, fq * 8);
#define PG8_SA(b, h) (((b) * 2 + (h)) * HTB)
#define PG8_SB(b, h) ((4 + (b) * 2 + (h)) * HTB)
#define PG8_STAGE(bufoff, gbase, voff) do { _Pragma("unroll") for (int _i = 0; _i < 2; ++_i) \
        __builtin_amdgcn_global_load_lds((const unsigned*)((const char*)(gbase) + (voff)[_i]), (PG8_LAS unsigned*)(lds + (bufoff) + ldsw + _i * 8192), 16, 0, 0); } while (0)
#define PG8_LDA(dst, b, h) do { _Pragma("unroll") for (int m = 0; m < 4; ++m) _Pragma("unroll") for (int k = 0; k < 2; ++k) dst[m][k] = *(const PG8_LAS bf16x8*)(lds + PG8_SA(b, h) + aoff + m * 2048 + k * 1024); } while (0)
#define PG8_LDB(dst, b, h) do { _Pragma("unroll") for (int n = 0; n < 2; ++n) _Pragma("unroll") for (int k = 0; k < 2; ++k) dst[n][k] = *(const PG8_LAS bf16x8*)(lds + PG8_SB(b, h) + boff + n * 2048 + k * 1024); } while (0)
#define PG8_MMA(ai, bj, At, Bt) do { __builtin_amdgcn_s_setprio(1); _Pragma("unroll") for (int m = 0; m < 4; ++m) _Pragma("unroll") for (int n = 0; n < 2; ++n) _Pragma("unroll") for (int k = 0; k < 2; ++k) \
        acc[ai][bj][m][n] = __builtin_amdgcn_mfma_f32_16x16x32_bf16(Bt[n][k], At[m][k], acc[ai][bj][m][n], 0, 0, 0); __builtin_amdgcn_s_setprio(0); } while (0)
#define PG8_WAIT_V(n) asm volatile("s_waitcnt vmcnt(" #n ")" ::: "memory")
#define PG8_WAIT_L(n) asm volatile("s_waitcnt lgkmcnt(" #n ")" ::: "memory")
#define PG8_BAR __builtin_amdgcn_s_barrier()
#define PG8_SCHED __builtin_amdgcn_sched_barrier(0)
    Unit cur{0, 0, 0, nt, 0}, nxt{0, 0, 0, nt, 0}; int ui = 0;
    if (!S.next(0, cur)) return;
    f32x4 acc[2][2][4][2];
#pragma unroll
    for (int a = 0; a < 2; ++a)
#pragma unroll
        for (int b = 0; b < 2; ++b)
#pragma unroll
            for (int m = 0; m < 4; ++m)
#pragma unroll
                for (int n = 0; n < 2; ++n) acc[a][b][m][n] = (f32x4){0.f, 0.f, 0.f, 0.f};
    bf16x8 At[4][2], B0[2][2], B1[2][2];
    const char* cA = (const char*)g.A + (size_t)cur.pm * tstepA + (size_t)cur.kofs * 2; const char* cB = (const char*)g.Bt + (size_t)cur.pn * tstepB + (size_t)cur.kofs * 2;
    S.a_ready(cur);
    PG8_STAGE(PG8_SB(0, 0), cB, voffB); PG8_STAGE(PG8_SB(0, 1), cB + hstepB, voffB); PG8_STAGE(PG8_SA(0, 0), cA, voffA); PG8_STAGE(PG8_SA(0, 1), cA + hstepA, voffA);
    if (wr == 1) PG8_BAR;
    PG8_WAIT_V(2); PG8_BAR;
    PG8_STAGE(PG8_SB(1, 0), cB + kstep, voffB); PG8_STAGE(PG8_SA(1, 0), cA + kstep, voffA); PG8_STAGE(PG8_SB(1, 1), cB + hstepB + kstep, voffB);
    PG8_WAIT_V(6); PG8_BAR;
    for (;;) {
        nxt.kofs = 0; nxt.nt = nt; nxt.part = 0;
        const bool has_next = S.next(ui + 1, nxt);
        const char* nA = has_next ? (const char*)g.A + (size_t)nxt.pm * tstepA + (size_t)nxt.kofs * 2 : cA; const char* nB = has_next ? (const char*)g.Bt + (size_t)nxt.pn * tstepB + (size_t)nxt.kofs * 2 : cB;
        const int ntc = cur.nt;
        for (int t = 0; t < ntc; t += 2) {
            const bool last = (t == ntc - 2);
            const char* a1 = cA + (size_t)(t + 1) * kstep;
            const char* a2 = last ? nA : cA + (size_t)(t + 2) * kstep; const char* b2 = last ? nB : cB + (size_t)(t + 2) * kstep;
            const char* a3 = a2 + kstep; const char* b3 = b2 + kstep;
            if (last && has_next) S.a_ready(nxt);
            PG8_LDB(B0, 0, 0); PG8_LDB(B1, 0, 1); PG8_SCHED; PG8_LDA(At, 0, 0); PG8_STAGE(PG8_SA(1, 1), a1 + hstepA, voffA);
            PG8_WAIT_V(8); PG8_WAIT_L(0); PG8_BAR; PG8_MMA(0, 0, At, B0); PG8_MMA(0, 1, At, B1); PG8_BAR; PG8_SCHED;
            PG8_LDA(At, 0, 1); PG8_STAGE(PG8_SB(0, 0), b2, voffB); PG8_STAGE(PG8_SB(0, 1), b2 + hstepB, voffB); PG8_STAGE(PG8_SA(0, 0), a2, voffA);
            PG8_WAIT_V(8); PG8_WAIT_L(0); PG8_BAR; PG8_MMA(1, 0, At, B0); PG8_MMA(1, 1, At, B1); PG8_BAR; PG8_SCHED;
            PG8_LDB(B0, 1, 0); PG8_LDB(B1, 1, 1); PG8_SCHED; PG8_LDA(At, 1, 0); PG8_STAGE(PG8_SA(0, 1), a2 + hstepA, voffA);
            PG8_WAIT_V(8); PG8_WAIT_L(0); PG8_BAR; PG8_MMA(0, 0, At, B0); PG8_MMA(0, 1, At, B1); PG8_BAR; PG8_SCHED;
            PG8_LDA(At, 1, 1); PG8_STAGE(PG8_SB(1, 0), b3, voffB); PG8_STAGE(PG8_SB(1, 1), b3 + hstepB, voffB); PG8_STAGE(PG8_SA(1, 0), a3, voffA);
            PG8_WAIT_V(8); PG8_WAIT_L(0); PG8_BAR; PG8_MMA(1, 0, At, B0); PG8_MMA(1, 1, At, B1); PG8_BAR; PG8_SCHED;
        }
        if constexpr (ALIGN_EPI) { if (wr == 0) PG8_BAR; }
        E(acc, cur, wr, wc, fr, fq); S.done(cur);
        if (!has_next) break;
#pragma unroll
        for (int a = 0; a < 2; ++a)
#pragma unroll
            for (int b = 0; b < 2; ++b)
#pragma unroll
                for (int m = 0; m < 4; ++m)
#pragma unroll
                    for (int n = 0; n < 2; ++n) acc[a][b][m][n] = (f32x4){0.f, 0.f, 0.f, 0.f};
        cur = nxt; cA = nA; cB = nB; ++ui;
        if constexpr (ALIGN_EPI) { if (wr == 1) PG8_BAR; }
    }
    PG8_WAIT_V(0);
    if constexpr (!ALIGN_EPI) { if (wr == 0) PG8_BAR; }
    PG8_BAR;
#undef PG8_SA
#undef PG8_SB
#undef PG8_STAGE
#undef PG8_LDA
#undef PG8_LDB
#undef PG8_MMA
#undef PG8_WAIT_V
#undef PG8_WAIT_L
#undef PG8_BAR
#undef PG8_SCHED
}
}

namespace at {
using bf16_t = unsigned short;
using bf16x8 = __attribute__((ext_vector_type(8))) short;
using s16x4  = __attribute__((ext_vector_type(4))) short;
using f32x16 = __attribute__((ext_vector_type(16))) float;
using u32x4  = __attribute__((ext_vector_type(4))) unsigned;
constexpr int NW = 8, QBLK = 32, KVBLK = 64;
constexpr int SHM_V = 16384, SHM_K = 16384, SHM_K2 = 8192;
constexpr int OFF_V = 0, OFF_K = 2 * SHM_V, OFF_K2 = OFF_K + 2 * SHM_K, OFF_WS = OFF_K2 + 2 * SHM_K2, OFF_Q2 = OFF_WS + NW * 64 * 4, OFF_FLG = OFF_Q2 + NW * 6144, ATT_LDS = OFF_FLG + 16;
constexpr float THR = 8.f;
constexpr int DUMP_FLOATS = NW * 66 * 64;
#define KSWZ(row, colB) ((row) * 256 + ((colB) ^ (((row) & 7) << 4)))
#define KSWZ2(row, colB) ((row) * 128 + ((colB) ^ (((row) & 7) << 4)))
#define SBAR() __builtin_amdgcn_sched_barrier(0)
__device__ __forceinline__ int crow(int r, int hi) { return (r & 3) + 8 * (r >> 2) + 4 * hi; }
__device__ __forceinline__ unsigned cvtpk(float lo, float hi) { unsigned r; asm volatile("v_cvt_pk_bf16_f32 %0, %1, %2" : "=v"(r) : "v"(lo), "v"(hi)); return r; }

struct AUnit {
    const bf16_t* Q; const bf16_t* KV; const bf16_t* K2; bf16_t* O;
    long kc, kl, vc, vl, k2c, k2l;
    int ldq, ldk, ldv, ldk2, ldo;
    int nct, ntl;
    float* part_own; const float* part_oth; unsigned* cnt;
    int qk_off;
    float sink;
};

template <int DK>
__device__ __forceinline__ void partialSM(f32x16& p0, f32x16& p1, float& m_reg, float& mn, float& alpha) {
    constexpr float SCALE = DK == 128 ? 0.08838834764831845f : 0.07216878364870323f, C = SCALE * 1.4426950408889634f;
    float pmax = p0[0];
#pragma unroll
    for (int r = 1; r < 16; ++r) pmax = fmaxf(pmax, p0[r]);
#pragma unroll
    for (int r = 0; r < 16; ++r) pmax = fmaxf(pmax, p1[r]);
    { auto rr = __builtin_amdgcn_permlane32_swap(__float_as_uint(pmax), __float_as_uint(pmax), false, false);
      pmax = fmaxf(__uint_as_float(rr[0]), __uint_as_float(rr[1])); }
    if (__builtin_expect(__all(pmax - m_reg <= THR / SCALE), 1)) { mn = m_reg; alpha = 1.f; }
    else { mn = fmaxf(m_reg, pmax); alpha = __builtin_amdgcn_exp2f((m_reg - mn) * C); m_reg = mn; }
    const float mnC = -mn * C;
#pragma unroll
    for (int r = 0; r < 16; ++r) p0[r] = fmaf(p0[r], C, mnC);
#pragma unroll
    for (int r = 0; r < 16; ++r) p1[r] = fmaf(p1[r], C, mnC);
#pragma unroll
    for (int r = 0; r < 16; ++r) p0[r] = __builtin_amdgcn_exp2f(p0[r]);
}
__device__ __forceinline__ void finishSM(f32x16& p0, f32x16& p1, float alpha, float& l_reg, bf16x8& pa0, bf16x8& pa1, bf16x8& pa2, bf16x8& pa3) {
#pragma unroll
    for (int r = 0; r < 16; ++r) p1[r] = __builtin_amdgcn_exp2f(p1[r]);
    float ps = 0;
#pragma unroll
    for (int r = 0; r < 16; ++r) ps += p0[r];
#pragma unroll
    for (int r = 0; r < 16; ++r) ps += p1[r];
    { auto rr = __builtin_amdgcn_permlane32_swap(__float_as_uint(ps), __float_as_uint(ps), false, false);
      ps = __uint_as_float(rr[0]) + __uint_as_float(rr[1]); }
    l_reg = l_reg * alpha + ps;
#define PK4(P, BASE, OUT) do { unsigned a0 = cvtpk(P[BASE + 0], P[BASE + 1]), a1 = cvtpk(P[BASE + 2], P[BASE + 3]);   \
    unsigned b0 = cvtpk(P[BASE + 4], P[BASE + 5]), b1 = cvtpk(P[BASE + 6], P[BASE + 7]);                              \
    auto r0 = __builtin_amdgcn_permlane32_swap(a0, b0, false, false); auto r1 = __builtin_amdgcn_permlane32_swap(a1, b1, false, false); \
    u32x4 w = {r0[0], r1[0], r0[1], r1[1]}; OUT = *reinterpret_cast<bf16x8*>(&w); } while (0)
    PK4(p0, 0, pa0); PK4(p0, 8, pa1); PK4(p1, 0, pa2); PK4(p1, 8, pa3);
#undef PK4
}
template <int DK>
__device__ __forceinline__ void qkt(f32x16& p0, f32x16& p1, const char* Ks, const char* K2s, const bf16x8* qr, const char* q2, int r32, int hi) {
    constexpr int NQR = 8;
    p0 = f32x16{}; p1 = f32x16{};
#pragma unroll
    for (int d0 = 0; d0 < 8; ++d0) { const int cb = (d0 * 16 + hi * 8) * 2;
        const bf16x8 b0 = *reinterpret_cast<const bf16x8*>(Ks + KSWZ(r32, cb));
        const bf16x8 b1 = *reinterpret_cast<const bf16x8*>(Ks + KSWZ(32 + r32, cb));
        bf16x8 qf; if (d0 < NQR) qf = qr[d0 < NQR ? d0 : 0]; else qf = *reinterpret_cast<const bf16x8*>(q2 + (d0 - 8) * 1024);
        p0 = __builtin_amdgcn_mfma_f32_32x32x16_bf16(b0, qf, p0, 0, 0, 0);
        p1 = __builtin_amdgcn_mfma_f32_32x32x16_bf16(b1, qf, p1, 0, 0, 0); }
    if constexpr (DK == 192) {
#pragma unroll
        for (int d0 = 0; d0 < 4; ++d0) { const int cb = (d0 * 16 + hi * 8) * 2;
            const bf16x8 b0 = *reinterpret_cast<const bf16x8*>(K2s + KSWZ2(r32, cb));
            const bf16x8 b1 = *reinterpret_cast<const bf16x8*>(K2s + KSWZ2(32 + r32, cb));
            const bf16x8 qf = *reinterpret_cast<const bf16x8*>(q2 + d0 * 1024);
            p0 = __builtin_amdgcn_mfma_f32_32x32x16_bf16(b0, qf, p0, 0, 0, 0);
            p1 = __builtin_amdgcn_mfma_f32_32x32x16_bf16(b1, qf, p1, 0, 0, 0); }
    }
}
__device__ __forceinline__ int v_st(int k, int c) { const int kk = (k & ~0xC) | ((k & 4) << 1) | ((k & 8) >> 1); return ((kk >> 3) * 4 + (c >> 5)) * 512 + ((kk & 7) * 32 + (c & 31)) * 2; }
__device__ __forceinline__ int v_rd_base(int lane) { return ((lane & 3) << 3) | (((lane >> 2) & 3) << 6) | (((lane >> 4) & 1) << 5) | (((lane >> 5) & 1) << 8); }
constexpr int v_rd_off(int d0, int ks, int half) { return d0 * 512 + ks * 4096 + half * 2048; }
template <int OFF> __device__ __forceinline__ s16x4 tr_read(int vb) {
    s16x4 r; asm volatile("ds_read_b64_tr_b16 %0, %1 offset:%2" : "=&v"(r) : "v"(vb), "i"(OFF) : "memory"); return r;
}
struct VFrag { s16x4 l0, h0, l1, h1, l2, h2, l3, h3; };
template <int D0> __device__ __forceinline__ void v_load(VFrag& f, int vb) {
    f.l0 = tr_read<v_rd_off(D0, 0, 0)>(vb); f.h0 = tr_read<v_rd_off(D0, 0, 1)>(vb); f.l1 = tr_read<v_rd_off(D0, 1, 0)>(vb); f.h1 = tr_read<v_rd_off(D0, 1, 1)>(vb);
    f.l2 = tr_read<v_rd_off(D0, 2, 0)>(vb); f.h2 = tr_read<v_rd_off(D0, 2, 1)>(vb); f.l3 = tr_read<v_rd_off(D0, 3, 0)>(vb); f.h3 = tr_read<v_rd_off(D0, 3, 1)>(vb);
}
__device__ __forceinline__ void v_mma(f32x16& od, const VFrag& f, bf16x8 pa0, bf16x8 pa1, bf16x8 pa2, bf16x8 pa3) {
#define PK(L, H) (bf16x8){L[0], L[1], L[2], L[3], H[0], H[1], H[2], H[3]}
    od = __builtin_amdgcn_mfma_f32_32x32x16_bf16(pa0, PK(f.l0, f.h0), od, 0, 0, 0);
    od = __builtin_amdgcn_mfma_f32_32x32x16_bf16(pa1, PK(f.l1, f.h1), od, 0, 0, 0);
    od = __builtin_amdgcn_mfma_f32_32x32x16_bf16(pa2, PK(f.l2, f.h2), od, 0, 0, 0);
    od = __builtin_amdgcn_mfma_f32_32x32x16_bf16(pa3, PK(f.l3, f.h3), od, 0, 0, 0);
#undef PK
}
template <int D0> __device__ __forceinline__ void pv_one(f32x16& od, int vb, bf16x8 pa0, bf16x8 pa1, bf16x8 pa2, bf16x8 pa3) {
    VFrag f; v_load<D0>(f, vb);
    asm volatile("s_waitcnt lgkmcnt(0)" ::: "memory"); SBAR();
    v_mma(od, f, pa0, pa1, pa2, pa3);
}
template <bool PIPE> __device__ __forceinline__ void pv_d0(f32x16* o, int vb, bf16x8 pa0, bf16x8 pa1, bf16x8 pa2, bf16x8 pa3) {
    if constexpr (!PIPE) { pv_one<0>(o[0], vb, pa0, pa1, pa2, pa3); pv_one<1>(o[1], vb, pa0, pa1, pa2, pa3); pv_one<2>(o[2], vb, pa0, pa1, pa2, pa3); pv_one<3>(o[3], vb, pa0, pa1, pa2, pa3); return; }
    VFrag fa, fb;
    v_load<0>(fa, vb); v_load<1>(fb, vb);
    asm volatile("s_waitcnt lgkmcnt(8)" ::: "memory"); SBAR(); v_mma(o[0], fa, pa0, pa1, pa2, pa3); SBAR();
    v_load<2>(fa, vb);
    asm volatile("s_waitcnt lgkmcnt(8)" ::: "memory"); SBAR(); v_mma(o[1], fb, pa0, pa1, pa2, pa3); SBAR();
    v_load<3>(fb, vb);
    asm volatile("s_waitcnt lgkmcnt(8)" ::: "memory"); SBAR(); v_mma(o[2], fa, pa0, pa1, pa2, pa3); SBAR();
    asm volatile("s_waitcnt lgkmcnt(0)" ::: "memory"); SBAR(); v_mma(o[3], fb, pa0, pa1, pa2, pa3);
}
__device__ __forceinline__ void wmask(f32x16& p0, f32x16& p1, int base, int hi) {
#pragma unroll
    for (int r = 0; r < 16; ++r) { const int d0 = base + (r & 3) + 8 * (r >> 2) + 4 * hi, d1 = d0 + 32;
        if (d0 > 128 || d0 < -128) p0[r] = -1e30f; if (d1 > 128 || d1 < -128) p1[r] = -1e30f; }
}

template <int DK, bool WINDOW, bool SPLIT = false, int SD = 1>
__device__ __forceinline__ void attn_unit(const AUnit U, char* lds) {
    constexpr int ND0 = DK / 16;
    constexpr float SCALE = DK == 128 ? 0.08838834764831845f : 0.07216878364870323f, C = SCALE * 1.4426950408889634f;
    int tid_ = threadIdx.x; asm volatile("" : "+v"(tid_));
    const int tid = tid_, wid = __builtin_amdgcn_readfirstlane(tid >> 6), lane = tid & 63, r32 = lane & 31, hi = lane >> 5;
    char* V_lds = lds + OFF_V; char* K_lds = lds + OFF_K; char* K2_lds = lds + OFF_K2;
    float* ws = (float*)(lds + OFF_WS) + wid * 64; float* li_l = ws; float* al_l = ws + 32;
    float m_reg = -1e30f, l_reg = 0; f32x16 o[4] = {}; bf16x8 qr[8];
    char* q2 = lds + OFF_Q2 + wid * 6144 + lane * 16;
    const bf16_t* Qw = U.Q + (size_t)(wid * QBLK + r32) * U.ldq + hi * 8;
#pragma unroll
    for (int d0 = 0; d0 < 8; ++d0) qr[d0] = *reinterpret_cast<const bf16x8*>(Qw + d0 * 16);
    if constexpr (DK == 192) {
#pragma unroll
        for (int d0 = 8; d0 < 12; ++d0) *reinterpret_cast<bf16x8*>(q2 + (d0 - 8) * 1024) = *reinterpret_cast<const bf16x8*>(Qw + d0 * 16);
    }
    const int sr = tid >> 4, sc = (tid & 15) * 8, vst0 = v_st(sr, sc), vst1 = v_st(32 + sr, sc);
    const int sr2 = tid >> 3, sc2 = (tid & 7) * 8;
    const int vb0 = (int)(uintptr_t)V_lds + v_rd_base(lane);
    bf16x8 vsE0, vsE1, ksE0, ksE1, k2E, vsO0, vsO1, ksO0, ksO1, k2O;
    const int NT = U.nct + U.ntl, nct = U.nct;
#define SLOAD(S, t) do { const int t_ = (t); const bool cx_ = t_ < nct; const long ro_ = (long)((cx_ ? t_ : t_ - nct) * KVBLK); \
    const bf16_t* kb_ = U.KV + ((cx_ ? U.kc : U.kl) + ro_ * U.ldk); const bf16_t* vb_ = U.KV + ((cx_ ? U.vc : U.vl) + ro_ * U.ldv); \
    vs##S##0 = *reinterpret_cast<const bf16x8*>(vb_ + (long)sr * U.ldv + sc); vs##S##1 = *reinterpret_cast<const bf16x8*>(vb_ + (long)(32 + sr) * U.ldv + sc); \
    ks##S##0 = *reinterpret_cast<const bf16x8*>(kb_ + (long)sr * U.ldk + sc); ks##S##1 = *reinterpret_cast<const bf16x8*>(kb_ + (long)(32 + sr) * U.ldk + sc); \
    if constexpr (DK == 192) { const bf16_t* k2_ = U.K2 + ((cx_ ? U.k2c : U.k2l) + ro_ * U.ldk2); k2##S = *reinterpret_cast<const bf16x8*>(k2_ + (long)sr2 * U.ldk2 + sc2); } } while (0)
#define SWRITE(b, S) do { *(bf16x8*)(V_lds + (b) * SHM_V + vst0) = vs##S##0; *(bf16x8*)(V_lds + (b) * SHM_V + vst1) = vs##S##1; const int kc_ = sc * 2; \
    *(bf16x8*)(K_lds + (b) * SHM_K + KSWZ(sr, kc_)) = ks##S##0; *(bf16x8*)(K_lds + (b) * SHM_K + KSWZ(32 + sr, kc_)) = ks##S##1; \
    if constexpr (DK == 192) { *(bf16x8*)(K2_lds + (b) * SHM_K2 + KSWZ2(sr2, sc2 * 2)) = k2##S; } } while (0)
#define RESC(a) do { if (__any((a) < 1.f)) { if (hi == 0) al_l[r32] = (a); asm volatile("s_waitcnt lgkmcnt(0)" ::: "memory"); \
    _Pragma("unroll") for (int d = 0; d < 4; ++d) _Pragma("unroll") for (int r = 0; r < 16; ++r) o[d][r] *= al_l[crow(r, hi)]; } } while (0)
#define WMASK(P0, P1, t) do { if constexpr (WINDOW) { if ((t) >= 4) wmask(P0, P1, U.qk_off + ((t) - 4) * KVBLK - wid * QBLK - r32, hi); } } while (0)
    f32x16 pA0, pA1, pB0, pB1; float mnA, mnB, alA, alB; bf16x8 pa0, pa1, pa2, pa3;
    SLOAD(E, 0); SWRITE(0, E); __syncthreads();
    qkt<DK>(pA0, pA1, K_lds, K2_lds, qr, q2, r32, hi); partialSM<DK>(pA0, pA1, m_reg, mnA, alA);
    if constexpr (SD == 2) { SLOAD(O, 1); SLOAD(E, 2); SWRITE(1, O); } else { SLOAD(E, 1); SWRITE(1, E); }
    __syncthreads();
    for (int j = 1; j + 1 < NT; j += 2) {
        SBAR(); qkt<DK>(pB0, pB1, K_lds + SHM_K, K2_lds + SHM_K2, qr, q2, r32, hi); WMASK(pB0, pB1, j);
        finishSM(pA0, pA1, alA, l_reg, pa0, pa1, pa2, pa3); SBAR();
        if constexpr (SD == 2) SLOAD(O, j + 2); else SLOAD(E, j + 1);
        SBAR();
        pv_d0<false>(o, vb0, pa0, pa1, pa2, pa3); partialSM<DK>(pB0, pB1, m_reg, mnB, alB);
        __syncthreads(); SWRITE(0, E);
        RESC(alB); __syncthreads();
        SBAR(); qkt<DK>(pA0, pA1, K_lds, K2_lds, qr, q2, r32, hi); WMASK(pA0, pA1, j + 1);
        finishSM(pB0, pB1, alB, l_reg, pa0, pa1, pa2, pa3); SBAR();
        if constexpr (SD == 2) { if (j + 3 < NT) SLOAD(E, j + 3); } else SLOAD(E, j + 2);
        SBAR();
        pv_d0<false>(o, vb0 + SHM_V, pa0, pa1, pa2, pa3); partialSM<DK>(pA0, pA1, m_reg, mnA, alA);
        __syncthreads();
        if constexpr (SD == 2) SWRITE(1, O); else SWRITE(1, E);
        RESC(alA); __syncthreads();
    }
    SBAR(); qkt<DK>(pB0, pB1, K_lds + SHM_K, K2_lds + SHM_K2, qr, q2, r32, hi); WMASK(pB0, pB1, NT - 1);
    finishSM(pA0, pA1, alA, l_reg, pa0, pa1, pa2, pa3); SBAR();
    pv_d0<false>(o, vb0, pa0, pa1, pa2, pa3); partialSM<DK>(pB0, pB1, m_reg, mnB, alB);
    __syncthreads(); RESC(alB);
    finishSM(pB0, pB1, alB, l_reg, pa0, pa1, pa2, pa3); SBAR();
    pv_d0<false>(o, vb0 + SHM_V, pa0, pa1, pa2, pa3);
    if constexpr (SPLIT) {
        float* dmp = U.part_own + (size_t)(wid * 66) * 64 + lane;
#pragma unroll
        for (int d = 0; d < 4; ++d)
#pragma unroll
            for (int r = 0; r < 16; ++r) dmp[(d * 16 + r) * 64] = o[d][r];
        dmp[64 * 64] = m_reg; dmp[65 * 64] = l_reg;
        asm volatile("s_waitcnt vmcnt(0)" ::: "memory"); __syncthreads();
        volatile unsigned* flg = (volatile unsigned*)(lds + OFF_FLG);
        if (tid == 0) {
            __builtin_amdgcn_fence(__ATOMIC_RELEASE, "agent"); asm volatile("s_waitcnt vmcnt(0)" ::: "memory");
            const unsigned old = __hip_atomic_fetch_add(U.cnt, 1u, __ATOMIC_RELAXED, __HIP_MEMORY_SCOPE_AGENT);
            if (old != 0u) { __builtin_amdgcn_fence(__ATOMIC_ACQUIRE, "agent"); asm volatile("s_waitcnt vmcnt(0)" ::: "memory"); }
            flg[0] = old;
        }
        __syncthreads();
        if (flg[0] == 0u) { __syncthreads(); return; }
        const float* oth = U.part_oth + (size_t)(wid * 66) * 64 + lane;
        const float m2 = oth[64 * 64], l2 = oth[65 * 64];
        const float mm = fmaxf(m_reg, m2), w1 = __builtin_amdgcn_exp2f((m_reg - mm) * C), w2 = __builtin_amdgcn_exp2f((m2 - mm) * C);
        l_reg = l_reg * w1 + l2 * w2; m_reg = mm;
        if (hi == 0) { li_l[r32] = w1; al_l[r32] = w2; }
        asm volatile("s_waitcnt lgkmcnt(0)" ::: "memory");
#pragma unroll
        for (int d = 0; d < 4; ++d)
#pragma unroll
            for (int r = 0; r < 16; ++r) o[d][r] = o[d][r] * li_l[crow(r, hi)] + oth[(d * 16 + r) * 64] * al_l[crow(r, hi)];
        asm volatile("s_waitcnt lgkmcnt(0)" ::: "memory");
    }
    l_reg += __builtin_amdgcn_exp2f(U.sink * 1.4426950408889634f - m_reg * C);
    if (hi == 0) li_l[r32] = l_reg; asm volatile("s_waitcnt lgkmcnt(0)" ::: "memory");
    float rli[16];
#pragma unroll
    for (int r = 0; r < 16; ++r) rli[r] = __builtin_amdgcn_rcpf(li_l[crow(r, hi)]);
    __syncthreads();
    bf16_t* stg = (bf16_t*)(lds + wid * 8192);
#pragma unroll
    for (int r = 0; r < 16; ++r) { const int orow = crow(r, hi);
#pragma unroll
        for (int d0 = 0; d0 < 4; ++d0) { const float v = o[d0][r] * rli[r]; stg[orow * 128 + d0 * 32 + r32] = (bf16_t)(cvtpk(v, v) & 0xffffu); } }
    asm volatile("s_waitcnt lgkmcnt(0)" ::: "memory");
    bf16_t* Ow = U.O + (size_t)(wid * QBLK) * U.ldo;
#pragma unroll
    for (int i = 0; i < 8; ++i) { const int row = i * 4 + (lane >> 4), ch = lane & 15; const u32x4 v = *(const u32x4*)(stg + row * 128 + ch * 8); gst16(Ow + (size_t)row * U.ldo + ch * 8, v); }
    __syncthreads();
#undef SLOAD
#undef SWRITE
#undef RESC
#undef WMASK
}
#undef KSWZ
#undef KSWZ2
#undef SBAR
}

#ifndef MERGE_POST
#define MERGE_POST 1
#endif
#ifndef COUNTED_NEXT
#define COUNTED_NEXT 0
#endif
#ifndef MERGE_THIN
#define MERGE_THIN 1
#endif
namespace mk {
constexpr int NWAVES = 8;
constexpr int D = 2048, SEQ = 4096, LCTX = 256, NL = 8192, NC = 512, NR = 8704, DEPTH = 4;
constexpr int DIN = 3392, NIN = 3584  , DFF = 5632;
constexpr int O_AQ = 0, O_AK = 768, O_AV = 1024, O_BQ = 1280, O_BK = 2048, O_BV = 2304, O_CQ = 2560, O_CKV = 3072, O_CKR = 3328;
constexpr float EPS = 1e-6f;
typedef unsigned short bf16;
typedef float f32x4 __attribute__((ext_vector_type(4)));
typedef float f32x2 __attribute__((ext_vector_type(2)));
typedef unsigned u32x4v __attribute__((ext_vector_type(4)));
typedef unsigned u32x2v __attribute__((ext_vector_type(2)));

constexpr size_t MiB = 1u << 20;
constexpr size_t WS_CTL = 0, CTL_ZERO_BYTES = 1 * MiB;
constexpr size_t WS_MODV = 2 * MiB;
constexpr size_t WS_COMB = 3 * MiB;
constexpr size_t WS_TAB128 = 4 * MiB, WS_TAB64 = 4 * MiB + 16384;
constexpr size_t WS_SSQ = 5 * MiB;
constexpr size_t WS_SSQB = 6 * MiB;
constexpr size_t WS_W = 8 * MiB;
constexpr size_t W_IN = 0, W_UQ = W_IN + (size_t)NIN * D * 2, W_UKV = W_UQ + (size_t)768 * 512 * 2, W_OUT = W_UKV + (size_t)1024 * 256 * 2,
                 W_13 = W_OUT + (size_t)D * D * 2, W_2 = W_13 + (size_t)2 * DFF * D * 2, W_LAYER = W_2 + (size_t)D * DFF * 2;
constexpr size_t WS_X = WS_W + DEPTH * W_LAYER;
constexpr size_t WS_H = WS_X + (size_t)NR * D * 4;
constexpr size_t WS_P = WS_H + (size_t)NR * D * 2;
constexpr size_t WS_QC = WS_P + (size_t)NR * NIN * 2;
constexpr size_t WS_KVC = WS_QC + (size_t)NR * 768 * 2;
constexpr size_t WS_CAT = WS_KVC + (size_t)NR * 1024 * 2;
constexpr size_t WS_OF = WS_CAT + (size_t)NR * D * 2;
constexpr size_t WS_U = WS_OF + (size_t)NR * D * 2;
constexpr size_t WS_OFP = WS_U + (size_t)NR * DFF * 2;
#ifndef IN_CQ_FIRST
#define IN_CQ_FIRST 1
#endif
constexpr int NP_OUT = 8, NP_F2 = 11;
constexpr size_t WS_PART = WS_OFP + (size_t)NP_F2 * NC * D * 2;
constexpr size_t WS_END = WS_PART + (size_t)64 * 2 * 33792 * 4;
static_assert(W_LAYER % 256 == 0 && WS_X % 256 == 0, "alignment");
constexpr int CW_BAR = 4096;
constexpr int CW_CONVQ = 8192;
constexpr int CW_ATTQ = 8192 + 64;
constexpr int CW_PAN = 40960;
constexpr int CW_SPLIT = 16384;

constexpr int RING_BYTES = 139264  , LDSCTL_OFF = RING_BYTES, MISC_OFF = LDSCTL_OFF + 320, LDS_BYTES = 147456;

#define GAS __attribute__((address_space(1)))
#define LAS __attribute__((address_space(3)))
#define LDS_WAIT() asm volatile("s_waitcnt lgkmcnt(0)" ::: "memory")
#define VM_WAIT() asm volatile("s_waitcnt vmcnt(0)" ::: "memory")
__device__ __forceinline__ unsigned cvtpk(float lo, float hi) { unsigned r; asm volatile("v_cvt_pk_bf16_f32 %0, %1, %2" : "=v"(r) : "v"(lo), "v"(hi)); return r; }
__device__ __forceinline__ float bf_lo(unsigned w) { return __uint_as_float(w << 16); }
__device__ __forceinline__ float bf_hi(unsigned w) { return __uint_as_float(w & 0xffff0000u); }

#define XB_TMO      128
#define XB_XCNT(j)  (256  + 64 * (j))
#define XB_XSUB(j)  (1280 + 64 * (j))
#define XB_XGEN(j)  (2304 + 64 * (j))
#define XB_TOP      3328
#define XB_TOPGEN   3392
#define XCD_BAR_WORDS 3456
#define XB_SPIN_CAP (1u << 18)
__device__ __forceinline__ unsigned xb_ld(unsigned* p)              { return __hip_atomic_load(p, __ATOMIC_RELAXED, __HIP_MEMORY_SCOPE_AGENT); }
__device__ __forceinline__ unsigned xb_add(unsigned* p, unsigned v) { return __hip_atomic_fetch_add(p, v, __ATOMIC_RELAXED, __HIP_MEMORY_SCOPE_AGENT); }
__device__ __forceinline__ unsigned xb_xcc_id() { return (unsigned)__builtin_amdgcn_s_getreg((3 << 11) | 20) & 0xFu; }
#define XB_SPIN(cond, bar) do { unsigned _sp = 0; while (cond) { __builtin_amdgcn_s_sleep(1); \
    if ((++_sp & 255u) == 0u) { if (xb_ld(&(bar)[XB_TMO])) break; if (_sp > XB_SPIN_CAP) { atomicAdd(&(bar)[XB_TMO], 1u); break; } } } } while (0)
struct XcdBarrier { unsigned* bar; unsigned x; volatile LAS unsigned* st; };
__device__ __forceinline__ XcdBarrier xcd_barrier_post(unsigned* bar, volatile LAS unsigned* st) {
    XcdBarrier b; b.bar = bar; b.x = xb_xcc_id(); b.st = st;
    if (threadIdx.x == 0) (void)xb_add(&bar[XB_XCNT(b.x)], 1u);
    return b;
}
__device__ __forceinline__ void xcd_barrier_complete(unsigned* bar, unsigned x, unsigned& nloc, unsigned& nx) {
    const unsigned G = gridDim.x * gridDim.y * gridDim.z;
    unsigned sum, cnt, mine, sp = 0u;
    for (;;) {
        sum = 0u; cnt = 0u; mine = 0u;
#pragma unroll
        for (unsigned j = 0; j < 16; ++j) { const unsigned c = xb_ld(&bar[XB_XCNT(j)]); sum += c; cnt += (c > 0u) ? 1u : 0u; mine = (j == x) ? c : mine; }
        if (sum == G) break;
        __builtin_amdgcn_s_sleep(1);
        if ((++sp & 255u) == 0u) { if (xb_ld(&bar[XB_TMO])) break; if (sp > XB_SPIN_CAP) { atomicAdd(&bar[XB_TMO], 1u); break; } }
    }
    nloc = mine > 0u ? mine : 1u; nx = cnt > 0u ? cnt : 1u;
}
__device__ __forceinline__ void xcd_barrier(const XcdBarrier& b) {
    asm volatile("s_waitcnt vmcnt(0)" ::: "memory");
    __syncthreads();
    if (threadIdx.x == 0) {
        unsigned* bar = b.bar;
        __builtin_amdgcn_s_waitcnt(0);
        unsigned nloc = b.st[0], nx = b.st[1];
        if (nloc == 0u) { xcd_barrier_complete(bar, b.x, nloc, nx); b.st[0] = nloc; b.st[1] = nx; }
        const unsigned old = xb_add(&bar[XB_XSUB(b.x)], 1u);
        const unsigned gen = old / nloc;
        if (old + 1u == (gen + 1u) * nloc) {
            __builtin_amdgcn_fence(__ATOMIC_RELEASE, "agent");
            asm volatile("s_waitcnt vmcnt(0)" ::: "memory");
            const unsigned og = xb_add(&bar[XB_TOP], 1u);
            const unsigned tg = og / nx;
            if (og + 1u == (tg + 1u) * nx) xb_add(&bar[XB_TOPGEN], 1u);
            else XB_SPIN(xb_ld(&bar[XB_TOPGEN]) == tg, bar);
            __builtin_amdgcn_fence(__ATOMIC_ACQUIRE, "agent");
            xb_add(&bar[XB_XGEN(b.x)], 1u);
            asm volatile("s_waitcnt vmcnt(0)" ::: "memory");
        } else {
            XB_SPIN(xb_ld(&bar[XB_XGEN(b.x)]) == gen, bar);
            __builtin_amdgcn_fence(__ATOMIC_ACQUIRE, "agent");
            asm volatile("s_waitcnt vmcnt(0)" ::: "memory");
        }
    }
    __syncthreads();
}

struct Args { const float* in[22]; float* out; unsigned char* ws; int ph_lo, ph_hi; };
enum { I_X = 0, I_C, I_CTX, I_CCTX, I_WMOD, I_BMOD, I_GMIXPRE, I_GMIXPOST, I_GFFNPRE, I_GFFNPOST, I_WIN, I_SINK, I_GQN, I_GKN, I_GCQ, I_WUQ, I_GCKV, I_WUKV, I_WOUT, I_W1, I_W3, I_W2 };

__device__ __forceinline__ float wave_sum(float v) {
#pragma unroll
    for (int o = 1; o < 64; o <<= 1) v += __shfl_xor(v, o);
    return v;
}
__device__ __forceinline__ int row_s(int r) { return r < NL ? (r >> 12) : 2; }

__device__ __forceinline__ void transpose_item(const float* W, int N, int k0, int n0, bf16* WTrow0, int ldt, const float* kgain, LAS float* scr, int lane, bool permute = false) {
    f32x4 v[16];
    const float* src = W + (size_t)(k0 + (lane >> 4)) * N + n0 + 4 * (lane & 15);
#pragma unroll
    for (int i = 0; i < 16; ++i) v[i] = *(const f32x4*)(src + (size_t)(4 * i) * N);
#pragma unroll
    for (int i = 0; i < 16; ++i) { const int kk = 4 * i + (lane >> 4); const float g = kgain ? kgain[k0 + kk] : 1.f; LAS float* d = scr + kk * 65 + 4 * (lane & 15);
        d[0] = v[i][0] * g; d[1] = v[i][1] * g; d[2] = v[i][2] * g; d[3] = v[i][3] * g; }
    LDS_WAIT(); asm volatile("" ::: "memory");
    const int c = lane & 7;
#pragma unroll
    for (int j = 0; j < 8; ++j) { const int n = (lane >> 3) + 8 * j; const LAS float* s = scr + (8 * c) * 65 + n;
        u32x4v o; o.x = cvtpk(s[0 * 65], s[1 * 65]); o.y = cvtpk(s[2 * 65], s[3 * 65]); o.z = cvtpk(s[4 * 65], s[5 * 65]); o.w = cvtpk(s[6 * 65], s[7 * 65]);
        gst16(WTrow0 + (size_t)(permute ? pg8::perm64(n) : n) * ldt + k0 + 8 * c, o); }
    LDS_WAIT(); asm volatile("" ::: "memory");
}
constexpr int IT_IN = (D / 64) * (DIN / 64), IT_UQ = (512 / 64) * (768 / 64), IT_UKV = (256 / 64) * (1024 / 64), IT_OUT = (D / 64) * (D / 64), IT_1 = (D / 64) * (DFF / 64), IT_2 = (DFF / 64) * (D / 64);
constexpr int IT_LAYER = IT_IN + IT_UQ + IT_UKV + IT_OUT + 2 * IT_1 + IT_2, IT_ALL = DEPTH * IT_LAYER, CONV_CHUNKS = (IT_LAYER + 47) / 48;
static_assert(CONV_CHUNKS == 236, "the attention queue's entry map is written for 236 conversion chunks");
__device__ __forceinline__ void conv_item(const Args& a, int it, LAS float* scr, int lane) {
    const int l = it / IT_LAYER; int r = it % IT_LAYER;
    unsigned char* wl = a.ws + WS_W + (size_t)l * W_LAYER;
    if (r < IT_IN)  { const int nb = DIN / 64, kb = r / nb, n0 = (r % nb) * 64; const bool pm_ = (ROPE_EPI_A && n0 < O_AV) || (ROPE_EPI_B && n0 >= O_BQ && n0 < O_BV);
        transpose_item(a.in[I_WIN] + (size_t)l * D * DIN, DIN, kb * 64, n0, (bf16*)(wl + W_IN) + (size_t)n0 * D, D, nullptr, scr, lane, pm_); return; } r -= IT_IN;
    if (r < IT_UQ)  { const int nb = 768 / 64, kb = r / nb, n0 = (r % nb) * 64; transpose_item(a.in[I_WUQ] + (size_t)l * 512 * 768, 768, kb * 64, n0, (bf16*)(wl + W_UQ) + (size_t)n0 * 512, 512, a.in[I_GCQ] + l * 512, scr, lane); return; } r -= IT_UQ;
    if (r < IT_UKV) { const int nb = 1024 / 64, kb = r / nb, n0 = (r % nb) * 64; transpose_item(a.in[I_WUKV] + (size_t)l * 256 * 1024, 1024, kb * 64, n0, (bf16*)(wl + W_UKV) + (size_t)n0 * 256, 256, a.in[I_GCKV] + l * 256, scr, lane); return; } r -= IT_UKV;
    if (r < IT_OUT) { const int nb = D / 64, kb = r / nb, n0 = (r % nb) * 64; transpose_item(a.in[I_WOUT] + (size_t)l * D * D, D, kb * 64, n0, (bf16*)(wl + W_OUT) + (size_t)n0 * D, D, nullptr, scr, lane); return; } r -= IT_OUT;
    if (r < 2 * IT_1) { const int which = r / IT_1; r %= IT_1; const int nb = DFF / 64, kb = r / nb, n0 = (r % nb) * 64;
        const int drow = (n0 / 128) * 256 + which * 128 + (n0 % 128);
        transpose_item(a.in[which ? I_W3 : I_W1] + (size_t)l * D * DFF, DFF, kb * 64, n0, (bf16*)(wl + W_13) + (size_t)drow * D, D, nullptr, scr, lane); return; } r -= 2 * IT_1;
    { const int nb = D / 64, kb = r / nb, n0 = (r % nb) * 64; transpose_item(a.in[I_W2] + (size_t)l * DFF * D, D, kb * 64, n0, (bf16*)(wl + W_2) + (size_t)n0 * DFF, DFF, nullptr, scr, lane); }
}
__device__ __forceinline__ void mod_unit(const Args& a, int u, LAS unsigned char* lds, int tid, int wave, int lane) {
    const int l = u / 48, nc = u % 48;
    LAS float* sc = (LAS float*)lds;
    LAS float* red = (LAS float*)(lds + 24576);
    for (int i = tid; i < 3 * D; i += NWAVES * 64) { const int s = i / D, k = i % D; const float v = s < 2 ? a.in[I_C][s * D + k] : a.in[I_CCTX][k]; sc[i] = v / (1.f + expf(-v)); }
    LDS_WAIT(); __syncthreads();
    const float* w = a.in[I_WMOD] + (size_t)l * D * 6 * D + (size_t)(wave * 256) * 6 * D + nc * 256 + lane * 4;
    f32x4 a0 = {0.f, 0.f, 0.f, 0.f}, a1 = a0, a2 = a0;
    for (int k = 0; k < 256; k += 8) {
        f32x4 wv[8];
#pragma unroll
        for (int j = 0; j < 8; ++j) wv[j] = *(const f32x4*)(w + (size_t)(k + j) * 6 * D);
#pragma unroll
        for (int j = 0; j < 8; ++j) { const int kk = wave * 256 + k + j; a0 += wv[j] * sc[kk]; a1 += wv[j] * sc[D + kk]; a2 += wv[j] * sc[2 * D + kk]; }
    }
    *(LAS f32x4*)(red + (wave * 3 + 0) * 256 + lane * 4) = a0; *(LAS f32x4*)(red + (wave * 3 + 1) * 256 + lane * 4) = a1; *(LAS f32x4*)(red + (wave * 3 + 2) * 256 + lane * 4) = a2;
    LDS_WAIT(); __syncthreads();
    for (int i = tid; i < 768; i += NWAVES * 64) { const int s = i >> 8, cidx = i & 255; float v = 0.f;
#pragma unroll
        for (int wv = 0; wv < 8; ++wv) v += red[(wv * 3 + s) * 256 + cidx];
        ((float*)(a.ws + WS_MODV))[(size_t)(l * 3 + s) * 6 * D + nc * 256 + cidx] = v + a.in[I_BMOD][l * 6 * D + nc * 256 + cidx]; }
    LDS_WAIT(); __syncthreads();
}

struct RowF { f32x4 v[8]; };
__device__ __forceinline__ void ld_row_f32(RowF& r, const float* p, int lane) {
#pragma unroll
    for (int j = 0; j < 8; ++j) r.v[j] = *(const f32x4*)(p + 4 * lane + 256 * j);
}
__device__ __forceinline__ void ld_row_bf16(RowF& r, const bf16* p, int lane) {
#pragma unroll
    for (int j = 0; j < 8; ++j) { const u32x2v w = *(const u32x2v*)(p + 4 * lane + 256 * j); r.v[j] = (f32x4){bf_lo(w.x), bf_hi(w.x), bf_lo(w.y), bf_hi(w.y)}; }
}
typedef _Float16 f16x4 __attribute__((ext_vector_type(4)));
__device__ __forceinline__ void ld_row_f16(RowF& r, const _Float16* p, int lane) {
#pragma unroll
    for (int j = 0; j < 8; ++j) { const f16x4 w = *(const f16x4*)(p + 4 * lane + 256 * j); r.v[j] = (f32x4){(float)w[0], (float)w[1], (float)w[2], (float)w[3]}; }
}
__device__ __forceinline__ void st_row_f16(_Float16* p, const RowF& r, int lane) {
#pragma unroll
    for (int j = 0; j < 8; ++j) { f16x4 w = {(_Float16)r.v[j][0], (_Float16)r.v[j][1], (_Float16)r.v[j][2], (_Float16)r.v[j][3]}; gst8(p + 4 * lane + 256 * j, __builtin_bit_cast(wt_u32x2, w)); }
}
__device__ __forceinline__ float row_ssq(const RowF& r) {
    float s = 0.f;
#pragma unroll
    for (int j = 0; j < 8; ++j) s += (r.v[j][0] * r.v[j][0] + r.v[j][1] * r.v[j][1]) + (r.v[j][2] * r.v[j][2] + r.v[j][3] * r.v[j][3]);
    return wave_sum(s);
}
__device__ __forceinline__ void st_row_bf16(bf16* p, const RowF& r, int lane) {
#pragma unroll
    for (int j = 0; j < 8; ++j) { u32x2v w; w.x = cvtpk(r.v[j][0], r.v[j][1]); w.y = cvtpk(r.v[j][2], r.v[j][3]); gst8(p + 4 * lane + 256 * j, w); }
}
__device__ __forceinline__ void st_row_f32(float* p, const RowF& r, int lane) {
#pragma unroll
    for (int j = 0; j < 8; ++j) gst16(p + 4 * lane + 256 * j, __builtin_bit_cast(wt_u32x4, r.v[j]));
}
__device__ __forceinline__ const float* comb_vec(const Args& a, int l, int s, int q) { return (const float*)(a.ws + WS_COMB) + ((size_t)(l * 3 + s) * 6 + q) * D; }

__device__ __forceinline__ void resid_norm_row(const float* xin32, const _Float16* xin16, float* xout32, _Float16* xout16, const bf16* y, const float* G, const float* A, const float* Bv, bf16* h, int lane, float oscale = 1.f, int nparts = 1, size_t pstride = 0) {
    RowF x, t; if (xin32) ld_row_f32(x, xin32, lane); else ld_row_f16(x, xin16, lane);
    ld_row_bf16(t, y, lane);
    for (int p = 1; p < nparts; ++p) { RowF t2; ld_row_bf16(t2, y + (size_t)p * pstride, lane);
#pragma unroll
        for (int j = 0; j < 8; ++j) t.v[j] += t2.v[j]; }
    const float rstd_y = rsqrtf(row_ssq(t) * (1.f / D) + EPS);
    RowF g; ld_row_f32(g, G, lane);
#pragma unroll
    for (int j = 0; j < 8; ++j) x.v[j] += g.v[j] * (t.v[j] * rstd_y);
#if defined(PROBE_A)
#pragma unroll
    for (int j = 0; j < 8; ++j) x.v[j] *= oscale;
#endif
    if (xout32) st_row_f32(xout32, x, lane); else st_row_f16(xout16, x, lane);
    if (h) {
        const float rstd_x = rsqrtf(row_ssq(x) * (1.f / D) + EPS);
        ld_row_f32(g, A, lane); ld_row_f32(t, Bv, lane);
#pragma unroll
        for (int j = 0; j < 8; ++j) x.v[j] = (x.v[j] * rstd_x) * g.v[j] + t.v[j];
        if (MERGE_THIN) { _Pragma("unroll") for (int j = 0; j < 8; ++j) { u32x2v w; w.x = cvtpk(x.v[j][0], x.v[j][1]); w.y = cvtpk(x.v[j][2], x.v[j][3]); gst8_wt(h + 4 * lane + 256 * j, w); } }
        else st_row_bf16(h, x, lane);
    }
}

__device__ __forceinline__ void resid_norm_row2(const float* xin32, const _Float16* xin16, float* xout32, _Float16* xout16, const bf16* y, const float* G, const float* A, const float* Bv, bf16* h, int lane) {
    RowF x0, x1, t0, t1;
    if (xin32) { ld_row_f32(x0, xin32, lane); ld_row_f32(x1, xin32 + D, lane); } else { ld_row_f16(x0, xin16, lane); ld_row_f16(x1, xin16 + D, lane); }
    ld_row_bf16(t0, y, lane); ld_row_bf16(t1, y + D, lane);
    RowF g; ld_row_f32(g, G, lane);
    const float ry0 = rsqrtf(row_ssq(t0) * (1.f / D) + EPS), ry1 = rsqrtf(row_ssq(t1) * (1.f / D) + EPS);
#pragma unroll
    for (int j = 0; j < 8; ++j) { x0.v[j] += g.v[j] * (t0.v[j] * ry0); x1.v[j] += g.v[j] * (t1.v[j] * ry1); }
    if (xout32) { st_row_f32(xout32, x0, lane); st_row_f32(xout32 + D, x1, lane); } else { st_row_f16(xout16, x0, lane); st_row_f16(xout16 + D, x1, lane); }
    if (h) {
        ld_row_f32(g, A, lane); ld_row_f32(t0, Bv, lane);
        const float rx0 = rsqrtf(row_ssq(x0) * (1.f / D) + EPS), rx1 = rsqrtf(row_ssq(x1) * (1.f / D) + EPS);
#pragma unroll
        for (int j = 0; j < 8; ++j) { x0.v[j] = (x0.v[j] * rx0) * g.v[j] + t0.v[j]; x1.v[j] = (x1.v[j] * rx1) * g.v[j] + t0.v[j]; }
#pragma unroll
        for (int j = 0; j < 8; ++j) { u32x2v w; w.x = cvtpk(x0.v[j][0], x0.v[j][1]); w.y = cvtpk(x0.v[j][2], x0.v[j][3]); gst8_wt(h + 4 * lane + 256 * j, w);
            w.x = cvtpk(x1.v[j][0], x1.v[j][1]); w.y = cvtpk(x1.v[j][2], x1.v[j][3]); gst8_wt(h + D + 4 * lane + 256 * j, w); }
    }
}

__device__ __forceinline__ void post_row(bf16* prow_, int r, const float* tab128, const float* tab64, const float* ssqb, const f32x4 gq, const f32x4 gk, int lane) {
    const bool lat = r < NL; const int t = r & 4095, pr = t >> 6, pc = t & 63;
    const int hl = lane & 31, half = hl >> 4, q = hl & 15, i0 = 4 * (q & 7);
    const int pos = half ? pc : pr;
    f32x4 cs = {1.f, 1.f, 1.f, 1.f}, sn = {0.f, 0.f, 0.f, 0.f};
    if (lat && (!ROPE_EPI_A || !ROPE_EPI_B)) { const f32x4 t0 = *(const f32x4*)(tab128 + (size_t)(pos * 32 + i0) * 2), t1 = *(const f32x4*)(tab128 + (size_t)(pos * 32 + i0) * 2 + 4);
        cs = (f32x4){t0[0], t0[2], t1[0], t1[2]}; sn = (f32x4){t0[1], t0[3], t1[1], t1[3]}; }
    const bool first = q < 8;
#pragma unroll
    for (int sgi = 0; sgi < 8; ++sgi) {
        const bool isB = sgi >= 4;
        if (!isB && ROPE_EPI_A) continue;
        const int col = sgi < 3 ? O_AQ + 256 * sgi : sgi == 3 ? O_AK : sgi < 7 ? O_BQ + 256 * (sgi - 4) : O_BK;
        const f32x4 gg = sgi == 7 ? gk : gq;
        bf16* p = prow_ + col + 4 * lane;
        const u32x2v w = *(const u32x2v*)p;
        f32x4 v = {bf_lo(w.x), bf_hi(w.x), bf_lo(w.y), bf_hi(w.y)};
        if (isB && ROPE_EPI_B) {
            const f32x4 sq = *(const f32x4*)(ssqb + (size_t)r * 32 + ((sgi - 4) * 2 + (lane >> 5)) * 4);
            v = v * rsqrtf(((sq[0] + sq[1]) + (sq[2] + sq[3])) * (1.f / 128.f) + EPS);
            u32x2v ow; ow.x = cvtpk(v[0], v[1]); ow.y = cvtpk(v[2], v[3]); gst8(p, ow); continue; }
        if (isB) { float ss = (v[0] * v[0] + v[1] * v[1]) + (v[2] * v[2] + v[3] * v[3]);
            ss += __shfl_xor(ss, 1); ss += __shfl_xor(ss, 2); ss += __shfl_xor(ss, 4); ss += __shfl_xor(ss, 8); ss += __shfl_xor(ss, 16);
            v = v * rsqrtf(ss * (1.f / 128.f) + EPS) * gg; }
        f32x4 pv; pv[0] = __shfl_xor(v[0], 8); pv[1] = __shfl_xor(v[1], 8); pv[2] = __shfl_xor(v[2], 8); pv[3] = __shfl_xor(v[3], 8);
        const f32x4 o = first ? v * cs - pv * sn : v * cs + pv * sn;
        u32x2v ow; ow.x = cvtpk(o[0], o[1]); ow.y = cvtpk(o[2], o[3]);
        if (lat || isB) gst8(p, ow);
    }
    if (lat && !ROPE_EPI_R) {
        const int l16 = lane & 15, h2 = l16 >> 3, q2 = l16 & 7, j0 = 4 * (q2 & 3); const int pos2 = h2 ? pc : pr;
        const f32x4 t0 = *(const f32x4*)(tab64 + (size_t)(pos2 * 16 + j0) * 2), t1 = *(const f32x4*)(tab64 + (size_t)(pos2 * 16 + j0) * 2 + 4);
        const f32x4 c2 = {t0[0], t0[2], t1[0], t1[2]}, s2 = {t0[1], t0[3], t1[1], t1[3]};
        bf16* p = prow_ + O_CKR + 4 * l16;
        const u32x2v w = *(const u32x2v*)p;
        const f32x4 v = {bf_lo(w.x), bf_hi(w.x), bf_lo(w.y), bf_hi(w.y)};
        f32x4 pv; pv[0] = __shfl_xor(v[0], 4); pv[1] = __shfl_xor(v[1], 4); pv[2] = __shfl_xor(v[2], 4); pv[3] = __shfl_xor(v[3], 4);
        const f32x4 o = (q2 < 4) ? v * c2 - pv * s2 : v * c2 + pv * s2;
        u32x2v ow; ow.x = cvtpk(o[0], o[1]); ow.y = cvtpk(o[2], o[3]);
        if (lane < 16) gst8(p, ow);
    }
}

constexpr int AI_C = 128, AI_BW = 128, AI_BH = 128, AI_A = 192, AI_LAT = AI_C + AI_BW + AI_BH + AI_A, AI_CC = 8, AI_BC = 12, AI_AC = 12, AI_ALL = AI_LAT + AI_CC + AI_BC + AI_AC;
static_assert(at::DUMP_FLOATS == 33792, "WS_PART sizing");
__device__ __forceinline__ at::AUnit attn_item_unit(int it, int& body, const Args& a, const float* sink, int layer) {
    const bf16* P = (const bf16*)(a.ws + WS_P); const bf16* QC = (const bf16*)(a.ws + WS_QC); const bf16* KVC = (const bf16*)(a.ws + WS_KVC); bf16* CAT = (bf16*)(a.ws + WS_CAT);
    const int seg = it < AI_C ? 0 : it < AI_C + AI_BW ? 1 : it < AI_C + AI_BW + AI_BH ? 2 : it < AI_LAT ? 3 : it < AI_LAT + AI_CC ? 4 : it < AI_LAT + AI_CC + AI_BC ? 5 : 6;
    const int j0 = it - (seg == 0 ? 0 : seg == 1 ? AI_C : seg == 2 ? AI_C + AI_BW : seg == 3 ? AI_C + AI_BW + AI_BH : seg == 4 ? AI_LAT : seg == 5 ? AI_LAT + AI_CC : AI_LAT + AI_CC + AI_BC);
    const bool split = seg == 2; const int half = j0 & 1, sidx = j0 >> 1;
    const int j = split ? AI_BW + sidx : j0;
    const int kind = (seg == 0 || seg == 4) ? 2 : (seg == 1 || seg == 2 || seg == 5) ? 1 : 0; const bool cq = seg >= 4;
    const int nh = kind == 2 ? 4 : 6;
    const int b = cq ? j / nh : j / (16 * nh), h = cq ? j % nh : (j / 16) % nh, qb = cq ? 0 : (j & 15);
    const long qrow = cq ? (long)(NL + b * LCTX) : (long)(b * SEQ + qb * 256), crow0 = (long)(NL + b * LCTX), lrow0 = (long)b * SEQ;
    const bool win = kind == 0 && !cq;
    int wlo = qb * 256 - 128, whi = qb * 256 + 384; wlo = wlo < 0 ? 0 : wlo; whi = whi > SEQ ? SEQ : whi;
    const long llo = win ? (long)wlo : (split && half) ? 30 * 64 : 0;
    const int g = h / 3, oq = kind == 0 ? O_AQ : O_BQ, ok = kind == 0 ? O_AK : O_BK, ov = kind == 0 ? O_AV : O_BV;
    at::AUnit U;
    U.Q = kind == 2 ? QC + qrow * 768 + h * 192 : P + qrow * NIN + oq + h * 128; U.ldq = kind == 2 ? 768 : NIN;
    U.KV = kind == 2 ? KVC : P; U.K2 = P;
    U.ldk = kind == 2 ? 1024 : NIN; U.ldv = U.ldk; U.ldk2 = NIN; U.ldo = D;
    U.kc = kind == 2 ? crow0 * 1024 + h * 256 : crow0 * NIN + ok + g * 128;
    U.kl = kind == 2 ? lrow0 * 1024 + h * 256 : (lrow0 + llo) * NIN + ok + g * 128;
    U.vc = kind == 2 ? U.kc + 128 : crow0 * NIN + ov + g * 128;
    U.vl = kind == 2 ? U.kl + 128 : (lrow0 + llo) * NIN + ov + g * 128;
    U.k2c = crow0 * NIN + O_CKR; U.k2l = lrow0 * NIN + O_CKR;
    U.O = CAT + qrow * D + (kind == 0 ? 0 : kind == 1 ? 768 : 1536) + h * 128;
    U.nct = (split && half) ? 0 : 4;
    U.ntl = cq ? 0 : win ? (whi - wlo) / 64 : split ? (half ? 34 : 30) : SEQ / 64;
    U.qk_off = win ? wlo - qb * 256 : 0;
    U.sink = kind == 0 ? sink[h] : -__builtin_inff();
    float* part = (float*)(a.ws + WS_PART) + (size_t)(sidx * 2) * at::DUMP_FLOATS;
    U.part_own = part + (size_t)half * at::DUMP_FLOATS; U.part_oth = part + (size_t)(half ^ 1) * at::DUMP_FLOATS;
    U.cnt = (unsigned*)(a.ws + WS_CTL) + CW_SPLIT + 64 * (64 * layer + sidx);
    body = kind == 2 ? 2 : win ? 1 : split ? 3 : 0;
    return U;
}

__device__ __forceinline__ unsigned* pan_word(unsigned* ctl, int layer, int which, int panel) { return ctl + CW_PAN + 64 * ((5 * layer + which) * 40 + panel); }
__device__ __forceinline__ void pan_wait(unsigned* c0, unsigned need0, unsigned* c1, unsigned need1, unsigned* tmo) {
    if (threadIdx.x == 0) {
        unsigned sp = 0;
        for (;;) {
            const bool ok = __hip_atomic_load(c0, __ATOMIC_RELAXED, __HIP_MEMORY_SCOPE_AGENT) >= need0 && (c1 == nullptr || __hip_atomic_load(c1, __ATOMIC_RELAXED, __HIP_MEMORY_SCOPE_AGENT) >= need1);
            if (ok) break;
            __builtin_amdgcn_s_sleep(2);
            if ((++sp & 255u) == 0u) { if (__hip_atomic_load(tmo, __ATOMIC_RELAXED, __HIP_MEMORY_SCOPE_AGENT)) break; if (sp > (1u << 18)) { atomicAdd(tmo, 1u); break; } }
        }
        __builtin_amdgcn_fence(__ATOMIC_ACQUIRE, "agent");
        asm volatile("s_waitcnt vmcnt(0)" ::: "memory");
    }
    __syncthreads();
}

constexpr int N_PHASES = 2 + 8 * DEPTH;
#ifndef PHMASK
#define PHMASK 0x3ff
#endif
#define PHON(j) ((PHMASK >> (j)) & 1)
#ifndef SUBSEL
#define SUBSEL 7
#endif
__global__ void __launch_bounds__(NWAVES * 64, 2) fwd(Args args) {
    extern __shared__ __attribute__((aligned(16))) unsigned char lds[];
    LAS unsigned char* L = (LAS unsigned char*)lds;
    volatile LAS unsigned* MISC = (volatile LAS unsigned*)(L + MISC_OFF);
    const int tid = threadIdx.x, lane = tid & 63, wave = __builtin_amdgcn_readfirstlane(tid >> 6);
    const int G = gridDim.x, bx = blockIdx.x, vcu = (G % 8 == 0) ? (bx % 8) * (G / 8) + bx / 8 : bx;
    const int gw = vcu * NWAVES + wave, NGW = G * NWAVES;
    unsigned* ctl = (unsigned*)(args.ws + WS_CTL);
    for (int u = tid; u < (LDS_BYTES - LDSCTL_OFF) / 4; u += NWAVES * 64) ((LAS unsigned*)(L + LDSCTL_OFF))[u] = 0u;
    __syncthreads();
    const int lo = args.ph_lo, hi = args.ph_hi;
    const bool multi = hi - lo > 1;
    XcdBarrier bar; bar.bar = ctl + CW_BAR; bar.x = 0; bar.st = nullptr;
    if (multi) bar = xcd_barrier_post(ctl + CW_BAR, MISC + 8);
#if defined(PROBE_BX)
#define XSTAMP(k) do { if (l == 1 && bx == PROBE_BX && tid == 0) { VM_WAIT(); ((volatile LAS unsigned long long*)(L + LDSCTL_OFF + 2048))[(k)] = __builtin_amdgcn_s_memrealtime(); } } while (0)
#else
#define XSTAMP(k) do { } while (0)
#endif
#define IN(k) (lo <= (k) && (k) < hi)
#if defined(PROBE_A)
    volatile LAS unsigned long long* STP = (volatile LAS unsigned long long*)(L + LDSCTL_OFF);
#define STAMP(k) do { if (tid == 0) STP[(k)] = __builtin_amdgcn_s_memrealtime(); } while (0)
#else
#define STAMP(k) do { } while (0)
#endif
    STAMP(0);
#define SEAM(k) do { if (IN(k) && IN((k) + 1)) xcd_barrier(bar); STAMP((k) + 1); } while (0)
#define WS_PTRS unsigned char* ws = args.ws; asm volatile("" : "+s"(ws)); \
    _Float16* X = (_Float16*)(ws + WS_X); bf16* H = (bf16*)(ws + WS_H); bf16* P = (bf16*)(ws + WS_P); bf16* QC = (bf16*)(ws + WS_QC); bf16* KVC = (bf16*)(ws + WS_KVC); \
    bf16* CAT = (bf16*)(ws + WS_CAT); bf16* OFP = (bf16*)(ws + WS_OFP); bf16* OF = (bf16*)(ws + WS_OF); bf16* U = (bf16*)(ws + WS_U); float* SSQ = (float*)(ws + WS_SSQ); float* SSQB = (float*)(ws + WS_SSQB); \
    const float* tab128 = (const float*)(ws + WS_TAB128); const float* tab64 = (const float*)(ws + WS_TAB64); \
    (void)X; (void)H; (void)P; (void)QC; (void)KVC; (void)CAT; (void)OFP; (void)OF; (void)U; (void)SSQ; (void)SSQB; (void)tab128; (void)tab64;

    if (PHON(0) && IN(0)) {
        WS_PTRS
        { const int gid = bx * NWAVES * 64 + tid;
          if (gid < 64 * 32) { const int pos = gid >> 5, i = gid & 31; const float ang = (float)pos * powf(10000.f, -(float)i / 32.f); ((float*)(ws + WS_TAB128))[2 * gid] = cosf(ang); ((float*)(ws + WS_TAB128))[2 * gid + 1] = sinf(ang); }
          else if (gid < 64 * 32 + 64 * 16) { const int e = gid - 64 * 32, pos = e >> 4, i = e & 15; const float ang = (float)pos * powf(10000.f, -(float)i / 16.f); ((float*)(ws + WS_TAB64))[2 * e] = cosf(ang); ((float*)(ws + WS_TAB64))[2 * e + 1] = sinf(ang); } }
        for (int i = gw * 64 + lane; i < DEPTH * (NIN - DIN) * D / 8; i += NGW * 64) { const int l = i / ((NIN - DIN) * D / 8), e = i % ((NIN - DIN) * D / 8);
            *(u32x4v*)((bf16*)(ws + WS_W + (size_t)l * W_LAYER + W_IN) + (size_t)DIN * D + (size_t)e * 8) = (u32x4v){0u, 0u, 0u, 0u}; }
        for (int u = bx; u < 192; u += G) mod_unit(args, u, L, tid, wave, lane);
        LAS float* scr = (LAS float*)(L + wave * 17408);
        for (;;) {
            int base = 0; if (lane == 0) base = (int)atomicAdd(ctl + CW_CONVQ, 8u);
            base = __builtin_amdgcn_readfirstlane(base);
            if (base >= IT_LAYER) break;
            for (int it = base; it < base + 8 && it < IT_LAYER; ++it) conv_item(args, it, scr, lane);
        }
    }
    SEAM(0);
    if (PHON(1) && IN(1)) {
        WS_PTRS
        const float* modv = (const float*)(ws + WS_MODV); float* comb = (float*)(ws + WS_COMB);
        for (int i = bx * NWAVES * 64 + tid; i < DEPTH * 3 * D; i += G * NWAVES * 64) { const int l = i / (3 * D), s = (i / D) % 3, c = i % D;
            const float* m = modv + (size_t)(l * 3 + s) * 6 * D; float* o = comb + (size_t)(l * 3 + s) * 6 * D + c;
            o[0 * D] = m[2 * D + c] * args.in[I_GMIXPOST][l * D + c]; o[1 * D] = args.in[I_GFFNPRE][l * D + c] * (1.f + m[4 * D + c]); o[2 * D] = m[3 * D + c];
            o[3 * D] = m[5 * D + c] * args.in[I_GFFNPOST][l * D + c]; o[4 * D] = args.in[I_GMIXPRE][l * D + c] * (1.f + m[1 * D + c]); o[5 * D] = m[0 * D + c]; }
        for (int r = gw; r < NR; r += NGW) { const int s = row_s(r);
            const float* xin = r < NL ? args.in[I_X] + (size_t)r * D : args.in[I_CTX] + (size_t)(r - NL) * D;
            RowF x; ld_row_f32(x, xin, lane);
            const float rstd = rsqrtf(row_ssq(x) * (1.f / D) + EPS);
            const float* m = modv + (size_t)s * 6 * D;
            RowF g, sc, sh; ld_row_f32(g, args.in[I_GMIXPRE], lane); ld_row_f32(sc, m + D, lane); ld_row_f32(sh, m, lane);
#pragma unroll
            for (int j = 0; j < 8; ++j) x.v[j] = (x.v[j] * rstd) * g.v[j] * (1.f + sc.v[j]) + sh.v[j];
            st_row_bf16(H + (size_t)r * D, x, lane); }
    }
    SEAM(1);
    for (int l = 0; l < DEPTH; ++l) {
        const int pb = 2 + 8 * l; const bool last = l == DEPTH - 1;
        int bx_ = blockIdx.x; asm volatile("" : "+s"(bx_)); const int bx = bx_;
        const unsigned char* wl = args.ws + WS_W + (size_t)l * W_LAYER;
        const int Mrows = last ? NL : NR;
        if (PHON(2) && IN(pb + 0)) {
            WS_PTRS
            pg8::Gemm g{H, (const bf16*)(wl + W_IN), NR, NIN, D, D};
#if IN_CQ_FIRST
            pg8::InOrder S; S.init(NR, G, bx); S.pan = pan_word(ctl, l, 4, 0);
#else
            pg8::CountedStatic S; S.init(NR, NIN, G, bx);
            S.ready = (MERGE_THIN && COUNTED_NEXT && l > 0) ? pan_word(ctl, l - 1, 3, 0) : nullptr; S.need_lat = 8u; S.need_ctx = 16u * NP_F2; S.tmo = ctl;
#endif
            pg8::EpiIn E{P, NIN, SSQ, SSQB, tab128, tab64, args.in[I_GQN] + l * 128, args.in[I_GKN] + l * 128, (PG8_LAS float*)(L + 131072), MERGE_POST != 0};
            XSTAMP(20);
#if IN_CQ_FIRST
            pg8::gemm_phase<pg8::EpiIn, pg8::InOrder, true>(L, g, S, E);
#else
            pg8::gemm_phase<pg8::EpiIn, pg8::CountedStatic, true>(L, g, S, E);
#endif
            XSTAMP(21);
#if MERGE_POST
#if IN_CQ_FIRST
            if (bx >= 220 && bx < 220 + NR / 256) { const int pm_ = bx - 220;
                pan_wait(pan_word(ctl, l, 4, pm_), 3u, nullptr, 0u, ctl); XSTAMP(22);
                pg8::PanelOrder S2{pm_, 3};
                pg8::Gemm g2{P + O_CQ, (const bf16*)(wl + W_UQ), NR, 768, 512, NIN}; pg8::EpiUq E2{QC, SSQ, tab64}; pg8::gemm_phase<pg8::EpiUq, pg8::PanelOrder, false>(L, g2, S2, E2); }
            { pg8::OffsetOrder S2; S2.init(NR, 1024, bx, 0);
              if (S2.has()) { pan_wait(pan_word(ctl, l, 4, S2.L / S2.nN), 3u, nullptr, 0u, ctl); XSTAMP(22);
                  pg8::Gemm g2{P + O_CKV, (const bf16*)(wl + W_UKV), NR, 1024, 256, NIN}; pg8::EpiUkv E2{KVC, SSQ}; pg8::gemm_phase<pg8::EpiUkv, pg8::OffsetOrder, false>(L, g2, S2, E2); } }
#else
            { pg8::Unit u{0, 0, 0, 0, 0};
              if (tid == 0) for (int i = 0; S.next(i, u); ++i) if (u.pn >= 10 && u.pn <= 12) __hip_atomic_fetch_add(pan_word(ctl, l, 4, u.pm), 1u, __ATOMIC_RELAXED, __HIP_MEMORY_SCOPE_AGENT); }
            const int bxo = bx;
            { pg8::OffsetOrder S2; S2.init(NR, 768, bxo, 0);
              if (S2.has()) { pan_wait(pan_word(ctl, l, 4, S2.L / S2.nN), 3u, nullptr, 0u, ctl); XSTAMP(22);
                  pg8::Gemm g2{P + O_CQ, (const bf16*)(wl + W_UQ), NR, 768, 512, NIN}; pg8::EpiUq E2{QC, SSQ, tab64}; pg8::gemm_phase<pg8::EpiUq, pg8::OffsetOrder, false>(L, g2, S2, E2); } }
            { pg8::OffsetOrder S2; S2.init(NR, 1024, bxo, 102);
              if (S2.has()) { pan_wait(pan_word(ctl, l, 4, S2.L / S2.nN), 3u, nullptr, 0u, ctl); XSTAMP(22);
                  pg8::Gemm g2{P + O_CKV, (const bf16*)(wl + W_UKV), NR, 1024, 256, NIN}; pg8::EpiUkv E2{KVC, SSQ}; pg8::gemm_phase<pg8::EpiUkv, pg8::OffsetOrder, false>(L, g2, S2, E2); } }
#endif
#endif
            XSTAMP(23);
        }
        if (!MERGE_POST) SEAM(pb + 0); else STAMP(pb + 1);
        if (!MERGE_POST && PHON(3) && IN(pb + 1)) {
            WS_PTRS
            { pg8::OffsetOrder S; S.init(NR, 768, bx, 0);
              if ((SUBSEL & 1) && S.has()) { pg8::Gemm g{P + O_CQ, (const bf16*)(wl + W_UQ), NR, 768, 512, NIN}; pg8::EpiUq E{QC, SSQ, tab64}; pg8::gemm_phase<pg8::EpiUq, pg8::OffsetOrder, false>(L, g, S, E); } }
            { pg8::OffsetOrder S; S.init(NR, 1024, bx, 102);
              if ((SUBSEL & 2) && S.has()) { pg8::Gemm g{P + O_CKV, (const bf16*)(wl + W_UKV), NR, 1024, 256, NIN}; pg8::EpiUkv E{KVC, SSQ}; pg8::gemm_phase<pg8::EpiUkv, pg8::OffsetOrder, false>(L, g, S, E); } }
            int ln = threadIdx.x; asm volatile("" : "+v"(ln)); ln &= 63;
            const f32x4 gq = *(const f32x4*)(args.in[I_GQN] + l * 128 + 4 * (ln & 31)), gk = *(const f32x4*)(args.in[I_GKN] + l * 128 + 4 * (ln & 31));
            if (SUBSEL & 4) for (int r = gw; r < NR; r += NGW) post_row(P + (size_t)r * NIN, r, tab128, tab64, SSQB, gq, gk, ln);
        }
        SEAM(pb + 1);
        if (PHON(4) && IN(pb + 2)) {
            WS_PTRS
            const int nitems = last ? AI_LAT : AI_ALL, nch = last ? 0 : CONV_CHUNKS;
            for (;;) {
                __syncthreads();
                if (tid == 0) MISC[0] = atomicAdd(ctl + CW_ATTQ + 64 * l, 1u);
                __syncthreads();
                const int q = __builtin_amdgcn_readfirstlane((int)MISC[0]);
                if (q >= nitems + nch) break;
                int it = q, cv = -1;
                if (nch > 0) {
                    if (q < 256) { if (q & 1) cv = q >> 1; else it = q >> 1; }
                    else if (q < 384) it = 128 + (q - 256);
                    else { const int e = q - 384;
                        if (e < 216) { if (e & 1) cv = 128 + (e >> 1); else it = 256 + (e >> 1); }
                        else if (e < 236) it = 256 + 108 + (e - 216);
                        else it = 384 + (e - 236); }
                }
                if (cv >= 0) {
                    int t_ = threadIdx.x; asm volatile("" : "+v"(t_));
                    const int cl = t_ & 63, cw = __builtin_amdgcn_readfirstlane(t_ >> 6); LAS float* cs = (LAS float*)(L + cw * 17408);
                    for (int k = 0; k < 6; ++k) { const int ci = cv * 48 + cw * 6 + k; if (ci < IT_LAYER) conv_item(args, (l + 1) * IT_LAYER + ci, cs, cl); }
                    continue;
                }
                int kind; const at::AUnit AU = attn_item_unit(it, kind, args, args.in[I_SINK] + l * 6, l);
                if (kind == 2) { if (SUBSEL & 1) at::attn_unit<192, false>(AU, (char*)lds); }
                else if (kind == 1) { if (SUBSEL & 2) at::attn_unit<128, true>(AU, (char*)lds); }
                else if (kind == 3) { if (SUBSEL & 4) at::attn_unit<128, false, true>(AU, (char*)lds); }
                else { if (SUBSEL & 4) at::attn_unit<128, false>(AU, (char*)lds); }
            }
        }
        SEAM(pb + 2);
        if (PHON(5) && IN(pb + 3)) {
            WS_PTRS
            pg8::Gemm g{CAT, (const bf16*)(wl + W_OUT), NR, D, D, D}; pg8::SplitTailOrder S; S.base.init(NL, D, G, bx); S.npieces = last ? 0 : NP_OUT; S.piece_nt = (D / 64) / NP_OUT;
            pg8::EpiPlain E{OF, D, OFP, (size_t)NC * D, NL / 256, MERGE_THIN != 0};
            pg8::gemm_phase<pg8::EpiPlain, pg8::SplitTailOrder, true>(L, g, S, E);
#if MERGE_THIN
            { pg8::Unit u0{0, 0, 0, 0, 0}, u1{0, 0, 0, 0, 0}; const bool has0 = S.next(0, u0), has1 = S.next(1, u1);
              if (tid == 0) { if (has0) __hip_atomic_fetch_add(pan_word(ctl, l, 0, u0.pm), 1u, __ATOMIC_RELAXED, __HIP_MEMORY_SCOPE_AGENT); if (has1) __hip_atomic_fetch_add(pan_word(ctl, l, 0, u1.pm), 1u, __ATOMIC_RELAXED, __HIP_MEMORY_SCOPE_AGENT); }
              int ln = threadIdx.x; asm volatile("" : "+v"(ln)); ln &= 63;
              if (has0) { pan_wait(pan_word(ctl, l, 0, u0.pm), 8u, nullptr, 0u, ctl);
                  for (int k = 0; k < 4; k += 2) { const int r = 256 * u0.pm + 32 * u0.pn + 4 * wave + k, s = r >> 12;
                      resid_norm_row2(l == 0 ? args.in[I_X] + (size_t)r * D : nullptr, X + (size_t)r * D, nullptr, X + (size_t)r * D, OF + (size_t)r * D, comb_vec(args, l, s, 0), comb_vec(args, l, s, 1), comb_vec(args, l, s, 2), H + (size_t)r * D, ln); } }
              if (!last && bx >= 16 * NP_OUT) { pan_wait(pan_word(ctl, l, 0, 32), 8u * NP_OUT, pan_word(ctl, l, 0, 33), 8u * NP_OUT, ctl);
                  const int rc = (bx - 16 * NP_OUT) + (G - 16 * NP_OUT) * wave;
                  if (rc < NC) { const int r = NL + rc;
                      resid_norm_row(l == 0 ? args.in[I_CTX] + (size_t)rc * D : nullptr, X + (size_t)r * D, nullptr, X + (size_t)r * D, OFP + (size_t)rc * D, comb_vec(args, l, 2, 0), comb_vec(args, l, 2, 1), comb_vec(args, l, 2, 2), H + (size_t)r * D, ln, 1.f, NP_OUT, (size_t)NC * D); } }
              if (COUNTED_NEXT) { VM_WAIT(); __syncthreads(); }
              if (COUNTED_NEXT && tid == 0) { if (has0) __hip_atomic_fetch_add(pan_word(ctl, l, 2, u0.pm), 1u, __ATOMIC_RELAXED, __HIP_MEMORY_SCOPE_AGENT);
                  if (has1) { __hip_atomic_fetch_add(pan_word(ctl, l, 2, 32), 1u, __ATOMIC_RELAXED, __HIP_MEMORY_SCOPE_AGENT); __hip_atomic_fetch_add(pan_word(ctl, l, 2, 33), 1u, __ATOMIC_RELAXED, __HIP_MEMORY_SCOPE_AGENT); } } }
#endif
        }
        if (!(MERGE_THIN && COUNTED_NEXT)) SEAM(pb + 3); else STAMP(pb + 4);
        if (!MERGE_THIN && PHON(6) && IN(pb + 4)) {
            WS_PTRS
            int ln = threadIdx.x; asm volatile("" : "+v"(ln)); ln &= 63;
            for (int r = gw; r < Mrows; r += NGW) { const int s = row_s(r);
                const float* xin = l == 0 ? (r < NL ? args.in[I_X] + (size_t)r * D : args.in[I_CTX] + (size_t)(r - NL) * D) : nullptr;
                const bool cx = r >= NL;
                resid_norm_row(xin, X + (size_t)r * D, nullptr, X + (size_t)r * D, cx ? OFP + (size_t)(r - NL) * D : OF + (size_t)r * D, comb_vec(args, l, s, 0), comb_vec(args, l, s, 1), comb_vec(args, l, s, 2), H + (size_t)r * D, ln, 1.f, cx ? NP_OUT : 1, (size_t)NC * D); }
        }
        if (!MERGE_THIN) SEAM(pb + 4); else STAMP(pb + 5);
        if (PHON(7) && IN(pb + 5)) {
            WS_PTRS
            pg8::Gemm g{H, (const bf16*)(wl + W_13), Mrows, 2 * DFF, D, D}; pg8::CountedStatic S; S.init(Mrows, 2 * DFF, G, bx);
            S.ready = (MERGE_THIN && COUNTED_NEXT) ? pan_word(ctl, l, 2, 0) : nullptr; S.need_lat = 8u; S.need_ctx = 16u * NP_OUT; S.tmo = ctl;
            pg8::EpiSwiglu E{U, DFF};
            pg8::gemm_phase<pg8::EpiSwiglu, pg8::CountedStatic, true>(L, g, S, E);
        }
        SEAM(pb + 5);
        if (PHON(8) && IN(pb + 6)) {
            WS_PTRS
            pg8::Gemm g{U, (const bf16*)(wl + W_2), NR, D, DFF, DFF}; pg8::SplitTailOrder S; S.base.init(NL, D, G, bx); S.npieces = last ? 0 : NP_F2; S.piece_nt = (DFF / 64) / NP_F2;
            pg8::EpiPlain E{OF, D, OFP, (size_t)NC * D, NL / 256, MERGE_THIN != 0};
            pg8::gemm_phase<pg8::EpiPlain, pg8::SplitTailOrder, true>(L, g, S, E);
#if MERGE_THIN
            { pg8::Unit u0{0, 0, 0, 0, 0}, u1{0, 0, 0, 0, 0}; const bool has0 = S.next(0, u0), has1 = S.next(1, u1);
              if (tid == 0) { if (has0) __hip_atomic_fetch_add(pan_word(ctl, l, 1, u0.pm), 1u, __ATOMIC_RELAXED, __HIP_MEMORY_SCOPE_AGENT); if (has1) __hip_atomic_fetch_add(pan_word(ctl, l, 1, u1.pm), 1u, __ATOMIC_RELAXED, __HIP_MEMORY_SCOPE_AGENT); }
              int ln = threadIdx.x; asm volatile("" : "+v"(ln)); ln &= 63;
              if (has0) { pan_wait(pan_word(ctl, l, 1, u0.pm), 8u, nullptr, 0u, ctl);
                  for (int k = 0; k < 4; k += 2) { const int r = 256 * u0.pm + 32 * u0.pn + 4 * wave + k, s = r >> 12;
                      resid_norm_row2(nullptr, X + (size_t)r * D, last ? args.out + (size_t)r * D : nullptr, X + (size_t)r * D, OF + (size_t)r * D, comb_vec(args, l, s, 3), last ? nullptr : comb_vec(args, l + 1, s, 4), last ? nullptr : comb_vec(args, l + 1, s, 5),
                                      last ? nullptr : H + (size_t)r * D, ln); } }
              if (!last && bx >= 16 * NP_F2) { pan_wait(pan_word(ctl, l, 1, 32), 8u * NP_F2, pan_word(ctl, l, 1, 33), 8u * NP_F2, ctl);
                  const int rc = (bx - 16 * NP_F2) + (G - 16 * NP_F2) * wave;
                  if (rc < NC) { const int r = NL + rc;
                      resid_norm_row(nullptr, X + (size_t)r * D, nullptr, X + (size_t)r * D, OFP + (size_t)rc * D, comb_vec(args, l, 2, 3), comb_vec(args, l + 1, 2, 4), comb_vec(args, l + 1, 2, 5), H + (size_t)r * D, ln, 1.f, NP_F2, (size_t)NC * D); } }
              if (COUNTED_NEXT) { VM_WAIT(); __syncthreads(); }
              if (COUNTED_NEXT && tid == 0) { if (has0) __hip_atomic_fetch_add(pan_word(ctl, l, 3, u0.pm), 1u, __ATOMIC_RELAXED, __HIP_MEMORY_SCOPE_AGENT);
                  if (has1) { __hip_atomic_fetch_add(pan_word(ctl, l, 3, 32), 1u, __ATOMIC_RELAXED, __HIP_MEMORY_SCOPE_AGENT); __hip_atomic_fetch_add(pan_word(ctl, l, 3, 33), 1u, __ATOMIC_RELAXED, __HIP_MEMORY_SCOPE_AGENT); } } }
#endif
        }
        if (!(MERGE_THIN && COUNTED_NEXT)) SEAM(pb + 6); else STAMP(pb + 7);
        if (!MERGE_THIN && PHON(9) && IN(pb + 7)) {
            WS_PTRS
            int ln = threadIdx.x; asm volatile("" : "+v"(ln)); ln &= 63;
            float osc = 1.f;
#if defined(PROBE_A)
            if (last) { __syncthreads(); osc = 1.f + 1e-6f * (float)(STP[PROBE_B + 1] - STP[PROBE_B]); }
#endif
            for (int r = gw; r < Mrows; r += NGW) { const int s = row_s(r);
                float* xo = last ? args.out + (size_t)r * D : nullptr;
                const bool cx = r >= NL;
                resid_norm_row(nullptr, X + (size_t)r * D, xo, X + (size_t)r * D, cx ? OFP + (size_t)(r - NL) * D : OF + (size_t)r * D, comb_vec(args, l, s, 3), last ? nullptr : comb_vec(args, l + 1, s, 4), last ? nullptr : comb_vec(args, l + 1, s, 5),
                               last ? nullptr : H + (size_t)r * D, ln, osc, cx ? NP_F2 : 1, (size_t)NC * D); }
        }
        if (!MERGE_THIN) SEAM(pb + 7); else STAMP(pb + 8);
    }
#if defined(PROBE_A)
#if defined(PROBE_BX)
    if (bx == PROBE_BX && tid == 0 && hi == N_PHASES) { volatile LAS unsigned long long* XS = (volatile LAS unsigned long long*)(L + LDSCTL_OFF + 2048); VM_WAIT(); args.out[0] += 0.0001f * (float)(XS[PROBE_C + 1] - XS[PROBE_C]); }
    if (false) {
#else
    if (bx == 0 && tid == 0 && hi == N_PHASES) {
#endif
      VM_WAIT(); STAMP(N_PHASES); args.out[0] += (PROBE_A == 99) ? 0.00001f * (float)(STP[N_PHASES] - STP[0]) : 0.0001f * (float)(STP[PROBE_A + 1] - STP[PROBE_A]); }
#endif
#undef IN
#undef SEAM
}

inline int setup() {
    static int grid = 0;
    if (grid == 0) {
        int dev = 0, cus = 0, per_cu = 0;
        if (hipGetDevice(&dev) != hipSuccess || hipDeviceGetAttribute(&cus, hipDeviceAttributeMultiprocessorCount, dev) != hipSuccess) { fprintf(stderr, "mk: device query failed\n"); grid = -1; return -1; }
        if (hipFuncSetAttribute((const void*)fwd, hipFuncAttributeMaxDynamicSharedMemorySize, LDS_BYTES) != hipSuccess) { fprintf(stderr, "mk: hipFuncSetAttribute failed\n"); grid = -1; return -1; }
        if (hipOccupancyMaxActiveBlocksPerMultiprocessor(&per_cu, (const void*)fwd, NWAVES * 64, LDS_BYTES) != hipSuccess || per_cu < 1) fprintf(stderr, "mk: occupancy query says %d\n", per_cu);
        (void)hipGetLastError();
        grid = cus;
    }
    return grid;
}
inline void prep(unsigned char* ws, hipStream_t stream) { (void)hipMemsetAsync(ws + WS_CTL, 0, CTL_ZERO_BYTES, stream); }
inline void run(void* const* d_in, float* d_out, unsigned char* ws, hipStream_t stream, int lo, int hi) {
    const int grid = setup(); if (grid <= 0) return;
    Args a{};
    for (int i = 0; i < 22; ++i) a.in[i] = (const float*)d_in[i];
    a.out = d_out; a.ws = ws; a.ph_lo = lo; a.ph_hi = hi;
    hipLaunchKernelGGL(fwd, dim3(grid), dim3(NWAVES * 64), LDS_BYTES, stream, a);
    const hipError_t le = hipPeekAtLastError();
    if (le != hipSuccess) fprintf(stderr, "mk: launch failed: %s\n", hipGetErrorName(le));
}
}

extern "C" void kernel_launch(void* const* d_in, const int* in_sizes, int n_in, void* d_out, int out_size, void* d_ws, size_t ws_size, hipStream_t stream) {
    unsigned char* ws = (unsigned char*)d_ws;
    if (n_in != 22 || out_size != mk::NL * mk::D || ws_size < mk::WS_END) { fprintf(stderr, "kernel_launch: n_in %d out %d ws %zu (need %zu)\n", n_in, out_size, ws_size, (size_t)mk::WS_END); return; }
    mk::prep(ws, stream);
    mk::run(d_in, (float*)d_out, ws, stream, 0, mk::N_PHASES);
}
```

```cpp
#include <hip/hip_runtime.h>
#include <stdint.h>
#include <stdio.h>
#include <cstdint>
#include <cmath>

#ifndef WT_STORES
#define WT_STORES 0
#endif
typedef unsigned wt_u32x4 __attribute__((ext_vector_type(4)));
typedef unsigned wt_u32x2 __attribute__((ext_vector_type(2)));
__device__ __forceinline__ void gst16(void* p, wt_u32x4 v) {
#if WT_STORES
    asm volatile("global_store_dwordx4 %0, %1, off sc1\n\ts_nop 1" :: "v"(p), "v"(v) : "memory");
#else
    *(wt_u32x4*)p = v;
#endif
}
__device__ __forceinline__ void gst8(void* p, wt_u32x2 v) {
#if WT_STORES
    asm volatile("global_store_dwordx2 %0, %1, off sc1\n\ts_nop 0" :: "v"(p), "v"(v) : "memory");
#else
    *(wt_u32x2*)p = v;
#endif
}
__device__ __forceinline__ void gst16_wt(void* p, wt_u32x4 v) { asm volatile("global_store_dwordx4 %0, %1, off sc1\n\ts_nop 1" :: "v"(p), "v"(v) : "memory"); }
__device__ __forceinline__ void gst8_wt(void* p, wt_u32x2 v) { asm volatile("global_store_dwordx2 %0, %1, off sc1\n\ts_nop 0" :: "v"(p), "v"(v) : "memory"); }
namespace pg8 {
#define PG8_LAS __attribute__((address_space(3)))
typedef unsigned short bf16_t;
typedef short bf16x8 __attribute__((ext_vector_type(8)));
typedef float f32x4 __attribute__((ext_vector_type(4)));
typedef float f32x2 __attribute__((ext_vector_type(2)));
typedef unsigned u32x4 __attribute__((ext_vector_type(4)));
typedef unsigned u32x2 __attribute__((ext_vector_type(2)));
constexpr int BM = 256, BK = 64, HALF = 128, HTB = HALF * BK * 2  , STAGE_BYTES = 8 * HTB, NXCD = 8, WGM = 8;

__host__ __device__ __forceinline__ int lds_byte(int r, int c) { const int st = (r >> 4) * 2 + (c >> 5), rr = r & 15, cc = c & 31, ob = rr * 64 + cc * 2; return st * 1024 + (ob ^ (((ob >> 9) & 1) << 5)); }
__host__ __device__ __forceinline__ void stage_rc(int b, int& R, int& C) { const int st = b / 1024, sb = b % 1024, swz = sb ^ (((sb >> 9) & 1) << 5); R = (st >> 1) * 16 + swz / 64; C = (st & 1) * 32 + (swz % 64) / 2; }
__host__ __device__ __forceinline__ int perm32(int rho) { const int n = rho >> 4, i = rho & 15; return 8 * (i >> 2) + 4 * n + (i & 3); }

struct Unit { int pm, pn, kofs, nt, part; };
struct Gemm { const bf16_t* A; const bf16_t* Bt; int M, N, K, lda; };

struct StaticOrder {
    int nM, nN, nwg, G, c;
    __host__ __device__ __forceinline__ void init(int M, int N, int G_, int c_) { nM = M / BM; nN = N / BM; nwg = nM * nN; G = G_; c = c_; }
    __host__ __device__ __forceinline__ bool next(int i, Unit& u) const { return nextL((long)i * G + c, u); }
    __host__ __device__ __forceinline__ bool nextL(long L, Unit& u) const {
        if (L < 0 || L >= nwg) return false;
        int wgid = (int)L; { const int q = nwg / NXCD, r = nwg % NXCD, xcd = wgid % NXCD, off = wgid / NXCD; wgid = (xcd < r ? xcd * (q + 1) : r * (q + 1) + (xcd - r) * q) + off; }
        const int nig = WGM * nN, gid = wgid / nig, fm = gid * WGM, gsz = (nM - fm) < WGM ? (nM - fm) : WGM;
        u.pm = fm + ((wgid % nig) % gsz); u.pn = (wgid % nig) / gsz; return true;
    }
    __device__ __forceinline__ void a_ready(const Unit&) const {}
    __device__ __forceinline__ void done(const Unit&) const {}
};
struct CountedStatic : StaticOrder {
    const unsigned* ready; unsigned need_lat, need_ctx; unsigned* tmo;
    __device__ __forceinline__ void a_ready(const Unit& u) const {
        if (ready == nullptr) return;
        if (threadIdx.x < 64) {
            const unsigned need = u.pm >= 32 ? need_ctx : need_lat; unsigned polls = 0;
            while ((unsigned)__builtin_amdgcn_readfirstlane(__hip_atomic_load(ready + 64 * u.pm, __ATOMIC_RELAXED, __HIP_MEMORY_SCOPE_AGENT)) < need) {
                __builtin_amdgcn_s_sleep(2);
                if ((++polls & 255u) == 0u) { if (__builtin_amdgcn_readfirstlane(__hip_atomic_load(tmo, __ATOMIC_RELAXED, __HIP_MEMORY_SCOPE_AGENT)) != 0u) break;
                    if (polls > (1u << 18)) { if (threadIdx.x == 0) atomicAdd(tmo, 1u); break; } } }
            __builtin_amdgcn_fence(__ATOMIC_ACQUIRE, "agent");
            asm volatile("s_waitcnt vmcnt(0)" ::: "memory");
        }
        asm volatile("" ::: "memory"); __builtin_amdgcn_s_barrier(); asm volatile("" ::: "memory");
    }
};
struct F13Order {
    StaticOrder base; bool shifted;
    __host__ __device__ __forceinline__ bool next(int i, Unit& u) const {
        const int c = base.c;
        if (!shifted || base.G != 256) return base.next(i, u);
        if (c >= 240) return i < 3 ? base.nextL((long)i * 256 + c, u) : false;
        if (i < 5) return base.nextL((long)i * 256 + c, u);
        if (i == 5) { if (c < 128) return base.nextL(1280 + c, u); if (c < 160) { const int o = c - 128; return base.nextL((long)(3 + o / 16) * 256 + 240 + (o % 16), u); } }
        return false;
    }
    __device__ __forceinline__ void a_ready(const Unit&) const {}
    __device__ __forceinline__ void done(const Unit&) const {}
};
#ifndef TAIL_BY_PANEL
#define TAIL_BY_PANEL 1
#endif
struct SplitTailOrder {
    StaticOrder base; int npieces, piece_nt;
    __host__ __device__ __forceinline__ bool next(int i, Unit& u) const {
        if (i == 0) return base.next(0, u);
        if (i == 1 && npieces > 0) {
#if TAIL_BY_PANEL
            Unit u0{0, 0, 0, 0, 0}; base.next(0, u0); const int id = u0.pm * 8 + u0.pn;
#else
            const int id = base.c;
#endif
            if (id < 16 * npieces) { const int tile = id / npieces, piece = id % npieces; u.pm = 32 + tile / 8; u.pn = tile % 8; u.kofs = piece * piece_nt * BK; u.nt = piece_nt; u.part = piece; return true; } }
        return false;
    }
    __device__ __forceinline__ void a_ready(const Unit&) const {}
    __device__ __forceinline__ void done(const Unit&) const {}
};
struct InOrder {
    int M, G, c; unsigned* pan;
    __host__ __device__ __forceinline__ void init(int M_, int G_, int c_) { M = M_; G = G_; c = c_; }
    __host__ __device__ __forceinline__ bool next(int i, Unit& u) const {
        const int n1 = (M / BM) * 3; const long L = (long)i * G + c;
        StaticOrder s;
        if (L < n1) { s.init(M, 3 * BM, G, c); s.nextL(L, u); u.pn += 10; return true; }
        s.init(M, 11 * BM, G, c);
        if (!s.nextL(L - n1, u)) return false;
        if (u.pn >= 10) u.pn += 3;
        return true;
    }
    __device__ __forceinline__ void a_ready(const Unit&) const {}
    __device__ __forceinline__ void done(const Unit& u) const {
        if (u.pn >= 10 && u.pn <= 12) {
            asm volatile("s_waitcnt vmcnt(0)" ::: "memory"); __builtin_amdgcn_s_barrier(); asm volatile("" ::: "memory");
            if (threadIdx.x == 0) __hip_atomic_fetch_add(pan + 64 * u.pm, 1u, __ATOMIC_RELAXED, __HIP_MEMORY_SCOPE_AGENT);
        }
    }
};
struct PanelOrder {
    int pm, n;
    __device__ __forceinline__ bool next(int i, Unit& u) const { if (i < 0 || i >= n) return false;
        int p = pm; asm volatile("" : "+s"(p));
        u.pm = p; u.pn = i; return true; }
    __device__ __forceinline__ void a_ready(const Unit&) const {}
    __device__ __forceinline__ void done(const Unit&) const {}
};
struct OffsetOrder {
    int nN, nwg, L;
    __host__ __device__ __forceinline__ void init(int M, int N, int c, int off) { nN = N / BM; nwg = (M / BM) * nN; L = c - off; }
    __host__ __device__ __forceinline__ bool has() const { return L >= 0 && L < nwg; }
    __host__ __device__ __forceinline__ bool next(int i, Unit& u) const { if (i != 0 || !has()) return false; u.pm = L / nN; u.pn = L % nN; return true; }
    __device__ __forceinline__ void a_ready(const Unit&) const {}
    __device__ __forceinline__ void done(const Unit&) const {}
};

__device__ __forceinline__ unsigned cvt_pk_bf16(float lo, float hi) { unsigned r; asm volatile("v_cvt_pk_bf16_f32 %0, %1, %2" : "=v"(r) : "v"(lo), "v"(hi)); return r; }
__device__ __forceinline__ u32x4 pack8(const f32x4 v0, const f32x4 v1) { u32x4 w; w.x = cvt_pk_bf16(v0[0], v0[1]); w.y = cvt_pk_bf16(v0[2], v0[3]); w.z = cvt_pk_bf16(v1[0], v1[1]); w.w = cvt_pk_bf16(v1[2], v1[3]); return w; }

struct EpiPlain {
    static constexpr bool PERM = true;
    bf16_t* O; int ldc; bf16_t* Opart; size_t pstride; int pm_ctx; bool wt;
    __device__ __forceinline__ void operator()(const f32x4 (&acc)[2][2][4][2], const Unit& u, int wr, int wc, int fr, int fq) const {
        const bool cx = Opart != nullptr && u.pm >= pm_ctx;
        bf16_t* base = cx ? Opart + (size_t)u.part * pstride - (size_t)pm_ctx * BM * ldc : O;
        const int row0 = u.pm * BM + wr * 64 + fr, col0 = u.pn * BM + wc * 32 + 8 * fq;
#pragma unroll
        for (int ai = 0; ai < 2; ++ai)
#pragma unroll
            for (int m = 0; m < 4; ++m) { bf16_t* rowp = base + (size_t)(row0 + ai * HALF + m * 16) * ldc + col0;
#pragma unroll
                for (int bj = 0; bj < 2; ++bj) { const u32x4 w = pack8(acc[ai][bj][m][0], acc[ai][bj][m][1]); if (wt) gst16_wt(rowp + bj * HALF, w); else gst16(rowp + bj * HALF, w); } }
    }
};
#ifndef ROPE_EPI_A
#define ROPE_EPI_A 1
#endif
#ifndef ROPE_EPI_B
#define ROPE_EPI_B 1
#endif
#ifndef B_NORM_EPI
#define B_NORM_EPI 1
#endif
#ifndef ROPE_EPI_R
#define ROPE_EPI_R 1
#endif
__host__ __device__ __forceinline__ int perm64(int r) { const int n = r >> 5, i = r & 31; return 32 * (i >> 4) + 8 * ((i >> 2) & 3) + 4 * n + (i & 3); }
struct EpiIn {
    static constexpr bool PERM = true;
    bf16_t* O; int ldc; float* ssq; float* ssqb; const float* tab128; const float* tab64; const float* gq; const float* gk; PG8_LAS float* xs; bool wt;
    __device__ __forceinline__ void operator()(const f32x4 (&acc)[2][2][4][2], const Unit& u, int wr, int wc, int fr, int fq) const {
        const int pn = u.pn, row0 = u.pm * BM + wr * 64 + fr, col0 = pn * BM + wc * 32 + 8 * fq;
        const bool ropeA = ROPE_EPI_A && pn <= 3, normB = ROPE_EPI_B && pn >= 5 && pn <= 8, ropeR = ROPE_EPI_R && pn == 13;
        if (ropeA || normB) {
            const int half = wc >> 1, i0 = 16 * (wc & 1) + 4 * fq;
            f32x4 g0 = {1.f, 1.f, 1.f, 1.f}, g1 = g0;
            if (normB) { const float* g = pn == 8 ? gk : gq; g0 = *(const f32x4*)(g + 64 * half + i0); g1 = *(const f32x4*)(g + 64 * half + i0 + 32); }
            if (normB && B_NORM_EPI) {
#pragma unroll
                for (int ai = 0; ai < 2; ++ai)
#pragma unroll
                    for (int m = 0; m < 4; ++m)
#pragma unroll
                        for (int bj = 0; bj < 2; ++bj) { const f32x4 x1 = acc[ai][bj][m][0], x2 = acc[ai][bj][m][1];
                            float s = ((x1[0] * x1[0] + x1[1] * x1[1]) + (x1[2] * x1[2] + x1[3] * x1[3])) + ((x2[0] * x2[0] + x2[1] * x2[1]) + (x2[2] * x2[2] + x2[3] * x2[3]));
                            s += __shfl_xor(s, 16); s += __shfl_xor(s, 32);
                            if (fq == 0) xs[((ai * HALF + wr * 64 + m * 16 + fr) * 2 + bj) * 4 + wc] = s; }
                asm volatile("s_waitcnt lgkmcnt(0)" ::: "memory"); __builtin_amdgcn_s_barrier(); asm volatile("" ::: "memory");
            }
#pragma unroll
            for (int ai = 0; ai < 2; ++ai)
#pragma unroll
                for (int m = 0; m < 4; ++m) { const int row = row0 + ai * HALF + m * 16; const bool lat = row < 8192; const int t = row & 4095, pos = half ? (t & 63) : (t >> 6);
                    f32x4 cs = {1.f, 1.f, 1.f, 1.f}, sn = {0.f, 0.f, 0.f, 0.f};
                    if (lat) { const f32x4 t0 = *(const f32x4*)(tab128 + (size_t)(pos * 32 + i0) * 2), t1 = *(const f32x4*)(tab128 + (size_t)(pos * 32 + i0) * 2 + 4);
                        cs = (f32x4){t0[0], t0[2], t1[0], t1[2]}; sn = (f32x4){t0[1], t0[3], t1[1], t1[3]}; }
                    bf16_t* rowp = O + (size_t)row * ldc + col0;
#pragma unroll
                    for (int bj = 0; bj < 2; ++bj) { f32x4 x1 = acc[ai][bj][m][0], x2 = acc[ai][bj][m][1];
                        if (normB && B_NORM_EPI) { const f32x4 sq = *(const PG8_LAS f32x4*)(xs + ((ai * HALF + wr * 64 + m * 16 + fr) * 2 + bj) * 4);
                            const float rstd = rsqrtf(((sq[0] + sq[1]) + (sq[2] + sq[3])) * (1.f / 128.f) + 1e-6f);
                            x1 = x1 * g0 * rstd; x2 = x2 * g1 * rstd; }
                        else if (normB) { float s = ((x1[0] * x1[0] + x1[1] * x1[1]) + (x1[2] * x1[2] + x1[3] * x1[3])) + ((x2[0] * x2[0] + x2[1] * x2[1]) + (x2[2] * x2[2] + x2[3] * x2[3]));
                            s += __shfl_xor(s, 16); s += __shfl_xor(s, 32);
                            if (fq == 0) ssqb[(size_t)row * 32 + ((pn - 5) * 2 + bj) * 4 + wc] = s;
                            x1 = x1 * g0; x2 = x2 * g1; }
                        gst16(rowp + bj * HALF, pack8(x1 * cs - x2 * sn, x2 * cs + x1 * sn)); }
                    if (m & 1) asm volatile("" ::: "memory"); }
            return;
        }
#pragma unroll
        for (int ai = 0; ai < 2; ++ai)
#pragma unroll
            for (int m = 0; m < 4; ++m) { const int row = row0 + ai * HALF + m * 16; bf16_t* rowp = O + (size_t)row * ldc + col0;
                f32x4 v0 = acc[ai][0][m][0], v1 = acc[ai][0][m][1];
                if (ropeR && wc < 2) {
                    f32x4 p0, p1;
#pragma unroll
                    for (int j = 0; j < 4; ++j) { p0[j] = __shfl_xor(v0[j], 32); p1[j] = __shfl_xor(v1[j], 32); }
                    if (row < 8192) { const int t = row & 4095, pos = wc ? (t & 63) : (t >> 6), ib = 8 * (fq & 1);
                        const f32x4 a0 = *(const f32x4*)(tab64 + (size_t)(pos * 16 + ib) * 2), a1 = *(const f32x4*)(tab64 + (size_t)(pos * 16 + ib) * 2 + 4), a2 = *(const f32x4*)(tab64 + (size_t)(pos * 16 + ib) * 2 + 8), a3 = *(const f32x4*)(tab64 + (size_t)(pos * 16 + ib) * 2 + 12);
                        const f32x4 c0 = {a0[0], a0[2], a1[0], a1[2]}, s0 = {a0[1], a0[3], a1[1], a1[3]}, c1 = {a2[0], a2[2], a3[0], a3[2]}, s1 = {a2[1], a2[3], a3[1], a3[3]};
                        if (fq < 2) { v0 = v0 * c0 - p0 * s0; v1 = v1 * c1 - p1 * s1; } else { v0 = v0 * c0 + p0 * s0; v1 = v1 * c1 + p1 * s1; } }
                }
                if (wt && pn >= 10 && pn <= 12) { gst16_wt(rowp, pack8(v0, v1)); gst16_wt(rowp + HALF, pack8(acc[ai][1][m][0], acc[ai][1][m][1])); }
                else { gst16(rowp, pack8(v0, v1)); gst16(rowp + HALF, pack8(acc[ai][1][m][0], acc[ai][1][m][1])); } }
        if (pn >= 10 && pn <= 12) {
#pragma unroll
            for (int ai = 0; ai < 2; ++ai)
#pragma unroll
                for (int m = 0; m < 4; ++m) { float s = 0.f;
#pragma unroll
                    for (int bj = 0; bj < 2; ++bj)
#pragma unroll
                        for (int n = 0; n < 2; ++n) { const f32x4 x = acc[ai][bj][m][n]; s += (x[0] * x[0] + x[1] * x[1]) + (x[2] * x[2] + x[3] * x[3]); }
                    s += __shfl_xor(s, 16); s += __shfl_xor(s, 32);
                    if (fq == 0) __hip_atomic_store(ssq + (size_t)(row0 + ai * HALF + m * 16) * 12 + (pn - 10) * 4 + wc, s, __ATOMIC_RELAXED, __HIP_MEMORY_SCOPE_AGENT); }
        }
    }
};
#ifndef UQ_ROPE_ON
#define UQ_ROPE_ON 1
#endif
struct EpiUq {
    static constexpr bool PERM = false;
    bf16_t* O; const float* ssq; const float* tab64; int rabs;
    __device__ __forceinline__ void operator()(const f32x4 (&acc)[2][2][4][2], const Unit& u, int wr, int wc, int fr, int fq) const {
        float rs[2][4];
#pragma unroll
        for (int ai = 0; ai < 2; ++ai)
#pragma unroll
            for (int m = 0; m < 4; ++m) { const int row = u.pm * BM + ai * HALF + wr * 64 + m * 16 + fr;
                const f32x4 q0 = *(const f32x4*)(ssq + (size_t)row * 12), q1 = *(const f32x4*)(ssq + (size_t)row * 12 + 4);
                rs[ai][m] = rsqrtf(((q0[0] + q0[1]) + (q0[2] + q0[3]) + (q1[0] + q1[1]) + (q1[2] + q1[3])) * (1.f / 512.f) + 1e-6f);
                if (m & 1) asm volatile("" ::: "memory"); }
#pragma unroll
        for (int ai = 0; ai < 2; ++ai)
#pragma unroll
            for (int m = 0; m < 4; ++m) {
                const int row = u.pm * BM + ai * HALF + wr * 64 + m * 16 + fr; const float rstd = rs[ai][m];
                const bool lat = rabs + row < 8192; const int t = (rabs + row) & 4095, prow = t >> 6, pcol = t & 63;
#pragma unroll
                for (int bj = 0; bj < 2; ++bj) {
                    const int g6 = (8 * u.pn + 4 * bj + wc) % 6;
                    f32x4 v0 = acc[ai][bj][m][0] * rstd, v1 = acc[ai][bj][m][1] * rstd;
                    if (UQ_ROPE_ON && g6 >= 4 && lat) {
                        const int pos = g6 == 4 ? prow : pcol;
                        const f32x4 t0 = *(const f32x4*)(tab64 + (size_t)(pos * 16 + 4 * fq) * 2), t1 = *(const f32x4*)(tab64 + (size_t)(pos * 16 + 4 * fq) * 2 + 4);
                        const f32x4 cs = {t0[0], t0[2], t1[0], t1[2]}, sn = {t0[1], t0[3], t1[1], t1[3]};
                        const f32x4 o0 = v0 * cs - v1 * sn, o1 = v1 * cs + v0 * sn; v0 = o0; v1 = o1;
                    }
                    bf16_t* p = O + (size_t)row * 768 + u.pn * BM + bj * HALF + wc * 32 + 4 * fq;
                    u32x2 w0, w1; w0.x = cvt_pk_bf16(v0[0], v0[1]); w0.y = cvt_pk_bf16(v0[2], v0[3]); w1.x = cvt_pk_bf16(v1[0], v1[1]); w1.y = cvt_pk_bf16(v1[2], v1[3]);
                    gst8(p, w0); gst8(p + 16, w1);
                }
                asm volatile("" ::: "memory");
            }
    }
};
struct EpiUkv {
    static constexpr bool PERM = true;
    bf16_t* O; const float* ssq;
    __device__ __forceinline__ void operator()(const f32x4 (&acc)[2][2][4][2], const Unit& u, int wr, int wc, int fr, int fq) const {
        const int row0 = u.pm * BM + wr * 64 + fr, col0 = u.pn * BM + wc * 32 + 8 * fq;
        float rs[2][4];
#pragma unroll
        for (int ai = 0; ai < 2; ++ai)
#pragma unroll
            for (int m = 0; m < 4; ++m) { const int row = row0 + ai * HALF + m * 16;
                const f32x4 q0 = *(const f32x4*)(ssq + (size_t)row * 12 + 8);
                rs[ai][m] = rsqrtf(((q0[0] + q0[1]) + (q0[2] + q0[3])) * (1.f / 256.f) + 1e-6f);
                if (m & 1) asm volatile("" ::: "memory"); }
#pragma unroll
        for (int ai = 0; ai < 2; ++ai)
#pragma unroll
            for (int m = 0; m < 4; ++m) { const int row = row0 + ai * HALF + m * 16; const float rstd = rs[ai][m];
                bf16_t* rowp = O + (size_t)row * 1024 + col0;
#pragma unroll
                for (int bj = 0; bj < 2; ++bj) gst16(rowp + bj * HALF, pack8(acc[ai][bj][m][0] * rstd, acc[ai][bj][m][1] * rstd)); }
    }
};
struct EpiSwiglu {
    static constexpr bool PERM = true;
    bf16_t* O; int ldc;
    __device__ __forceinline__ void operator()(const f32x4 (&acc)[2][2][4][2], const Unit& u, int wr, int wc, int fr, int fq) const {
        const int row0 = u.pm * BM + wr * 64 + fr, col0 = u.pn * HALF + wc * 32 + 8 * fq;
#pragma unroll
        for (int ai = 0; ai < 2; ++ai)
#pragma unroll
            for (int m = 0; m < 4; ++m) { f32x4 r[2];
#pragma unroll
                for (int n = 0; n < 2; ++n) { const f32x4 g = acc[ai][0][m][n], up = acc[ai][1][m][n];
#pragma unroll
                    for (int j = 0; j < 4; ++j) { const float e = __builtin_amdgcn_exp2f(g[j] * -1.4426950408889634f); r[n][j] = g[j] * __builtin_amdgcn_rcpf(1.f + e) * up[j]; } }
                gst16(O + (size_t)(row0 + ai * HALF + m * 16) * ldc + col0, pack8(r[0], r[1])); }
    }
};

template <class Epi, class Sched, bool ALIGN_EPI>
__device__ __forceinline__ void gemm_phase(PG8_LAS unsigned char* lds, const Gemm g, const Sched& S, const Epi& E) {
    int tid_ = threadIdx.x; asm volatile("" : "+v"(tid_));
    const int tid = tid_, wid = __builtin_amdgcn_readfirstlane(tid >> 6), lane = tid & 63, wr = wid >> 2, wc = wid & 3, fr = lane & 15, fq = lane >> 4;
    int K_ = g.K; asm volatile("" : "+s"(K_));
    const int K = K_, nt = K / BK, lda = g.lda;
    unsigned voffA[2], voffB[2];
#pragma unroll
    for (int i = 0; i < 2; ++i) { int R, C; stage_rc(tid * 16 + i * 8192, R, C); const int Rb = Epi::PERM ? ((R & ~31) + perm32(R & 31)) : R;
        voffA[i] = (unsigned)(R * lda + C) * 2u; voffB[i] = (unsigned)(Rb * K + C) * 2u; }
    const size_t kstep = (size_t)(BK * 2);
    const size_t hstepA = (size_t)HALF * lda * 2, tstepA = 2 * hstepA, hstepB = (size_t)HALF * K * 2, tstepB = 2 * hstepB;
    const unsigned ldsw = (unsigned)wid * 1024u;
    const int aoff = lds_byte(wr * 64 + fr, fq * 8), boff = lds_byte(wc * 32 + fr, fq * 8);
#define PG8_SA(b, h) (((b) * 2 + (h)) * HTB)
#define PG8_SB(b, h) ((4 + (b) * 2 + (h)) * HTB)
#define PG8_STAGE(bufoff, gbase, voff) do { _Pragma("unroll") for (int _i = 0; _i < 2; ++_i) \
        __builtin_amdgcn_global_load_lds((const unsigned*)((const char*)(gbase) + (voff)[_i]), (PG8_LAS unsigned*)(lds + (bufoff) + ldsw + _i * 8192), 16, 0, 0); } while (0)
#define PG8_LDA(dst, b, h) do { _Pragma("unroll") for (int m = 0; m < 4; ++m) _Pragma("unroll") for (int k = 0; k < 2; ++k) dst[m][k] = *(const PG8_LAS bf16x8*)(lds + PG8_SA(b, h) + aoff + m * 2048 + k * 1024); } while (0)
#define PG8_LDB(dst, b, h) do { _Pragma("unroll") for (int n = 0; n < 2; ++n) _Pragma("unroll") for (int k = 0; k < 2; ++k) dst[n][k] = *(const PG8_LAS bf16x8*)(lds + PG8_SB(b, h) + boff + n * 2048 + k * 1024); } while (0)
#define PG8_MMA(ai, bj, At, Bt) do { __builtin_amdgcn_s_setprio(1); _Pragma("unroll") for (int m = 0; m < 4; ++m) _Pragma("unroll") for (int n = 0; n < 2; ++n) _Pragma("unroll") for (int k = 0; k < 2; ++k) \
        acc[ai][bj][m][n] = __builtin_amdgcn_mfma_f32_16x16x32_bf16(Bt[n][k], At[m][k], acc[ai][bj][m][n], 0, 0, 0); __builtin_amdgcn_s_setprio(0); } while (0)
#define PG8_WAIT_V(n) asm volatile("s_waitcnt vmcnt(" #n ")" ::: "memory")
#define PG8_WAIT_L(n) asm volatile("s_waitcnt lgkmcnt(" #n ")" ::: "memory")
#define PG8_BAR __builtin_amdgcn_s_barrier()
#define PG8_SCHED __builtin_amdgcn_sched_barrier(0)
    Unit cur{0, 0, 0, nt, 0}, nxt{0, 0, 0, nt, 0}; int ui = 0;
    if (!S.next(0, cur)) return;
    f32x4 acc[2][2][4][2];
#pragma unroll
    for (int a = 0; a < 2; ++a)
#pragma unroll
        for (int b = 0; b < 2; ++b)
#pragma unroll
            for (int m = 0; m < 4; ++m)
#pragma unroll
                for (int n = 0; n < 2; ++n) acc[a][b][m][n] = (f32x4){0.f, 0.f, 0.f, 0.f};
    bf16x8 At[4][2], B0[2][2], B1[2][2];
    const char* cA = (const char*)g.A + (size_t)cur.pm * tstepA + (size_t)cur.kofs * 2; const char* cB = (const char*)g.Bt + (size_t)cur.pn * tstepB + (size_t)cur.kofs * 2;
    S.a_ready(cur);
    PG8_STAGE(PG8_SB(0, 0), cB, voffB); PG8_STAGE(PG8_SB(0, 1), cB + hstepB, voffB); PG8_STAGE(PG8_SA(0, 0), cA, voffA); PG8_STAGE(PG8_SA(0, 1), cA + hstepA, voffA);
    if (wr == 1) PG8_BAR;
    PG8_WAIT_V(2); PG8_BAR;
    PG8_STAGE(PG8_SB(1, 0), cB + kstep, voffB); PG8_STAGE(PG8_SA(1, 0), cA + kstep, voffA); PG8_STAGE(PG8_SB(1, 1), cB + hstepB + kstep, voffB);
    PG8_WAIT_V(6); PG8_BAR;
    for (;;) {
        nxt.kofs = 0; nxt.nt = nt; nxt.part = 0;
        const bool has_next = S.next(ui + 1, nxt);
        const char* nA = has_next ? (const char*)g.A + (size_t)nxt.pm * tstepA + (size_t)nxt.kofs * 2 : cA; const char* nB = has_next ? (const char*)g.Bt + (size_t)nxt.pn * tstepB + (size_t)nxt.kofs * 2 : cB;
        const int ntc = cur.nt;
        for (int t = 0; t < ntc; t += 2) {
            const bool last = (t == ntc - 2);
            const char* a1 = cA + (size_t)(t + 1) * kstep;
            const char* a2 = last ? nA : cA + (size_t)(t + 2) * kstep; const char* b2 = last ? nB : cB + (size_t)(t + 2) * kstep;
            const char* a3 = a2 + kstep; const char* b3 = b2 + kstep;
            if (last && has_next) S.a_ready(nxt);
            PG8_LDB(B0, 0, 0); PG8_LDB(B1, 0, 1); PG8_SCHED; PG8_LDA(At, 0, 0); PG8_STAGE(PG8_SA(1, 1), a1 + hstepA, voffA);
            PG8_WAIT_V(8); PG8_WAIT_L(0); PG8_BAR; PG8_MMA(0, 0, At, B0); PG8_MMA(0, 1, At, B1); PG8_BAR; PG8_SCHED;
            PG8_LDA(At, 0, 1); PG8_STAGE(PG8_SB(0, 0), b2, voffB); PG8_STAGE(PG8_SB(0, 1), b2 + hstepB, voffB); PG8_STAGE(PG8_SA(0, 0), a2, voffA);
            PG8_WAIT_V(8); PG8_WAIT_L(0); PG8_BAR; PG8_MMA(1, 0, At, B0); PG8_MMA(1, 1, At, B1); PG8_BAR; PG8_SCHED;
            PG8_LDB(B0, 1, 0); PG8_LDB(B1, 1, 1); PG8_SCHED; PG8_LDA(At, 1, 0); PG8_STAGE(PG8_SA(0, 1), a2 + hstepA, voffA);
            PG8_WAIT_V(8); PG8_WAIT_L(0); PG8_BAR; PG8_MMA(0, 0, At, B0); PG8_MMA(0, 1, At, B1); PG8_BAR; PG8_SCHED;
            PG8_LDA(At, 1, 1); PG8_STAGE(PG8_SB(1, 0), b3, voffB); PG8_STAGE(PG8_SB(1, 1), b3 + hstepB, voffB); PG8_STAGE(PG8_SA(1, 0), a3, voffA);
            PG8_WAIT_V(8); PG8_WAIT_L(0); PG8_BAR; PG8_MMA(1, 0, At, B0); PG8_MMA(1, 1, At, B1); PG8_BAR; PG8_SCHED;
        }
        if constexpr (ALIGN_EPI) { if (wr == 0) PG8_BAR; }
        E(acc, cur, wr, wc, fr, fq); S.done(cur);
        if (!has_next) break;
#pragma unroll
        for (int a = 0; a < 2; ++a)
#pragma unroll
            for (int b = 0; b < 2; ++b)
#pragma unroll
                for (int m = 0; m < 4; ++m)
#pragma unroll
                    for (int n = 0; n < 2; ++n) acc[a][b][m][n] = (f32x4){0.f, 0.f, 0.f, 0.f};
        cur = nxt; cA = nA; cB = nB; ++ui;
        if constexpr (ALIGN_EPI) { if (wr == 1) PG8_BAR; }
    }
    PG8_WAIT_V(0);
    if constexpr (!ALIGN_EPI) { if (wr == 0) PG8_BAR; }
    PG8_BAR;
#undef PG8_SA
#undef PG8_SB
#undef PG8_STAGE
#undef PG8_LDA
#undef PG8_LDB
#undef PG8_MMA
#undef PG8_WAIT_V
#undef PG8_WAIT_L
#undef PG8_BAR
#undef PG8_SCHED
}
}

namespace at {
using bf16_t = unsigned short;
using bf16x8 = __attribute__((ext_vector_type(8))) short;
using s16x4  = __attribute__((ext_vector_type(4))) short;
using f32x16 = __attribute__((ext_vector_type(16))) float;
using u32x4  = __attribute__((ext_vector_type(4))) unsigned;
constexpr int NW = 8, QBLK = 32, KVBLK = 64;
constexpr int SHM_V = 16384, SHM_K = 16384, SHM_K2 = 8192;
constexpr int OFF_V = 0, OFF_K = 2 * SHM_V, OFF_K2 = OFF_K + 2 * SHM_K, OFF_WS = OFF_K2 + 2 * SHM_K2, OFF_Q2 = OFF_WS + NW * 64 * 4, OFF_FLG = OFF_Q2 + NW * 6144, ATT_LDS = OFF_FLG + 16;
constexpr float THR = 8.f;
constexpr int DUMP_FLOATS = NW * 66 * 64;
#define KSWZ(row, colB) ((row) * 256 + ((colB) ^ (((row) & 7) << 4)))
#define KSWZ2(row, colB) ((row) * 128 + ((colB) ^ (((row) & 7) << 4)))
#define SBAR() __builtin_amdgcn_sched_barrier(0)
__device__ __forceinline__ int crow(int r, int hi) { return (r & 3) + 8 * (r >> 2) + 4 * hi; }
__device__ __forceinline__ unsigned cvtpk(float lo, float hi) { unsigned r; asm volatile("v_cvt_pk_bf16_f32 %0, %1, %2" : "=v"(r) : "v"(lo), "v"(hi)); return r; }

struct AUnit {
    const bf16_t* Q; const bf16_t* KV; const bf16_t* K2; bf16_t* O;
    long kc, kl, vc, vl, k2c, k2l;
    int ldq, ldk, ldv, ldk2, ldo;
    int nct, ntl;
    float* part_own; const float* part_oth; unsigned* cnt;
    int qk_off;
    float sink;
};

template <int DK>
__device__ __forceinline__ void partialSM(f32x16& p0, f32x16& p1, float& m_reg, float& mn, float& alpha) {
    constexpr float SCALE = DK == 128 ? 0.08838834764831845f : 0.07216878364870323f, C = SCALE * 1.4426950408889634f;
    float pmax = p0[0];
#pragma unroll
    for (int r = 1; r < 16; ++r) pmax = fmaxf(pmax, p0[r]);
#pragma unroll
    for (int r = 0; r < 16; ++r) pmax = fmaxf(pmax, p1[r]);
    { auto rr = __builtin_amdgcn_permlane32_swap(__float_as_uint(pmax), __float_as_uint(pmax), false, false);
      pmax = fmaxf(__uint_as_float(rr[0]), __uint_as_float(rr[1])); }
    if (__builtin_expect(__all(pmax - m_reg <= THR / SCALE), 1)) { mn = m_reg; alpha = 1.f; }
    else { mn = fmaxf(m_reg, pmax); alpha = __builtin_amdgcn_exp2f((m_reg - mn) * C); m_reg = mn; }
    const float mnC = -mn * C;
#pragma unroll
    for (int r = 0; r < 16; ++r) p0[r] = fmaf(p0[r], C, mnC);
#pragma unroll
    for (int r = 0; r < 16; ++r) p1[r] = fmaf(p1[r], C, mnC);
#pragma unroll
    for (int r = 0; r < 16; ++r) p0[r] = __builtin_amdgcn_exp2f(p0[r]);
}
__device__ __forceinline__ void finishSM(f32x16& p0, f32x16& p1, float alpha, float& l_reg, bf16x8& pa0, bf16x8& pa1, bf16x8& pa2, bf16x8& pa3) {
#pragma unroll
    for (int r = 0; r < 16; ++r) p1[r] = __builtin_amdgcn_exp2f(p1[r]);
    float ps = 0;
#pragma unroll
    for (int r = 0; r < 16; ++r) ps += p0[r];
#pragma unroll
    for (int r = 0; r < 16; ++r) ps += p1[r];
    { auto rr = __builtin_amdgcn_permlane32_swap(__float_as_uint(ps), __float_as_uint(ps), false, false);
      ps = __uint_as_float(rr[0]) + __uint_as_float(rr[1]); }
    l_reg = l_reg * alpha + ps;
#define PK4(P, BASE, OUT) do { unsigned a0 = cvtpk(P[BASE + 0], P[BASE + 1]), a1 = cvtpk(P[BASE + 2], P[BASE + 3]);   \
    unsigned b0 = cvtpk(P[BASE + 4], P[BASE + 5]), b1 = cvtpk(P[BASE + 6], P[BASE + 7]);                              \
    auto r0 = __builtin_amdgcn_permlane32_swap(a0, b0, false, false); auto r1 = __builtin_amdgcn_permlane32_swap(a1, b1, false, false); \
    u32x4 w = {r0[0], r1[0], r0[1], r1[1]}; OUT = *reinterpret_cast<bf16x8*>(&w); } while (0)
    PK4(p0, 0, pa0); PK4(p0, 8, pa1); PK4(p1, 0, pa2); PK4(p1, 8, pa3);
#undef PK4
}
template <int DK>
__device__ __forceinline__ void qkt(f32x16& p0, f32x16& p1, const char* Ks, const char* K2s, const bf16x8* qr, const char* q2, int r32, int hi) {
    constexpr int NQR = 8;
    p0 = f32x16{}; p1 = f32x16{};
#pragma unroll
    for (int d0 = 0; d0 < 8; ++d0) { const int cb = (d0 * 16 + hi * 8) * 2;
        const bf16x8 b0 = *reinterpret_cast<const bf16x8*>(Ks + KSWZ(r32, cb));
        const bf16x8 b1 = *reinterpret_cast<const bf16x8*>(Ks + KSWZ(32 + r32, cb));
        bf16x8 qf; if (d0 < NQR) qf = qr[d0 < NQR ? d0 : 0]; else qf = *reinterpret_cast<const bf16x8*>(q2 + (d0 - 8) * 1024);
        p0 = __builtin_amdgcn_mfma_f32_32x32x16_bf16(b0, qf, p0, 0, 0, 0);
        p1 = __builtin_amdgcn_mfma_f32_32x32x16_bf16(b1, qf, p1, 0, 0, 0); }
    if constexpr (DK == 192) {
#pragma unroll
        for (int d0 = 0; d0 < 4; ++d0) { const int cb = (d0 * 16 + hi * 8) * 2;
            const bf16x8 b0 = *reinterpret_cast<const bf16x8*>(K2s + KSWZ2(r32, cb));
            const bf16x8 b1 = *reinterpret_cast<const bf16x8*>(K2s + KSWZ2(32 + r32, cb));
            const bf16x8 qf = *reinterpret_cast<const bf16x8*>(q2 + d0 * 1024);
            p0 = __builtin_amdgcn_mfma_f32_32x32x16_bf16(b0, qf, p0, 0, 0, 0);
            p1 = __builtin_amdgcn_mfma_f32_32x32x16_bf16(b1, qf, p1, 0, 0, 0); }
    }
}
__device__ __forceinline__ int v_st(int k, int c) { const int kk = (k & ~0xC) | ((k & 4) << 1) | ((k & 8) >> 1); return ((kk >> 3) * 4 + (c >> 5)) * 512 + ((kk & 7) * 32 + (c & 31)) * 2; }
__device__ __forceinline__ int v_rd_base(int lane) { return ((lane & 3) << 3) | (((lane >> 2) & 3) << 6) | (((lane >> 4) & 1) << 5) | (((lane >> 5) & 1) << 8); }
constexpr int v_rd_off(int d0, int ks, int half) { return d0 * 512 + ks * 4096 + half * 2048; }
template <int OFF> __device__ __forceinline__ s16x4 tr_read(int vb) {
    s16x4 r; asm volatile("ds_read_b64_tr_b16 %0, %1 offset:%2" : "=&v"(r) : "v"(vb), "i"(OFF) : "memory"); return r;
}
struct VFrag { s16x4 l0, h0, l1, h1, l2, h2, l3, h3; };
template <int D0> __device__ __forceinline__ void v_load(VFrag& f, int vb) {
    f.l0 = tr_read<v_rd_off(D0, 0, 0)>(vb); f.h0 = tr_read<v_rd_off(D0, 0, 1)>(vb); f.l1 = tr_read<v_rd_off(D0, 1, 0)>(vb); f.h1 = tr_read<v_rd_off(D0, 1, 1)>(vb);
    f.l2 = tr_read<v_rd_off(D0, 2, 0)>(vb); f.h2 = tr_read<v_rd_off(D0, 2, 1)>(vb); f.l3 = tr_read<v_rd_off(D0, 3, 0)>(vb); f.h3 = tr_read<v_rd_off(D0, 3, 1)>(vb);
}
__device__ __forceinline__ void v_mma(f32x16& od, const VFrag& f, bf16x8 pa0, bf16x8 pa1, bf16x8 pa2, bf16x8 pa3) {
#define PK(L, H) (bf16x8){L[0], L[1], L[2], L[3], H[0], H[1], H[2], H[3]}
    od = __builtin_amdgcn_mfma_f32_32x32x16_bf16(pa0, PK(f.l0, f.h0), od, 0, 0, 0);
    od = __builtin_amdgcn_mfma_f32_32x32x16_bf16(pa1, PK(f.l1, f.h1), od, 0, 0, 0);
    od = __builtin_amdgcn_mfma_f32_32x32x16_bf16(pa2, PK(f.l2, f.h2), od, 0, 0, 0);
    od = __builtin_amdgcn_mfma_f32_32x32x16_bf16(pa3, PK(f.l3, f.h3), od, 0, 0, 0);
#undef PK
}
template <int D0> __device__ __forceinline__ void pv_one(f32x16& od, int vb, bf16x8 pa0, bf16x8 pa1, bf16x8 pa2, bf16x8 pa3) {
    VFrag f; v_load<D0>(f, vb);
    asm volatile("s_waitcnt lgkmcnt(0)" ::: "memory"); SBAR();
    v_mma(od, f, pa0, pa1, pa2, pa3);
}
template <bool PIPE> __device__ __forceinline__ void pv_d0(f32x16* o, int vb, bf16x8 pa0, bf16x8 pa1, bf16x8 pa2, bf16x8 pa3) {
    if constexpr (!PIPE) { pv_one<0>(o[0], vb, pa0, pa1, pa2, pa3); pv_one<1>(o[1], vb, pa0, pa1, pa2, pa3); pv_one<2>(o[2], vb, pa0, pa1, pa2, pa3); pv_one<3>(o[3], vb, pa0, pa1, pa2, pa3); return; }
    VFrag fa, fb;
    v_load<0>(fa, vb); v_load<1>(fb, vb);
    asm volatile("s_waitcnt lgkmcnt(8)" ::: "memory"); SBAR(); v_mma(o[0], fa, pa0, pa1, pa2, pa3); SBAR();
    v_load<2>(fa, vb);
    asm volatile("s_waitcnt lgkmcnt(8)" ::: "memory"); SBAR(); v_mma(o[1], fb, pa0, pa1, pa2, pa3); SBAR();
    v_load<3>(fb, vb);
    asm volatile("s_waitcnt lgkmcnt(8)" ::: "memory"); SBAR(); v_mma(o[2], fa, pa0, pa1, pa2, pa3); SBAR();
    asm volatile("s_waitcnt lgkmcnt(0)" ::: "memory"); SBAR(); v_mma(o[3], fb, pa0, pa1, pa2, pa3);
}
__device__ __forceinline__ void wmask(f32x16& p0, f32x16& p1, int base, int hi) {
#pragma unroll
    for (int r = 0; r < 16; ++r) { const int d0 = base + (r & 3) + 8 * (r >> 2) + 4 * hi, d1 = d0 + 32;
        if (d0 > 128 || d0 < -128) p0[r] = -1e30f; if (d1 > 128 || d1 < -128) p1[r] = -1e30f; }
}

template <int DK, bool WINDOW, bool SPLIT = false, int SD = 1>
__device__ __forceinline__ void attn_unit(const AUnit U, char* lds) {
    constexpr int ND0 = DK / 16;
    constexpr float SCALE = DK == 128 ? 0.08838834764831845f : 0.07216878364870323f, C = SCALE * 1.4426950408889634f;
    int tid_ = threadIdx.x; asm volatile("" : "+v"(tid_));
    const int tid = tid_, wid = __builtin_amdgcn_readfirstlane(tid >> 6), lane = tid & 63, r32 = lane & 31, hi = lane >> 5;
    char* V_lds = lds + OFF_V; char* K_lds = lds + OFF_K; char* K2_lds = lds + OFF_K2;
    float* ws = (float*)(lds + OFF_WS) + wid * 64; float* li_l = ws; float* al_l = ws + 32;
    float m_reg = -1e30f, l_reg = 0; f32x16 o[4] = {}; bf16x8 qr[8];
    char* q2 = lds + OFF_Q2 + wid * 6144 + lane * 16;
    const bf16_t* Qw = U.Q + (size_t)(wid * QBLK + r32) * U.ldq + hi * 8;
#pragma unroll
    for (int d0 = 0; d0 < 8; ++d0) qr[d0] = *reinterpret_cast<const bf16x8*>(Qw + d0 * 16);
    if constexpr (DK == 192) {
#pragma unroll
        for (int d0 = 8; d0 < 12; ++d0) *reinterpret_cast<bf16x8*>(q2 + (d0 - 8) * 1024) = *reinterpret_cast<const bf16x8*>(Qw + d0 * 16);
    }
    const int sr = tid >> 4, sc = (tid & 15) * 8, vst0 = v_st(sr, sc), vst1 = v_st(32 + sr, sc);
    const int sr2 = tid >> 3, sc2 = (tid & 7) * 8;
    const int vb0 = (int)(uintptr_t)V_lds + v_rd_base(lane);
    bf16x8 vsE0, vsE1, ksE0, ksE1, k2E, vsO0, vsO1, ksO0, ksO1, k2O;
    const int NT = U.nct + U.ntl, nct = U.nct;
#define SLOAD(S, t) do { const int t_ = (t); const bool cx_ = t_ < nct; const long ro_ = (long)((cx_ ? t_ : t_ - nct) * KVBLK); \
    const bf16_t* kb_ = U.KV + ((cx_ ? U.kc : U.kl) + ro_ * U.ldk); const bf16_t* vb_ = U.KV + ((cx_ ? U.vc : U.vl) + ro_ * U.ldv); \
    vs##S##0 = *reinterpret_cast<const bf16x8*>(vb_ + (long)sr * U.ldv + sc); vs##S##1 = *reinterpret_cast<const bf16x8*>(vb_ + (long)(32 + sr) * U.ldv + sc); \
    ks##S##0 = *reinterpret_cast<const bf16x8*>(kb_ + (long)sr * U.ldk + sc); ks##S##1 = *reinterpret_cast<const bf16x8*>(kb_ + (long)(32 + sr) * U.ldk + sc); \
    if constexpr (DK == 192) { const bf16_t* k2_ = U.K2 + ((cx_ ? U.k2c : U.k2l) + ro_ * U.ldk2); k2##S = *reinterpret_cast<const bf16x8*>(k2_ + (long)sr2 * U.ldk2 + sc2); } } while (0)
#define SWRITE(b, S) do { *(bf16x8*)(V_lds + (b) * SHM_V + vst0) = vs##S##0; *(bf16x8*)(V_lds + (b) * SHM_V + vst1) = vs##S##1; const int kc_ = sc * 2; \
    *(bf16x8*)(K_lds + (b) * SHM_K + KSWZ(sr, kc_)) = ks##S##0; *(bf16x8*)(K_lds + (b) * SHM_K + KSWZ(32 + sr, kc_)) = ks##S##1; \
    if constexpr (DK == 192) { *(bf16x8*)(K2_lds + (b) * SHM_K2 + KSWZ2(sr2, sc2 * 2)) = k2##S; } } while (0)
#define RESC(a) do { if (__any((a) < 1.f)) { if (hi == 0) al_l[r32] = (a); asm volatile("s_waitcnt lgkmcnt(0)" ::: "memory"); \
    _Pragma("unroll") for (int d = 0; d < 4; ++d) _Pragma("unroll") for (int r = 0; r < 16; ++r) o[d][r] *= al_l[crow(r, hi)]; } } while (0)
#define WMASK(P0, P1, t) do { if constexpr (WINDOW) { if ((t) >= 4) wmask(P0, P1, U.qk_off + ((t) - 4) * KVBLK - wid * QBLK - r32, hi); } } while (0)
    f32x16 pA0, pA1, pB0, pB1; float mnA, mnB, alA, alB; bf16x8 pa0, pa1, pa2, pa3;
    SLOAD(E, 0); SWRITE(0, E); __syncthreads();
    qkt<DK>(pA0, pA1, K_lds, K2_lds, qr, q2, r32, hi); partialSM<DK>(pA0, pA1, m_reg, mnA, alA);
    if constexpr (SD == 2) { SLOAD(O, 1); SLOAD(E, 2); SWRITE(1, O); } else { SLOAD(E, 1); SWRITE(1, E); }
    __syncthreads();
    for (int j = 1; j + 1 < NT; j += 2) {
        SBAR(); qkt<DK>(pB0, pB1, K_lds + SHM_K, K2_lds + SHM_K2, qr, q2, r32, hi); WMASK(pB0, pB1, j);
        finishSM(pA0, pA1, alA, l_reg, pa0, pa1, pa2, pa3); SBAR();
        if constexpr (SD == 2) SLOAD(O, j + 2); else SLOAD(E, j + 1);
        SBAR();
        pv_d0<false>(o, vb0, pa0, pa1, pa2, pa3); partialSM<DK>(pB0, pB1, m_reg, mnB, alB);
        __syncthreads(); SWRITE(0, E);
        RESC(alB); __syncthreads();
        SBAR(); qkt<DK>(pA0, pA1, K_lds, K2_lds, qr, q2, r32, hi); WMASK(pA0, pA1, j + 1);
        finishSM(pB0, pB1, alB, l_reg, pa0, pa1, pa2, pa3); SBAR();
        if constexpr (SD == 2) { if (j + 3 < NT) SLOAD(E, j + 3); } else SLOAD(E, j + 2);
        SBAR();
        pv_d0<false>(o, vb0 + SHM_V, pa0, pa1, pa2, pa3); partialSM<DK>(pA0, pA1, m_reg, mnA, alA);
        __syncthreads();
        if constexpr (SD == 2) SWRITE(1, O); else SWRITE(1, E);
        RESC(alA); __syncthreads();
    }
    SBAR(); qkt<DK>(pB0, pB1, K_lds + SHM_K, K2_lds + SHM_K2, qr, q2, r32, hi); WMASK(pB0, pB1, NT - 1);
    finishSM(pA0, pA1, alA, l_reg, pa0, pa1, pa2, pa3); SBAR();
    pv_d0<false>(o, vb0, pa0, pa1, pa2, pa3); partialSM<DK>(pB0, pB1, m_reg, mnB, alB);
    __syncthreads(); RESC(alB);
    finishSM(pB0, pB1, alB, l_reg, pa0, pa1, pa2, pa3); SBAR();
    pv_d0<false>(o, vb0 + SHM_V, pa0, pa1, pa2, pa3);
    if constexpr (SPLIT) {
        float* dmp = U.part_own + (size_t)(wid * 66) * 64 + lane;
#pragma unroll
        for (int d = 0; d < 4; ++d)
#pragma unroll
            for (int r = 0; r < 16; ++r) dmp[(d * 16 + r) * 64] = o[d][r];
        dmp[64 * 64] = m_reg; dmp[65 * 64] = l_reg;
        asm volatile("s_waitcnt vmcnt(0)" ::: "memory"); __syncthreads();
        volatile unsigned* flg = (volatile unsigned*)(lds + OFF_FLG);
        if (tid == 0) {
            __builtin_amdgcn_fence(__ATOMIC_RELEASE, "agent"); asm volatile("s_waitcnt vmcnt(0)" ::: "memory");
            const unsigned old = __hip_atomic_fetch_add(U.cnt, 1u, __ATOMIC_RELAXED, __HIP_MEMORY_SCOPE_AGENT);
            if (old != 0u) { __builtin_amdgcn_fence(__ATOMIC_ACQUIRE, "agent"); asm volatile("s_waitcnt vmcnt(0)" ::: "memory"); }
            flg[0] = old;
        }
        __syncthreads();
        if (flg[0] == 0u) { __syncthreads(); return; }
        const float* oth = U.part_oth + (size_t)(wid * 66) * 64 + lane;
        const float m2 = oth[64 * 64], l2 = oth[65 * 64];
        const float mm = fmaxf(m_reg, m2), w1 = __builtin_amdgcn_exp2f((m_reg - mm) * C), w2 = __builtin_amdgcn_exp2f((m2 - mm) * C);
        l_reg = l_reg * w1 + l2 * w2; m_reg = mm;
        if (hi == 0) { li_l[r32] = w1; al_l[r32] = w2; }
        asm volatile("s_waitcnt lgkmcnt(0)" ::: "memory");
#pragma unroll
        for (int d = 0; d < 4; ++d)
#pragma unroll
            for (int r = 0; r < 16; ++r) o[d][r] = o[d][r] * li_l[crow(r, hi)] + oth[(d * 16 + r) * 64] * al_l[crow(r, hi)];
        asm volatile("s_waitcnt lgkmcnt(0)" ::: "memory");
    }
    l_reg += __builtin_amdgcn_exp2f(U.sink * 1.4426950408889634f - m_reg * C);
    if (hi == 0) li_l[r32] = l_reg; asm volatile("s_waitcnt lgkmcnt(0)" ::: "memory");
    float rli[16];
#pragma unroll
    for (int r = 0; r < 16; ++r) rli[r] = __builtin_amdgcn_rcpf(li_l[crow(r, hi)]);
    __syncthreads();
    bf16_t* stg = (bf16_t*)(lds + wid * 8192);
#pragma unroll
    for (int r = 0; r < 16; ++r) { const int orow = crow(r, hi);
#pragma unroll
        for (int d0 = 0; d0 < 4; ++d0) { const float v = o[d0][r] * rli[r]; stg[orow * 128 + d0 * 32 + r32] = (bf16_t)(cvtpk(v, v) & 0xffffu); } }
    asm volatile("s_waitcnt lgkmcnt(0)" ::: "memory");
    bf16_t* Ow = U.O + (size_t)(wid * QBLK) * U.ldo;
#pragma unroll
    for (int i = 0; i < 8; ++i) { const int row = i * 4 + (lane >> 4), ch = lane & 15; const u32x4 v = *(const u32x4*)(stg + row * 128 + ch * 8); gst16(Ow + (size_t)row * U.ldo + ch * 8, v); }
    __syncthreads();
#undef SLOAD
#undef SWRITE
#undef RESC
#undef WMASK
}
#undef KSWZ
#undef KSWZ2
#undef SBAR
}

#ifndef MERGE_POST
#define MERGE_POST 1
#endif
#ifndef COUNTED_NEXT
#define COUNTED_NEXT 0
#endif
#ifndef MERGE_THIN
#define MERGE_THIN 1
#endif
namespace mk {
constexpr int NWAVES = 8;
constexpr int D = 2048, SEQ = 4096, LCTX = 256, NL = 8192, NC = 512, NR = 8704, DEPTH = 4;
constexpr int DIN = 3392, NIN = 3584  , DFF = 5632;
constexpr int O_AQ = 0, O_AK = 768, O_AV = 1024, O_BQ = 1280, O_BK = 2048, O_BV = 2304, O_CQ = 2560, O_CKV = 3072, O_CKR = 3328;
constexpr float EPS = 1e-6f;
typedef unsigned short bf16;
typedef float f32x4 __attribute__((ext_vector_type(4)));
typedef float f32x2 __attribute__((ext_vector_type(2)));
typedef unsigned u32x4v __attribute__((ext_vector_type(4)));
typedef unsigned u32x2v __attribute__((ext_vector_type(2)));

constexpr size_t MiB = 1u << 20;
constexpr size_t WS_CTL = 0, CTL_ZERO_BYTES = 1 * MiB;
constexpr size_t WS_MODV = 2 * MiB;
constexpr size_t WS_COMB = 3 * MiB;
constexpr size_t WS_TAB128 = 4 * MiB, WS_TAB64 = 4 * MiB + 16384;
constexpr size_t WS_SSQ = 5 * MiB;
constexpr size_t WS_SSQB = 6 * MiB;
constexpr size_t WS_W = 8 * MiB;
constexpr size_t W_IN = 0, W_UQ = W_IN + (size_t)NIN * D * 2, W_UKV = W_UQ + (size_t)768 * 512 * 2, W_OUT = W_UKV + (size_t)1024 * 256 * 2,
                 W_13 = W_OUT + (size_t)D * D * 2, W_2 = W_13 + (size_t)2 * DFF * D * 2, W_LAYER = W_2 + (size_t)D * DFF * 2;
constexpr size_t WS_X = WS_W + DEPTH * W_LAYER;
constexpr size_t WS_H = WS_X + (size_t)NR * D * 4;
constexpr size_t WS_P = WS_H + (size_t)NR * D * 2;
constexpr size_t WS_QC = WS_P + (size_t)NR * NIN * 2;
constexpr size_t WS_KVC = WS_QC + (size_t)NR * 768 * 2;
constexpr size_t WS_CAT = WS_KVC + (size_t)NR * 1024 * 2;
constexpr size_t WS_OF = WS_CAT + (size_t)NR * D * 2;
constexpr size_t WS_U = WS_OF + (size_t)NR * D * 2;
constexpr size_t WS_OFP = WS_U + (size_t)NR * DFF * 2;
#ifndef PROBE_C
#define PROBE_C 0
#endif
#ifndef PROBE_D
#define PROBE_D 0
#endif
#ifndef CONV_PIPE
#define CONV_PIPE 0
#endif
#ifndef CONV_CI_A
#define CONV_CI_A 2
#endif
#ifndef CONV_CI_B
#define CONV_CI_B 0
#endif
#ifndef CONV_CF
#define CONV_CF 0
#endif
#ifndef IN_CQ_FIRST
#define IN_CQ_FIRST 0
#endif
constexpr int NP_OUT = 8, NP_F2 = 11;
constexpr size_t WS_PART = WS_OFP + (size_t)NP_F2 * NC * D * 2;
constexpr size_t WS_END = WS_PART + (size_t)64 * 2 * 33792 * 4;
static_assert(W_LAYER % 256 == 0 && WS_X % 256 == 0, "alignment");
constexpr int CW_BAR = 4096;
constexpr int CW_CONVQ = 8192;
constexpr int CW_ATTQ = 8192 + 64;
constexpr int CW_PAN = 40960;
constexpr int CW_SPLIT = 16384;

constexpr int RING_BYTES = 139264  , LDSCTL_OFF = RING_BYTES, MISC_OFF = LDSCTL_OFF + 320, LDS_BYTES = 147456;

#define GAS __attribute__((address_space(1)))
#define LAS __attribute__((address_space(3)))
#define LDS_WAIT() asm volatile("s_waitcnt lgkmcnt(0)" ::: "memory")
#define VM_WAIT() asm volatile("s_waitcnt vmcnt(0)" ::: "memory")
__device__ __forceinline__ unsigned cvtpk(float lo, float hi) { unsigned r; asm volatile("v_cvt_pk_bf16_f32 %0, %1, %2" : "=v"(r) : "v"(lo), "v"(hi)); return r; }
__device__ __forceinline__ float bf_lo(unsigned w) { return __uint_as_float(w << 16); }
__device__ __forceinline__ float bf_hi(unsigned w) { return __uint_as_float(w & 0xffff0000u); }

#define XB_TMO      128
#define XB_XCNT(j)  (256  + 64 * (j))
#define XB_XSUB(j)  (1280 + 64 * (j))
#define XB_XGEN(j)  (2304 + 64 * (j))
#define XB_TOP      3328
#define XB_TOPGEN   3392
#define XCD_BAR_WORDS 3456
#define XB_SPIN_CAP (1u << 18)
__device__ __forceinline__ unsigned xb_ld(unsigned* p)              { return __hip_atomic_load(p, __ATOMIC_RELAXED, __HIP_MEMORY_SCOPE_AGENT); }
__device__ __forceinline__ unsigned xb_add(unsigned* p, unsigned v) { return __hip_atomic_fetch_add(p, v, __ATOMIC_RELAXED, __HIP_MEMORY_SCOPE_AGENT); }
__device__ __forceinline__ unsigned xb_xcc_id() { return (unsigned)__builtin_amdgcn_s_getreg((3 << 11) | 20) & 0xFu; }
#define XB_SPIN(cond, bar) do { unsigned _sp = 0; while (cond) { __builtin_amdgcn_s_sleep(1); \
    if ((++_sp & 255u) == 0u) { if (xb_ld(&(bar)[XB_TMO])) break; if (_sp > XB_SPIN_CAP) { atomicAdd(&(bar)[XB_TMO], 1u); break; } } } } while (0)
struct XcdBarrier { unsigned* bar; unsigned x; volatile LAS unsigned* st; };
__device__ __forceinline__ XcdBarrier xcd_barrier_post(unsigned* bar, volatile LAS unsigned* st) {
    XcdBarrier b; b.bar = bar; b.x = xb_xcc_id(); b.st = st;
    if (threadIdx.x == 0) (void)xb_add(&bar[XB_XCNT(b.x)], 1u);
    return b;
}
__device__ __forceinline__ void xcd_barrier_complete(unsigned* bar, unsigned x, unsigned& nloc, unsigned& nx) {
    const unsigned G = gridDim.x * gridDim.y * gridDim.z;
    unsigned sum, cnt, mine, sp = 0u;
    for (;;) {
        sum = 0u; cnt = 0u; mine = 0u;
#pragma unroll
        for (unsigned j = 0; j < 16; ++j) { const unsigned c = xb_ld(&bar[XB_XCNT(j)]); sum += c; cnt += (c > 0u) ? 1u : 0u; mine = (j == x) ? c : mine; }
        if (sum == G) break;
        __builtin_amdgcn_s_sleep(1);
        if ((++sp & 255u) == 0u) { if (xb_ld(&bar[XB_TMO])) break; if (sp > XB_SPIN_CAP) { atomicAdd(&bar[XB_TMO], 1u); break; } }
    }
    nloc = mine > 0u ? mine : 1u; nx = cnt > 0u ? cnt : 1u;
}
__device__ __forceinline__ void xcd_barrier(const XcdBarrier& b) {
    asm volatile("s_waitcnt vmcnt(0)" ::: "memory");
    __syncthreads();
    if (threadIdx.x == 0) {
        unsigned* bar = b.bar;
        __builtin_amdgcn_s_waitcnt(0);
        unsigned nloc = b.st[0], nx = b.st[1];
        if (nloc == 0u) { xcd_barrier_complete(bar, b.x, nloc, nx); b.st[0] = nloc; b.st[1] = nx; }
        const unsigned old = xb_add(&bar[XB_XSUB(b.x)], 1u);
        const unsigned gen = old / nloc;
        if (old + 1u == (gen + 1u) * nloc) {
            __builtin_amdgcn_fence(__ATOMIC_RELEASE, "agent");
            asm volatile("s_waitcnt vmcnt(0)" ::: "memory");
            const unsigned og = xb_add(&bar[XB_TOP], 1u);
            const unsigned tg = og / nx;
            if (og + 1u == (tg + 1u) * nx) xb_add(&bar[XB_TOPGEN], 1u);
            else XB_SPIN(xb_ld(&bar[XB_TOPGEN]) == tg, bar);
            __builtin_amdgcn_fence(__ATOMIC_ACQUIRE, "agent");
            xb_add(&bar[XB_XGEN(b.x)], 1u);
            asm volatile("s_waitcnt vmcnt(0)" ::: "memory");
        } else {
            XB_SPIN(xb_ld(&bar[XB_XGEN(b.x)]) == gen, bar);
            __builtin_amdgcn_fence(__ATOMIC_ACQUIRE, "agent");
            asm volatile("s_waitcnt vmcnt(0)" ::: "memory");
        }
    }
    __syncthreads();
}

struct Args { const float* in[22]; float* out; unsigned char* ws; int ph_lo, ph_hi; };
enum { I_X = 0, I_C, I_CTX, I_CCTX, I_WMOD, I_BMOD, I_GMIXPRE, I_GMIXPOST, I_GFFNPRE, I_GFFNPOST, I_WIN, I_SINK, I_GQN, I_GKN, I_GCQ, I_WUQ, I_GCKV, I_WUKV, I_WOUT, I_W1, I_W3, I_W2 };

__device__ __forceinline__ float wave_sum(float v) {
#pragma unroll
    for (int o = 1; o < 64; o <<= 1) v += __shfl_xor(v, o);
    return v;
}
__device__ __forceinline__ int row_s(int r) { return r < NL ? (r >> 12) : 2; }

__device__ __forceinline__ void transpose_item(const float* W, int N, int k0, int n0, bf16* WTrow0, int ldt, const float* kgain, LAS float* scr, int lane, bool permute = false) {
    f32x4 v[16];
    const float* src = W + (size_t)(k0 + (lane >> 4)) * N + n0 + 4 * (lane & 15);
#pragma unroll
    for (int i = 0; i < 16; ++i) v[i] = *(const f32x4*)(src + (size_t)(4 * i) * N);
#pragma unroll
    for (int i = 0; i < 16; ++i) { const int kk = 4 * i + (lane >> 4); const float g = kgain ? kgain[k0 + kk] : 1.f; LAS float* d = scr + kk * 65 + 4 * (lane & 15);
        d[0] = v[i][0] * g; d[1] = v[i][1] * g; d[2] = v[i][2] * g; d[3] = v[i][3] * g; }
    LDS_WAIT(); asm volatile("" ::: "memory");
    const int c = lane & 7;
#pragma unroll
    for (int j = 0; j < 8; ++j) { const int n = (lane >> 3) + 8 * j; const LAS float* s = scr + (8 * c) * 65 + n;
        u32x4v o; o.x = cvtpk(s[0 * 65], s[1 * 65]); o.y = cvtpk(s[2 * 65], s[3 * 65]); o.z = cvtpk(s[4 * 65], s[5 * 65]); o.w = cvtpk(s[6 * 65], s[7 * 65]);
        gst16(WTrow0 + (size_t)(permute ? pg8::perm64(n) : n) * ldt + k0 + 8 * c, o); }
    LDS_WAIT(); asm volatile("" ::: "memory");
}
constexpr int IT_IN = (D / 64) * (DIN / 64), IT_UQ = (512 / 64) * (768 / 64), IT_UKV = (256 / 64) * (1024 / 64), IT_OUT = (D / 64) * (D / 64), IT_1 = (D / 64) * (DFF / 64), IT_2 = (DFF / 64) * (D / 64);
constexpr int IT_LAYER = IT_IN + IT_UQ + IT_UKV + IT_OUT + 2 * IT_1 + IT_2, IT_ALL = DEPTH * IT_LAYER, CONV_CHUNKS = (IT_LAYER + 47) / 48;
static_assert(CONV_CHUNKS == 236, "the attention queue's entry map is written for 236 conversion chunks");
constexpr int NA_CONV = CONV_CHUNKS - 18 * (CONV_CI_A + CONV_CI_B) - 40 * CONV_CF;
static_assert(NA_CONV >= 0, "more idle-slot chunks than chunks");
struct TDesc { const float* W; int N, k0, n0; bf16* WT; int ldt; const float* kg; bool perm; };
__device__ __forceinline__ TDesc conv_desc(const Args& a, int it) {
    const int l = it / IT_LAYER; int r = it % IT_LAYER;
    unsigned char* wl = a.ws + WS_W + (size_t)l * W_LAYER;
    if (r < IT_IN)  { const int nb = DIN / 64, kb = r / nb, n0 = (r % nb) * 64; const bool pm_ = (ROPE_EPI_A && n0 < O_AV) || (ROPE_EPI_B && n0 >= O_BQ && n0 < O_BV);
        return TDesc{a.in[I_WIN] + (size_t)l * D * DIN, DIN, kb * 64, n0, (bf16*)(wl + W_IN) + (size_t)n0 * D, D, nullptr, pm_}; } r -= IT_IN;
    if (r < IT_UQ)  { const int nb = 768 / 64, kb = r / nb, n0 = (r % nb) * 64; return TDesc{a.in[I_WUQ] + (size_t)l * 512 * 768, 768, kb * 64, n0, (bf16*)(wl + W_UQ) + (size_t)n0 * 512, 512, a.in[I_GCQ] + l * 512, false}; } r -= IT_UQ;
    if (r < IT_UKV) { const int nb = 1024 / 64, kb = r / nb, n0 = (r % nb) * 64; return TDesc{a.in[I_WUKV] + (size_t)l * 256 * 1024, 1024, kb * 64, n0, (bf16*)(wl + W_UKV) + (size_t)n0 * 256, 256, a.in[I_GCKV] + l * 256, false}; } r -= IT_UKV;
    if (r < IT_OUT) { const int nb = D / 64, kb = r / nb, n0 = (r % nb) * 64; return TDesc{a.in[I_WOUT] + (size_t)l * D * D, D, kb * 64, n0, (bf16*)(wl + W_OUT) + (size_t)n0 * D, D, nullptr, false}; } r -= IT_OUT;
    if (r < 2 * IT_1) { const int which = r / IT_1; r %= IT_1; const int nb = DFF / 64, kb = r / nb, n0 = (r % nb) * 64;
        const int drow = (n0 / 128) * 256 + which * 128 + (n0 % 128);
        return TDesc{a.in[which ? I_W3 : I_W1] + (size_t)l * D * DFF, DFF, kb * 64, n0, (bf16*)(wl + W_13) + (size_t)drow * D, D, nullptr, false}; } r -= 2 * IT_1;
    { const int nb = D / 64, kb = r / nb, n0 = (r % nb) * 64; return TDesc{a.in[I_W2] + (size_t)l * DFF * D, D, kb * 64, n0, (bf16*)(wl + W_2) + (size_t)n0 * DFF, DFF, nullptr, false}; }
}
__device__ __forceinline__ void conv_item(const Args& a, int it, LAS float* scr, int lane) {
    const TDesc d = conv_desc(a, it);
    transpose_item(d.W, d.N, d.k0, d.n0, d.WT, d.ldt, d.kg, scr, lane, d.perm);
}
__device__ __forceinline__ void titem_load(const TDesc& d, f32x4 (&v)[16], int lane) {
    const float* src = d.W + (size_t)(d.k0 + (lane >> 4)) * d.N + d.n0 + 4 * (lane & 15);
#pragma unroll
    for (int i = 0; i < 16; ++i) v[i] = *(const f32x4*)(src + (size_t)(4 * i) * d.N);
}
__device__ __forceinline__ void titem_store(const TDesc& d, const f32x4 (&v)[16], LAS float* scr, int lane) {
#pragma unroll
    for (int i = 0; i < 16; ++i) { const int kk = 4 * i + (lane >> 4); const float g = d.kg ? d.kg[d.k0 + kk] : 1.f; LAS float* p = scr + kk * 65 + 4 * (lane & 15);
        p[0] = v[i][0] * g; p[1] = v[i][1] * g; p[2] = v[i][2] * g; p[3] = v[i][3] * g; }
    LDS_WAIT(); asm volatile("" ::: "memory");
    const int c = lane & 7;
#pragma unroll
    for (int j = 0; j < 8; ++j) { const int n = (lane >> 3) + 8 * j; const LAS float* s = scr + (8 * c) * 65 + n;
        u32x4v o; o.x = cvtpk(s[0 * 65], s[1 * 65]); o.y = cvtpk(s[2 * 65], s[3 * 65]); o.z = cvtpk(s[4 * 65], s[5 * 65]); o.w = cvtpk(s[6 * 65], s[7 * 65]);
        gst16(d.WT + (size_t)(d.perm ? pg8::perm64(n) : n) * d.ldt + d.k0 + 8 * c, o); }
    LDS_WAIT(); asm volatile("" ::: "memory");
}
__device__ __forceinline__ void conv_items_pipe(const Args& a, int it0, int n, int it_end, LAS float* scr, int lane) {
    f32x4 va[16], vb[16];
    TDesc da = conv_desc(a, it0 < it_end ? it0 : it_end - 1), db = da;
    if (it0 < it_end) titem_load(da, va, lane);
    for (int k = 0; k < n; k += 2) {
        const int i1 = it0 + k + 1, i2 = it0 + k + 2;
        if (i1 < it_end) { db = conv_desc(a, i1); titem_load(db, vb, lane); }
        if (it0 + k < it_end) titem_store(da, va, scr, lane);
        if (k + 2 < n && i2 < it_end) { da = conv_desc(a, i2); titem_load(da, va, lane); }
        if (i1 < it_end) titem_store(db, vb, scr, lane);
    }
}
__device__ __forceinline__ void mod_unit(const Args& a, int u, LAS unsigned char* lds, int tid, int wave, int lane) {
    const int l = u / 48, nc = u % 48;
    LAS float* sc = (LAS float*)lds;
    LAS float* red = (LAS float*)(lds + 24576);
    for (int i = tid; i < 3 * D; i += NWAVES * 64) { const int s = i / D, k = i % D; const float v = s < 2 ? a.in[I_C][s * D + k] : a.in[I_CCTX][k]; sc[i] = v / (1.f + expf(-v)); }
    LDS_WAIT(); __syncthreads();
    const float* w = a.in[I_WMOD] + (size_t)l * D * 6 * D + (size_t)(wave * 256) * 6 * D + nc * 256 + lane * 4;
    f32x4 a0 = {0.f, 0.f, 0.f, 0.f}, a1 = a0, a2 = a0;
    for (int k = 0; k < 256; k += 8) {
        f32x4 wv[8];
#pragma unroll
        for (int j = 0; j < 8; ++j) wv[j] = *(const f32x4*)(w + (size_t)(k + j) * 6 * D);
#pragma unroll
        for (int j = 0; j < 8; ++j) { const int kk = wave * 256 + k + j; a0 += wv[j] * sc[kk]; a1 += wv[j] * sc[D + kk]; a2 += wv[j] * sc[2 * D + kk]; }
    }
    *(LAS f32x4*)(red + (wave * 3 + 0) * 256 + lane * 4) = a0; *(LAS f32x4*)(red + (wave * 3 + 1) * 256 + lane * 4) = a1; *(LAS f32x4*)(red + (wave * 3 + 2) * 256 + lane * 4) = a2;
    LDS_WAIT(); __syncthreads();
    for (int i = tid; i < 768; i += NWAVES * 64) { const int s = i >> 8, cidx = i & 255; float v = 0.f;
#pragma unroll
        for (int wv = 0; wv < 8; ++wv) v += red[(wv * 3 + s) * 256 + cidx];
        ((float*)(a.ws + WS_MODV))[(size_t)(l * 3 + s) * 6 * D + nc * 256 + cidx] = v + a.in[I_BMOD][l * 6 * D + nc * 256 + cidx]; }
    LDS_WAIT(); __syncthreads();
}

struct RowF { f32x4 v[8]; };
__device__ __forceinline__ void ld_row_f32(RowF& r, const float* p, int lane) {
#pragma unroll
    for (int j = 0; j < 8; ++j) r.v[j] = *(const f32x4*)(p + 4 * lane + 256 * j);
}
__device__ __forceinline__ void ld_row_bf16(RowF& r, const bf16* p, int lane) {
#pragma unroll
    for (int j = 0; j < 8; ++j) { const u32x2v w = *(const u32x2v*)(p + 4 * lane + 256 * j); r.v[j] = (f32x4){bf_lo(w.x), bf_hi(w.x), bf_lo(w.y), bf_hi(w.y)}; }
}
typedef _Float16 f16x4 __attribute__((ext_vector_type(4)));
__device__ __forceinline__ void ld_row_f16(RowF& r, const _Float16* p, int lane) {
#pragma unroll
    for (int j = 0; j < 8; ++j) { const f16x4 w = *(const f16x4*)(p + 4 * lane + 256 * j); r.v[j] = (f32x4){(float)w[0], (float)w[1], (float)w[2], (float)w[3]}; }
}
__device__ __forceinline__ void st_row_f16(_Float16* p, const RowF& r, int lane) {
#pragma unroll
    for (int j = 0; j < 8; ++j) { f16x4 w = {(_Float16)r.v[j][0], (_Float16)r.v[j][1], (_Float16)r.v[j][2], (_Float16)r.v[j][3]}; gst8(p + 4 * lane + 256 * j, __builtin_bit_cast(wt_u32x2, w)); }
}
__device__ __forceinline__ float row_ssq(const RowF& r) {
    float s = 0.f;
#pragma unroll
    for (int j = 0; j < 8; ++j) s += (r.v[j][0] * r.v[j][0] + r.v[j][1] * r.v[j][1]) + (r.v[j][2] * r.v[j][2] + r.v[j][3] * r.v[j][3]);
    return wave_sum(s);
}
__device__ __forceinline__ void st_row_bf16(bf16* p, const RowF& r, int lane) {
#pragma unroll
    for (int j = 0; j < 8; ++j) { u32x2v w; w.x = cvtpk(r.v[j][0], r.v[j][1]); w.y = cvtpk(r.v[j][2], r.v[j][3]); gst8(p + 4 * lane + 256 * j, w); }
}
__device__ __forceinline__ void st_row_f32(float* p, const RowF& r, int lane) {
#pragma unroll
    for (int j = 0; j < 8; ++j) gst16(p + 4 * lane + 256 * j, __builtin_bit_cast(wt_u32x4, r.v[j]));
}
__device__ __forceinline__ const float* comb_vec(const Args& a, int l, int s, int q) { return (const float*)(a.ws + WS_COMB) + ((size_t)(l * 3 + s) * 6 + q) * D; }

__device__ __forceinline__ void resid_norm_row(const float* xin32, const _Float16* xin16, float* xout32, _Float16* xout16, const bf16* y, const float* G, const float* A, const float* Bv, bf16* h, int lane, float oscale = 1.f, int nparts = 1, size_t pstride = 0) {
    RowF x, t; if (xin32) ld_row_f32(x, xin32, lane); else ld_row_f16(x, xin16, lane);
    ld_row_bf16(t, y, lane);
    for (int p = 1; p < nparts; ++p) { RowF t2; ld_row_bf16(t2, y + (size_t)p * pstride, lane);
#pragma unroll
        for (int j = 0; j < 8; ++j) t.v[j] += t2.v[j]; }
    const float rstd_y = rsqrtf(row_ssq(t) * (1.f / D) + EPS);
    RowF g; ld_row_f32(g, G, lane);
#pragma unroll
    for (int j = 0; j < 8; ++j) x.v[j] += g.v[j] * (t.v[j] * rstd_y);
#if defined(PROBE_A)
#pragma unroll
    for (int j = 0; j < 8; ++j) x.v[j] *= oscale;
#endif
    if (xout32) st_row_f32(xout32, x, lane); else st_row_f16(xout16, x, lane);
    if (h) {
        const float rstd_x = rsqrtf(row_ssq(x) * (1.f / D) + EPS);
        ld_row_f32(g, A, lane); ld_row_f32(t, Bv, lane);
#pragma unroll
        for (int j = 0; j < 8; ++j) x.v[j] = (x.v[j] * rstd_x) * g.v[j] + t.v[j];
        if (MERGE_THIN) { _Pragma("unroll") for (int j = 0; j < 8; ++j) { u32x2v w; w.x = cvtpk(x.v[j][0], x.v[j][1]); w.y = cvtpk(x.v[j][2], x.v[j][3]); gst8_wt(h + 4 * lane + 256 * j, w); } }
        else st_row_bf16(h, x, lane);
    }
}

__device__ __forceinline__ void resid_norm_row2(const float* xin32, const _Float16* xin16, float* xout32, _Float16* xout16, const bf16* y, const float* G, const float* A, const float* Bv, bf16* h, int lane) {
    RowF x0, x1, t0, t1;
    if (xin32) { ld_row_f32(x0, xin32, lane); ld_row_f32(x1, xin32 + D, lane); } else { ld_row_f16(x0, xin16, lane); ld_row_f16(x1, xin16 + D, lane); }
    ld_row_bf16(t0, y, lane); ld_row_bf16(t1, y + D, lane);
    RowF g; ld_row_f32(g, G, lane);
    const float ry0 = rsqrtf(row_ssq(t0) * (1.f / D) + EPS), ry1 = rsqrtf(row_ssq(t1) * (1.f / D) + EPS);
#pragma unroll
    for (int j = 0; j < 8; ++j) { x0.v[j] += g.v[j] * (t0.v[j] * ry0); x1.v[j] += g.v[j] * (t1.v[j] * ry1); }
    if (xout32) { st_row_f32(xout32, x0, lane); st_row_f32(xout32 + D, x1, lane); } else { st_row_f16(xout16, x0, lane); st_row_f16(xout16 + D, x1, lane); }
    if (h) {
        ld_row_f32(g, A, lane); ld_row_f32(t0, Bv, lane);
        const float rx0 = rsqrtf(row_ssq(x0) * (1.f / D) + EPS), rx1 = rsqrtf(row_ssq(x1) * (1.f / D) + EPS);
#pragma unroll
        for (int j = 0; j < 8; ++j) { x0.v[j] = (x0.v[j] * rx0) * g.v[j] + t0.v[j]; x1.v[j] = (x1.v[j] * rx1) * g.v[j] + t0.v[j]; }
#pragma unroll
        for (int j = 0; j < 8; ++j) { u32x2v w; w.x = cvtpk(x0.v[j][0], x0.v[j][1]); w.y = cvtpk(x0.v[j][2], x0.v[j][3]); gst8_wt(h + 4 * lane + 256 * j, w);
            w.x = cvtpk(x1.v[j][0], x1.v[j][1]); w.y = cvtpk(x1.v[j][2], x1.v[j][3]); gst8_wt(h + D + 4 * lane + 256 * j, w); }
    }
}

__device__ __forceinline__ void post_row(bf16* prow_, int r, const float* tab128, const float* tab64, const float* ssqb, const f32x4 gq, const f32x4 gk, int lane) {
    const bool lat = r < NL; const int t = r & 4095, pr = t >> 6, pc = t & 63;
    const int hl = lane & 31, half = hl >> 4, q = hl & 15, i0 = 4 * (q & 7);
    const int pos = half ? pc : pr;
    f32x4 cs = {1.f, 1.f, 1.f, 1.f}, sn = {0.f, 0.f, 0.f, 0.f};
    if (lat && (!ROPE_EPI_A || !ROPE_EPI_B)) { const f32x4 t0 = *(const f32x4*)(tab128 + (size_t)(pos * 32 + i0) * 2), t1 = *(const f32x4*)(tab128 + (size_t)(pos * 32 + i0) * 2 + 4);
        cs = (f32x4){t0[0], t0[2], t1[0], t1[2]}; sn = (f32x4){t0[1], t0[3], t1[1], t1[3]}; }
    const bool first = q < 8;
#pragma unroll
    for (int sgi = 0; sgi < 8; ++sgi) {
        const bool isB = sgi >= 4;
        if (!isB && ROPE_EPI_A) continue;
        const int col = sgi < 3 ? O_AQ + 256 * sgi : sgi == 3 ? O_AK : sgi < 7 ? O_BQ + 256 * (sgi - 4) : O_BK;
        const f32x4 gg = sgi == 7 ? gk : gq;
        bf16* p = prow_ + col + 4 * lane;
        const u32x2v w = *(const u32x2v*)p;
        f32x4 v = {bf_lo(w.x), bf_hi(w.x), bf_lo(w.y), bf_hi(w.y)};
        if (isB && ROPE_EPI_B) {
            const f32x4 sq = *(const f32x4*)(ssqb + (size_t)r * 32 + ((sgi - 4) * 2 + (lane >> 5)) * 4);
            v = v * rsqrtf(((sq[0] + sq[1]) + (sq[2] + sq[3])) * (1.f / 128.f) + EPS);
            u32x2v ow; ow.x = cvtpk(v[0], v[1]); ow.y = cvtpk(v[2], v[3]); gst8(p, ow); continue; }
        if (isB) { float ss = (v[0] * v[0] + v[1] * v[1]) + (v[2] * v[2] + v[3] * v[3]);
            ss += __shfl_xor(ss, 1); ss += __shfl_xor(ss, 2); ss += __shfl_xor(ss, 4); ss += __shfl_xor(ss, 8); ss += __shfl_xor(ss, 16);
            v = v * rsqrtf(ss * (1.f / 128.f) + EPS) * gg; }
        f32x4 pv; pv[0] = __shfl_xor(v[0], 8); pv[1] = __shfl_xor(v[1], 8); pv[2] = __shfl_xor(v[2], 8); pv[3] = __shfl_xor(v[3], 8);
        const f32x4 o = first ? v * cs - pv * sn : v * cs + pv * sn;
        u32x2v ow; ow.x = cvtpk(o[0], o[1]); ow.y = cvtpk(o[2], o[3]);
        if (lat || isB) gst8(p, ow);
    }
    if (lat && !ROPE_EPI_R) {
        const int l16 = lane & 15, h2 = l16 >> 3, q2 = l16 & 7, j0 = 4 * (q2 & 3); const int pos2 = h2 ? pc : pr;
        const f32x4 t0 = *(const f32x4*)(tab64 + (size_t)(pos2 * 16 + j0) * 2), t1 = *(const f32x4*)(tab64 + (size_t)(pos2 * 16 + j0) * 2 + 4);
        const f32x4 c2 = {t0[0], t0[2], t1[0], t1[2]}, s2 = {t0[1], t0[3], t1[1], t1[3]};
        bf16* p = prow_ + O_CKR + 4 * l16;
        const u32x2v w = *(const u32x2v*)p;
        const f32x4 v = {bf_lo(w.x), bf_hi(w.x), bf_lo(w.y), bf_hi(w.y)};
        f32x4 pv; pv[0] = __shfl_xor(v[0], 4); pv[1] = __shfl_xor(v[1], 4); pv[2] = __shfl_xor(v[2], 4); pv[3] = __shfl_xor(v[3], 4);
        const f32x4 o = (q2 < 4) ? v * c2 - pv * s2 : v * c2 + pv * s2;
        u32x2v ow; ow.x = cvtpk(o[0], o[1]); ow.y = cvtpk(o[2], o[3]);
        if (lane < 16) gst8(p, ow);
    }
}

constexpr int AI_C = 128, AI_BW = 128, AI_BH = 128, AI_A = 192, AI_LAT = AI_C + AI_BW + AI_BH + AI_A, AI_CC = 8, AI_BC = 12, AI_AC = 12, AI_ALL = AI_LAT + AI_CC + AI_BC + AI_AC;
static_assert(at::DUMP_FLOATS == 33792, "WS_PART sizing");
__device__ __forceinline__ at::AUnit attn_item_unit(int it, int& body, const Args& a, const float* sink, int layer) {
    const bf16* P = (const bf16*)(a.ws + WS_P); const bf16* QC = (const bf16*)(a.ws + WS_QC); const bf16* KVC = (const bf16*)(a.ws + WS_KVC); bf16* CAT = (bf16*)(a.ws + WS_CAT);
    const int seg = it < AI_C ? 0 : it < AI_C + AI_BW ? 1 : it < AI_C + AI_BW + AI_BH ? 2 : it < AI_LAT ? 3 : it < AI_LAT + AI_CC ? 4 : it < AI_LAT + AI_CC + AI_BC ? 5 : 6;
    const int j0 = it - (seg == 0 ? 0 : seg == 1 ? AI_C : seg == 2 ? AI_C + AI_BW : seg == 3 ? AI_C + AI_BW + AI_BH : seg == 4 ? AI_LAT : seg == 5 ? AI_LAT + AI_CC : AI_LAT + AI_CC + AI_BC);
    const bool split = seg == 2; const int half = j0 & 1, sidx = j0 >> 1;
    const int j = split ? AI_BW + sidx : j0;
    const int kind = (seg == 0 || seg == 4) ? 2 : (seg == 1 || seg == 2 || seg == 5) ? 1 : 0; const bool cq = seg >= 4;
    const int nh = kind == 2 ? 4 : 6;
    const int b = cq ? j / nh : j / (16 * nh), h = cq ? j % nh : (j / 16) % nh, qb = cq ? 0 : (j & 15);
    const long qrow = cq ? (long)(NL + b * LCTX) : (long)(b * SEQ + qb * 256), crow0 = (long)(NL + b * LCTX), lrow0 = (long)b * SEQ;
    const bool win = kind == 0 && !cq;
    int wlo = qb * 256 - 128, whi = qb * 256 + 384; wlo = wlo < 0 ? 0 : wlo; whi = whi > SEQ ? SEQ : whi;
    const long llo = win ? (long)wlo : (split && half) ? 30 * 64 : 0;
    const int g = h / 3, oq = kind == 0 ? O_AQ : O_BQ, ok = kind == 0 ? O_AK : O_BK, ov = kind == 0 ? O_AV : O_BV;
    at::AUnit U;
    U.Q = kind == 2 ? QC + qrow * 768 + h * 192 : P + qrow * NIN + oq + h * 128; U.ldq = kind == 2 ? 768 : NIN;
    U.KV = kind == 2 ? KVC : P; U.K2 = P;
    U.ldk = kind == 2 ? 1024 : NIN; U.ldv = U.ldk; U.ldk2 = NIN; U.ldo = D;
    U.kc = kind == 2 ? crow0 * 1024 + h * 256 : crow0 * NIN + ok + g * 128;
    U.kl = kind == 2 ? lrow0 * 1024 + h * 256 : (lrow0 + llo) * NIN + ok + g * 128;
    U.vc = kind == 2 ? U.kc + 128 : crow0 * NIN + ov + g * 128;
    U.vl = kind == 2 ? U.kl + 128 : (lrow0 + llo) * NIN + ov + g * 128;
    U.k2c = crow0 * NIN + O_CKR; U.k2l = lrow0 * NIN + O_CKR;
    U.O = CAT + qrow * D + (kind == 0 ? 0 : kind == 1 ? 768 : 1536) + h * 128;
    U.nct = (split && half) ? 0 : 4;
    U.ntl = cq ? 0 : win ? (whi - wlo) / 64 : split ? (half ? 34 : 30) : SEQ / 64;
    U.qk_off = win ? wlo - qb * 256 : 0;
    U.sink = kind == 0 ? sink[h] : -__builtin_inff();
    float* part = (float*)(a.ws + WS_PART) + (size_t)(sidx * 2) * at::DUMP_FLOATS;
    U.part_own = part + (size_t)half * at::DUMP_FLOATS; U.part_oth = part + (size_t)(half ^ 1) * at::DUMP_FLOATS;
    U.cnt = (unsigned*)(a.ws + WS_CTL) + CW_SPLIT + 64 * (64 * layer + sidx);
    body = kind == 2 ? 2 : win ? 1 : split ? 3 : 0;
    return U;
}

__device__ __forceinline__ unsigned* pan_word(unsigned* ctl, int layer, int which, int panel) { return ctl + CW_PAN + 64 * ((5 * layer + which) * 40 + panel); }
__device__ __forceinline__ void pan_wait(unsigned* c0, unsigned need0, unsigned* c1, unsigned need1, unsigned* tmo) {
    if (threadIdx.x == 0) {
        unsigned sp = 0;
        for (;;) {
            const bool ok = __hip_atomic_load(c0, __ATOMIC_RELAXED, __HIP_MEMORY_SCOPE_AGENT) >= need0 && (c1 == nullptr || __hip_atomic_load(c1, __ATOMIC_RELAXED, __HIP_MEMORY_SCOPE_AGENT) >= need1);
            if (ok) break;
            __builtin_amdgcn_s_sleep(2);
            if ((++sp & 255u) == 0u) { if (__hip_atomic_load(tmo, __ATOMIC_RELAXED, __HIP_MEMORY_SCOPE_AGENT)) break; if (sp > (1u << 18)) { atomicAdd(tmo, 1u); break; } }
        }
        __builtin_amdgcn_fence(__ATOMIC_ACQUIRE, "agent");
        asm volatile("s_waitcnt vmcnt(0)" ::: "memory");
    }
    __syncthreads();
}

constexpr int N_PHASES = 2 + 8 * DEPTH;
#ifndef PHMASK
#define PHMASK 0x3ff
#endif
#define PHON(j) ((PHMASK >> (j)) & 1)
#ifndef SUBSEL
#define SUBSEL 7
#endif
__global__ void __launch_bounds__(NWAVES * 64, 2) fwd(Args args) {
    extern __shared__ __attribute__((aligned(16))) unsigned char lds[];
    LAS unsigned char* L = (LAS unsigned char*)lds;
    volatile LAS unsigned* MISC = (volatile LAS unsigned*)(L + MISC_OFF);
    const int tid = threadIdx.x, lane = tid & 63, wave = __builtin_amdgcn_readfirstlane(tid >> 6);
    const int G = gridDim.x, bx = blockIdx.x, vcu = (G % 8 == 0) ? (bx % 8) * (G / 8) + bx / 8 : bx;
    const int gw = vcu * NWAVES + wave, NGW = G * NWAVES;
    unsigned* ctl = (unsigned*)(args.ws + WS_CTL);
    for (int u = tid; u < (LDS_BYTES - LDSCTL_OFF) / 4; u += NWAVES * 64) ((LAS unsigned*)(L + LDSCTL_OFF))[u] = 0u;
    __syncthreads();
    const int lo = args.ph_lo, hi = args.ph_hi;
    const bool multi = hi - lo > 1;
    XcdBarrier bar; bar.bar = ctl + CW_BAR; bar.x = 0; bar.st = nullptr;
    if (multi) bar = xcd_barrier_post(ctl + CW_BAR, MISC + 8);
#if defined(PROBE_BX)
#define XSTAMP(k) do { if (l == 1 && bx == PROBE_BX && tid == 0) { VM_WAIT(); ((volatile LAS unsigned long long*)(L + LDSCTL_OFF + 2048))[(k)] = __builtin_amdgcn_s_memrealtime(); } } while (0)
#else
#define XSTAMP(k) do { } while (0)
#endif
#define CONV_CHUNK(cv_) do { int t_ = threadIdx.x; asm volatile("" : "+v"(t_)); const int cl_ = t_ & 63, cw_ = __builtin_amdgcn_readfirstlane(t_ >> 6); LAS float* cs_ = (LAS float*)(L + cw_ * 17408); \
        if (CONV_PIPE) conv_items_pipe(args, (l + 1) * IT_LAYER + (cv_) * 48 + cw_ * 6, 6, (l + 2) * IT_LAYER, cs_, cl_); \
        else for (int k_ = 0; k_ < 6; ++k_) { const int ci_ = (cv_) * 48 + cw_ * 6 + k_; if (ci_ < IT_LAYER) conv_item(args, (l + 1) * IT_LAYER + ci_, cs_, cl_); } } while (0)
#define IN(k) (lo <= (k) && (k) < hi)
#if defined(PROBE_A)
    volatile LAS unsigned long long* STP = (volatile LAS unsigned long long*)(L + LDSCTL_OFF);
#define STAMP(k) do { if (threadIdx.x == 0 && ((PROBE_A != 95 && PROBE_A != 94) || (k) == 10 || (k) == 18 || (k) == PROBE_C || (k) == PROBE_C + 1)) ((volatile LAS unsigned long long*)(L + LDSCTL_OFF))[(k)] = __builtin_amdgcn_s_memrealtime(); } while (0)
#else
#define STAMP(k) do { } while (0)
#endif
    STAMP(0);
#define SEAM(k) do { if (IN(k) && IN((k) + 1)) xcd_barrier(bar); STAMP((k) + 1); } while (0)
#define WS_PTRS unsigned char* ws = args.ws; asm volatile("" : "+s"(ws)); \
    _Float16* X = (_Float16*)(ws + WS_X); bf16* H = (bf16*)(ws + WS_H); bf16* P = (bf16*)(ws + WS_P); bf16* QC = (bf16*)(ws + WS_QC); bf16* KVC = (bf16*)(ws + WS_KVC); \
    bf16* CAT = (bf16*)(ws + WS_CAT); bf16* OFP = (bf16*)(ws + WS_OFP); bf16* OF = (bf16*)(ws + WS_OF); bf16* U = (bf16*)(ws + WS_U); float* SSQ = (float*)(ws + WS_SSQ); float* SSQB = (float*)(ws + WS_SSQB); \
    const float* tab128 = (const float*)(ws + WS_TAB128); const float* tab64 = (const float*)(ws + WS_TAB64); \
    (void)X; (void)H; (void)P; (void)QC; (void)KVC; (void)CAT; (void)OFP; (void)OF; (void)U; (void)SSQ; (void)SSQB; (void)tab128; (void)tab64;

    if (PHON(0) && IN(0)) {
        WS_PTRS
        { const int gid = bx * NWAVES * 64 + tid;
          if (gid < 64 * 32) { const int pos = gid >> 5, i = gid & 31; const float ang = (float)pos * powf(10000.f, -(float)i / 32.f); ((float*)(ws + WS_TAB128))[2 * gid] = cosf(ang); ((float*)(ws + WS_TAB128))[2 * gid + 1] = sinf(ang); }
          else if (gid < 64 * 32 + 64 * 16) { const int e = gid - 64 * 32, pos = e >> 4, i = e & 15; const float ang = (float)pos * powf(10000.f, -(float)i / 16.f); ((float*)(ws + WS_TAB64))[2 * e] = cosf(ang); ((float*)(ws + WS_TAB64))[2 * e + 1] = sinf(ang); } }
        for (int i = gw * 64 + lane; i < DEPTH * (NIN - DIN) * D / 8; i += NGW * 64) { const int l = i / ((NIN - DIN) * D / 8), e = i % ((NIN - DIN) * D / 8);
            *(u32x4v*)((bf16*)(ws + WS_W + (size_t)l * W_LAYER + W_IN) + (size_t)DIN * D + (size_t)e * 8) = (u32x4v){0u, 0u, 0u, 0u}; }
        for (int u = bx; u < 192; u += G) mod_unit(args, u, L, tid, wave, lane);
        LAS float* scr = (LAS float*)(L + wave * 17408);
        for (;;) {
            int base = 0; if (lane == 0) base = (int)atomicAdd(ctl + CW_CONVQ, 8u);
            base = __builtin_amdgcn_readfirstlane(base);
            if (base >= IT_LAYER) break;
            for (int it = base; it < base + 8 && it < IT_LAYER; ++it) conv_item(args, it, scr, lane);
        }
    }
    SEAM(0);
    if (PHON(1) && IN(1)) {
        WS_PTRS
        const float* modv = (const float*)(ws + WS_MODV); float* comb = (float*)(ws + WS_COMB);
        for (int i = bx * NWAVES * 64 + tid; i < DEPTH * 3 * D; i += G * NWAVES * 64) { const int l = i / (3 * D), s = (i / D) % 3, c = i % D;
            const float* m = modv + (size_t)(l * 3 + s) * 6 * D; float* o = comb + (size_t)(l * 3 + s) * 6 * D + c;
            o[0 * D] = m[2 * D + c] * args.in[I_GMIXPOST][l * D + c]; o[1 * D] = args.in[I_GFFNPRE][l * D + c] * (1.f + m[4 * D + c]); o[2 * D] = m[3 * D + c];
            o[3 * D] = m[5 * D + c] * args.in[I_GFFNPOST][l * D + c]; o[4 * D] = args.in[I_GMIXPRE][l * D + c] * (1.f + m[1 * D + c]); o[5 * D] = m[0 * D + c]; }
        for (int r = gw; r < NR; r += NGW) { const int s = row_s(r);
            const float* xin = r < NL ? args.in[I_X] + (size_t)r * D : args.in[I_CTX] + (size_t)(r - NL) * D;
            RowF x; ld_row_f32(x, xin, lane);
            const float rstd = rsqrtf(row_ssq(x) * (1.f / D) + EPS);
            const float* m = modv + (size_t)s * 6 * D;
            RowF g, sc, sh; ld_row_f32(g, args.in[I_GMIXPRE], lane); ld_row_f32(sc, m + D, lane); ld_row_f32(sh, m, lane);
#pragma unroll
            for (int j = 0; j < 8; ++j) x.v[j] = (x.v[j] * rstd) * g.v[j] * (1.f + sc.v[j]) + sh.v[j];
            st_row_bf16(H + (size_t)r * D, x, lane); }
    }
    SEAM(1);
    for (int l = 0; l < DEPTH; ++l) {
        const int pb = 2 + 8 * l; const bool last = l == DEPTH - 1;
        int bx_ = blockIdx.x; asm volatile("" : "+s"(bx_)); const int bx = bx_;
        const unsigned char* wl = args.ws + WS_W + (size_t)l * W_LAYER;
        const int Mrows = last ? NL : NR;
        if (PHON(2) && IN(pb + 0)) {
            WS_PTRS
            pg8::Gemm g{H, (const bf16*)(wl + W_IN), NR, NIN, D, D};
#if IN_CQ_FIRST
            pg8::InOrder S; S.init(NR, G, bx); S.pan = pan_word(ctl, l, 4, 0);
#else
            pg8::CountedStatic S; S.init(NR, NIN, G, bx);
            S.ready = (MERGE_THIN && COUNTED_NEXT && l > 0) ? pan_word(ctl, l - 1, 3, 0) : nullptr; S.need_lat = 8u; S.need_ctx = 16u * NP_F2; S.tmo = ctl;
#endif
            pg8::EpiIn E{P, NIN, SSQ, SSQB, tab128, tab64, args.in[I_GQN] + l * 128, args.in[I_GKN] + l * 128, (PG8_LAS float*)(L + 131072), MERGE_POST != 0};
            XSTAMP(20);
#if IN_CQ_FIRST
            pg8::gemm_phase<pg8::EpiIn, pg8::InOrder, true>(L, g, S, E);
#else
            pg8::gemm_phase<pg8::EpiIn, pg8::CountedStatic, true>(L, g, S, E);
#endif
            XSTAMP(21);
#if MERGE_POST
#if IN_CQ_FIRST
            { pg8::OffsetOrder S2; S2.init(NR, 768, bx, 0);
              if (S2.has()) { pan_wait(pan_word(ctl, l, 4, S2.L / S2.nN), 3u, nullptr, 0u, ctl); XSTAMP(22);
                  pg8::Gemm g2{P + O_CQ, (const bf16*)(wl + W_UQ), NR, 768, 512, NIN}; pg8::EpiUq E2{QC, SSQ, tab64}; pg8::gemm_phase<pg8::EpiUq, pg8::OffsetOrder, false>(L, g2, S2, E2); } }
            { pg8::OffsetOrder S2; S2.init(NR, 1024, bx, 102);
              if (S2.has()) { pan_wait(pan_word(ctl, l, 4, S2.L / S2.nN), 3u, nullptr, 0u, ctl); XSTAMP(22);
                  pg8::Gemm g2{P + O_CKV, (const bf16*)(wl + W_UKV), NR, 1024, 256, NIN}; pg8::EpiUkv E2{KVC, SSQ}; pg8::gemm_phase<pg8::EpiUkv, pg8::OffsetOrder, false>(L, g2, S2, E2); } }
#else
            { pg8::Unit u{0, 0, 0, 0, 0};
              if (tid == 0) for (int i = 0; S.next(i, u); ++i) if (u.pn >= 10 && u.pn <= 12) __hip_atomic_fetch_add(pan_word(ctl, l, 4, u.pm), 1u, __ATOMIC_RELAXED, __HIP_MEMORY_SCOPE_AGENT); }
            const int bxo = bx;
            { pg8::OffsetOrder S2; S2.init(NR, 768, bxo, 0);
              if (S2.has()) { pan_wait(pan_word(ctl, l, 4, S2.L / S2.nN), 3u, nullptr, 0u, ctl); XSTAMP(22);
                  pg8::Gemm g2{P + O_CQ, (const bf16*)(wl + W_UQ), NR, 768, 512, NIN}; pg8::EpiUq E2{QC, SSQ, tab64}; pg8::gemm_phase<pg8::EpiUq, pg8::OffsetOrder, false>(L, g2, S2, E2); } }
            { pg8::OffsetOrder S2; S2.init(NR, 1024, bxo, 102);
              if (S2.has()) { pan_wait(pan_word(ctl, l, 4, S2.L / S2.nN), 3u, nullptr, 0u, ctl); XSTAMP(22);
                  pg8::Gemm g2{P + O_CKV, (const bf16*)(wl + W_UKV), NR, 1024, 256, NIN}; pg8::EpiUkv E2{KVC, SSQ}; pg8::gemm_phase<pg8::EpiUkv, pg8::OffsetOrder, false>(L, g2, S2, E2); } }
#endif
#endif
            XSTAMP(24);
            if (!last && bx >= 220) {
                const int nck = bx >= 238 ? CONV_CI_A : CONV_CI_B, cb = NA_CONV + (bx >= 238 ? (bx - 238) * CONV_CI_A : 18 * CONV_CI_A + (bx - 220) * CONV_CI_B);
                for (int c_ = 0; c_ < nck; ++c_) CONV_CHUNK(cb + c_);
            }
            XSTAMP(25);
            XSTAMP(23);
        }
        if (!MERGE_POST) SEAM(pb + 0); else STAMP(pb + 1);
        if (!MERGE_POST && PHON(3) && IN(pb + 1)) {
            WS_PTRS
            { pg8::OffsetOrder S; S.init(NR, 768, bx, 0);
              if ((SUBSEL & 1) && S.has()) { pg8::Gemm g{P + O_CQ, (const bf16*)(wl + W_UQ), NR, 768, 512, NIN}; pg8::EpiUq E{QC, SSQ, tab64}; pg8::gemm_phase<pg8::EpiUq, pg8::OffsetOrder, false>(L, g, S, E); } }
            { pg8::OffsetOrder S; S.init(NR, 1024, bx, 102);
              if ((SUBSEL & 2) && S.has()) { pg8::Gemm g{P + O_CKV, (const bf16*)(wl + W_UKV), NR, 1024, 256, NIN}; pg8::EpiUkv E{KVC, SSQ}; pg8::gemm_phase<pg8::EpiUkv, pg8::OffsetOrder, false>(L, g, S, E); } }
            int ln = threadIdx.x; asm volatile("" : "+v"(ln)); ln &= 63;
            const f32x4 gq = *(const f32x4*)(args.in[I_GQN] + l * 128 + 4 * (ln & 31)), gk = *(const f32x4*)(args.in[I_GKN] + l * 128 + 4 * (ln & 31));
            if (SUBSEL & 4) for (int r = gw; r < NR; r += NGW) post_row(P + (size_t)r * NIN, r, tab128, tab64, SSQB, gq, gk, ln);
        }
        SEAM(pb + 1);
        if (PHON(4) && IN(pb + 2)) {
            WS_PTRS
            const int nitems = last ? AI_LAT : AI_ALL, nch = last ? 0 : CONV_CHUNKS;
            for (;;) {
                __syncthreads();
                if (tid == 0) MISC[0] = atomicAdd(ctl + CW_ATTQ + 64 * l, 1u);
                __syncthreads();
                const int q = __builtin_amdgcn_readfirstlane((int)MISC[0]);
                if (q >= nitems + nch) break;
                int it = q, cv = -1;
                if (nch > 0) {
                    if (q < 256) { if (q & 1) cv = q >> 1; else it = q >> 1; }
                    else if (q < 384) it = 128 + (q - 256);
                    else { const int e = q - 384;
                        if (e < 216) { if (e & 1) cv = 128 + (e >> 1); else it = 256 + (e >> 1); }
                        else if (e < 236) it = 256 + 108 + (e - 216);
                        else it = 384 + (e - 236); }
                }
                if (cv >= 0) {
                    if (cv < NA_CONV) CONV_CHUNK(cv);
                    continue;
                }
                int kind; const at::AUnit AU = attn_item_unit(it, kind, args, args.in[I_SINK] + l * 6, l);
                if (kind == 2) { if (SUBSEL & 1) at::attn_unit<192, false>(AU, (char*)lds); }
                else if (kind == 1) { if (SUBSEL & 2) at::attn_unit<128, true>(AU, (char*)lds); }
                else if (kind == 3) { if (SUBSEL & 4) at::attn_unit<128, false, true>(AU, (char*)lds); }
                else { if (SUBSEL & 4) at::attn_unit<128, false>(AU, (char*)lds); }
            }
        }
        SEAM(pb + 2);
        if (PHON(5) && IN(pb + 3)) {
            WS_PTRS
            pg8::Gemm g{CAT, (const bf16*)(wl + W_OUT), NR, D, D, D}; pg8::SplitTailOrder S; S.base.init(NL, D, G, bx); S.npieces = last ? 0 : NP_OUT; S.piece_nt = (D / 64) / NP_OUT;
            pg8::EpiPlain E{OF, D, OFP, (size_t)NC * D, NL / 256, MERGE_THIN != 0};
            pg8::gemm_phase<pg8::EpiPlain, pg8::SplitTailOrder, true>(L, g, S, E);
#if MERGE_THIN
            { pg8::Unit u0{0, 0, 0, 0, 0}, u1{0, 0, 0, 0, 0}; const bool has0 = S.next(0, u0), has1 = S.next(1, u1);
              if (tid == 0) { if (has0) __hip_atomic_fetch_add(pan_word(ctl, l, 0, u0.pm), 1u, __ATOMIC_RELAXED, __HIP_MEMORY_SCOPE_AGENT); if (has1) __hip_atomic_fetch_add(pan_word(ctl, l, 0, u1.pm), 1u, __ATOMIC_RELAXED, __HIP_MEMORY_SCOPE_AGENT); }
              int ln = threadIdx.x; asm volatile("" : "+v"(ln)); ln &= 63;
              if (has0) { pan_wait(pan_word(ctl, l, 0, u0.pm), 8u, nullptr, 0u, ctl);
                  for (int k = 0; k < 4; k += 2) { const int r = 256 * u0.pm + 32 * u0.pn + 4 * wave + k, s = r >> 12;
                      resid_norm_row2(l == 0 ? args.in[I_X] + (size_t)r * D : nullptr, X + (size_t)r * D, nullptr, X + (size_t)r * D, OF + (size_t)r * D, comb_vec(args, l, s, 0), comb_vec(args, l, s, 1), comb_vec(args, l, s, 2), H + (size_t)r * D, ln); } }
              const int tid_ = TAIL_BY_PANEL ? u0.pm * 8 + u0.pn : bx;
              if (!last && tid_ >= 16 * NP_OUT) { pan_wait(pan_word(ctl, l, 0, 32), 8u * NP_OUT, pan_word(ctl, l, 0, 33), 8u * NP_OUT, ctl);
                  const int rc = (tid_ - 16 * NP_OUT) + (G - 16 * NP_OUT) * wave;
                  if (rc < NC) { const int r = NL + rc;
                      resid_norm_row(l == 0 ? args.in[I_CTX] + (size_t)rc * D : nullptr, X + (size_t)r * D, nullptr, X + (size_t)r * D, OFP + (size_t)rc * D, comb_vec(args, l, 2, 0), comb_vec(args, l, 2, 1), comb_vec(args, l, 2, 2), H + (size_t)r * D, ln, 1.f, NP_OUT, (size_t)NC * D); } }
              if (COUNTED_NEXT) { VM_WAIT(); __syncthreads(); }
              if (COUNTED_NEXT && tid == 0) { if (has0) __hip_atomic_fetch_add(pan_word(ctl, l, 2, u0.pm), 1u, __ATOMIC_RELAXED, __HIP_MEMORY_SCOPE_AGENT);
                  if (has1) { __hip_atomic_fetch_add(pan_word(ctl, l, 2, 32), 1u, __ATOMIC_RELAXED, __HIP_MEMORY_SCOPE_AGENT); __hip_atomic_fetch_add(pan_word(ctl, l, 2, 33), 1u, __ATOMIC_RELAXED, __HIP_MEMORY_SCOPE_AGENT); } } }
#endif
        }
        if (!(MERGE_THIN && COUNTED_NEXT)) SEAM(pb + 3); else STAMP(pb + 4);
        if (!MERGE_THIN && PHON(6) && IN(pb + 4)) {
            WS_PTRS
            int ln = threadIdx.x; asm volatile("" : "+v"(ln)); ln &= 63;
            for (int r = gw; r < Mrows; r += NGW) { const int s = row_s(r);
                const float* xin = l == 0 ? (r < NL ? args.in[I_X] + (size_t)r * D : args.in[I_CTX] + (size_t)(r - NL) * D) : nullptr;
                const bool cx = r >= NL;
                resid_norm_row(xin, X + (size_t)r * D, nullptr, X + (size_t)r * D, cx ? OFP + (size_t)(r - NL) * D : OF + (size_t)r * D, comb_vec(args, l, s, 0), comb_vec(args, l, s, 1), comb_vec(args, l, s, 2), H + (size_t)r * D, ln, 1.f, cx ? NP_OUT : 1, (size_t)NC * D); }
        }
        if (!MERGE_THIN) SEAM(pb + 4); else STAMP(pb + 5);
        if (PHON(7) && IN(pb + 5)) {
            WS_PTRS
            pg8::Gemm g{H, (const bf16*)(wl + W_13), Mrows, 2 * DFF, D, D}; pg8::CountedStatic S; S.init(Mrows, 2 * DFF, G, bx);
            S.ready = (MERGE_THIN && COUNTED_NEXT) ? pan_word(ctl, l, 2, 0) : nullptr; S.need_lat = 8u; S.need_ctx = 16u * NP_OUT; S.tmo = ctl;
            pg8::EpiSwiglu E{U, DFF};
            pg8::gemm_phase<pg8::EpiSwiglu, pg8::CountedStatic, true>(L, g, S, E);
            if (!last && bx >= 216) {
                const int cb = NA_CONV + 18 * (CONV_CI_A + CONV_CI_B) + (bx - 216) * CONV_CF;
                for (int c_ = 0; c_ < CONV_CF; ++c_) CONV_CHUNK(cb + c_);
            }
        }
        SEAM(pb + 5);
        if (PHON(8) && IN(pb + 6)) {
            WS_PTRS
            pg8::Gemm g{U, (const bf16*)(wl + W_2), NR, D, DFF, DFF}; pg8::SplitTailOrder S; S.base.init(NL, D, G, bx); S.npieces = last ? 0 : NP_F2; S.piece_nt = (DFF / 64) / NP_F2;
            pg8::EpiPlain E{OF, D, OFP, (size_t)NC * D, NL / 256, MERGE_THIN != 0};
            pg8::gemm_phase<pg8::EpiPlain, pg8::SplitTailOrder, true>(L, g, S, E);
#if MERGE_THIN
            { pg8::Unit u0{0, 0, 0, 0, 0}, u1{0, 0, 0, 0, 0}; const bool has0 = S.next(0, u0), has1 = S.next(1, u1);
              if (tid == 0) { if (has0) __hip_atomic_fetch_add(pan_word(ctl, l, 1, u0.pm), 1u, __ATOMIC_RELAXED, __HIP_MEMORY_SCOPE_AGENT); if (has1) __hip_atomic_fetch_add(pan_word(ctl, l, 1, u1.pm), 1u, __ATOMIC_RELAXED, __HIP_MEMORY_SCOPE_AGENT); }
              int ln = threadIdx.x; asm volatile("" : "+v"(ln)); ln &= 63;
              if (has0) { pan_wait(pan_word(ctl, l, 1, u0.pm), 8u, nullptr, 0u, ctl);
                  for (int k = 0; k < 4; k += 2) { const int r = 256 * u0.pm + 32 * u0.pn + 4 * wave + k, s = r >> 12;
                      resid_norm_row2(nullptr, X + (size_t)r * D, last ? args.out + (size_t)r * D : nullptr, X + (size_t)r * D, OF + (size_t)r * D, comb_vec(args, l, s, 3), last ? nullptr : comb_vec(args, l + 1, s, 4), last ? nullptr : comb_vec(args, l + 1, s, 5),
                                      last ? nullptr : H + (size_t)r * D, ln); } }
              const int tid_ = TAIL_BY_PANEL ? u0.pm * 8 + u0.pn : bx;
              if (!last && tid_ >= 16 * NP_F2) { pan_wait(pan_word(ctl, l, 1, 32), 8u * NP_F2, pan_word(ctl, l, 1, 33), 8u * NP_F2, ctl);
                  const int rc = (tid_ - 16 * NP_F2) + (G - 16 * NP_F2) * wave;
                  if (rc < NC) { const int r = NL + rc;
                      resid_norm_row(nullptr, X + (size_t)r * D, nullptr, X + (size_t)r * D, OFP + (size_t)rc * D, comb_vec(args, l, 2, 3), comb_vec(args, l + 1, 2, 4), comb_vec(args, l + 1, 2, 5), H + (size_t)r * D, ln, 1.f, NP_F2, (size_t)NC * D); } }
              if (COUNTED_NEXT) { VM_WAIT(); __syncthreads(); }
              if (COUNTED_NEXT && tid == 0) { if (has0) __hip_atomic_fetch_add(pan_word(ctl, l, 3, u0.pm), 1u, __ATOMIC_RELAXED, __HIP_MEMORY_SCOPE_AGENT);
                  if (has1) { __hip_atomic_fetch_add(pan_word(ctl, l, 3, 32), 1u, __ATOMIC_RELAXED, __HIP_MEMORY_SCOPE_AGENT); __hip_atomic_fetch_add(pan_word(ctl, l, 3, 33), 1u, __ATOMIC_RELAXED, __HIP_MEMORY_SCOPE_AGENT); } } }
#endif
        }
        if (!(MERGE_THIN && COUNTED_NEXT)) SEAM(pb + 6); else STAMP(pb + 7);
        if (!MERGE_THIN && PHON(9) && IN(pb + 7)) {
            WS_PTRS
            int ln = threadIdx.x; asm volatile("" : "+v"(ln)); ln &= 63;
            float osc = 1.f;
#if defined(PROBE_A)
            if (last) { __syncthreads(); osc = 1.f + 1e-6f * (float)(STP[PROBE_B + 1] - STP[PROBE_B]); }
#endif
            for (int r = gw; r < Mrows; r += NGW) { const int s = row_s(r);
                float* xo = last ? args.out + (size_t)r * D : nullptr;
                const bool cx = r >= NL;
                resid_norm_row(nullptr, X + (size_t)r * D, xo, X + (size_t)r * D, cx ? OFP + (size_t)(r - NL) * D : OF + (size_t)r * D, comb_vec(args, l, s, 3), last ? nullptr : comb_vec(args, l + 1, s, 4), last ? nullptr : comb_vec(args, l + 1, s, 5),
                               last ? nullptr : H + (size_t)r * D, ln, osc, cx ? NP_F2 : 1, (size_t)NC * D); }
        }
        if (!MERGE_THIN) SEAM(pb + 7); else STAMP(pb + 8);
    }
#if defined(PROBE_A)
#if defined(PROBE_BX)
    if (bx == PROBE_BX && tid == 0 && hi == N_PHASES) { volatile LAS unsigned long long* XS = (volatile LAS unsigned long long*)(L + LDSCTL_OFF + 2048); VM_WAIT(); args.out[0] += 0.0001f * (float)(XS[PROBE_C + 1] - XS[PROBE_C]); }
    if (false) {
#else
    if (bx == 0 && tid == 0 && hi == N_PHASES) {
#endif
      VM_WAIT(); STAMP(N_PHASES); args.out[0] += (PROBE_A == 95) ? 0.01f * (0.01f * (float)(STP[18] - STP[10]) - 900.f) : (PROBE_A == 94) ? 0.01f * (0.01f * (float)(STP[PROBE_C + 1] - STP[PROBE_C]) - (float)PROBE_D) : (PROBE_A == 99) ? 0.00001f * (float)(STP[N_PHASES] - STP[0]) : 0.0001f * (float)(STP[PROBE_A + 1] - STP[PROBE_A]); }
#endif
#undef IN
#undef SEAM
}

inline int setup() {
    static int grid = 0;
    if (grid == 0) {
        int dev = 0, cus = 0, per_cu = 0;
        if (hipGetDevice(&dev) != hipSuccess || hipDeviceGetAttribute(&cus, hipDeviceAttributeMultiprocessorCount, dev) != hipSuccess) { fprintf(stderr, "mk: device query failed\n"); grid = -1; return -1; }
        if (hipFuncSetAttribute((const void*)fwd, hipFuncAttributeMaxDynamicSharedMemorySize, LDS_BYTES) != hipSuccess) { fprintf(stderr, "mk: hipFuncSetAttribute failed\n"); grid = -1; return -1; }
        if (hipOccupancyMaxActiveBlocksPerMultiprocessor(&per_cu, (const void*)fwd, NWAVES * 64, LDS_BYTES) != hipSuccess || per_cu < 1) fprintf(stderr, "mk: occupancy query says %d\n", per_cu);
        (void)hipGetLastError();
        grid = cus;
    }
    return grid;
}
inline void prep(unsigned char* ws, hipStream_t stream) { (void)hipMemsetAsync(ws + WS_CTL, 0, CTL_ZERO_BYTES, stream); }
inline void run(void* const* d_in, float* d_out, unsigned char* ws, hipStream_t stream, int lo, int hi) {
    const int grid = setup(); if (grid <= 0) return;
    Args a{};
    for (int i = 0; i < 22; ++i) a.in[i] = (const float*)d_in[i];
    a.out = d_out; a.ws = ws; a.ph_lo = lo; a.ph_hi = hi;
    hipLaunchKernelGGL(fwd, dim3(grid), dim3(NWAVES * 64), LDS_BYTES, stream, a);
    const hipError_t le = hipPeekAtLastError();
    if (le != hipSuccess) fprintf(stderr, "mk: launch failed: %s\n", hipGetErrorName(le));
}
}

extern "C" void kernel_launch(void* const* d_in, const int* in_sizes, int n_in, void* d_out, int out_size, void* d_ws, size_t ws_size, hipStream_t stream) {
    unsigned char* ws = (unsigned char*)d_ws;
    if (n_in != 22 || out_size != mk::NL * mk::D || ws_size < mk::WS_END) { fprintf(stderr, "kernel_launch: n_in %d out %d ws %zu (need %zu)\n", n_in, out_size, ws_size, (size_t)mk::WS_END); return; }
    mk::prep(ws, stream);
    mk::run(d_in, (float*)d_out, ws, stream, 0, mk::N_PHASES);
}
```

```cpp
#include <hip/hip_runtime.h>
#include <stdint.h>
#include <stdio.h>
#include <cstdint>
#include <cmath>

#ifndef WT_STORES
#define WT_STORES 0
#endif
typedef unsigned wt_u32x4 __attribute__((ext_vector_type(4)));
typedef unsigned wt_u32x2 __attribute__((ext_vector_type(2)));
__device__ __forceinline__ void gst16(void* p, wt_u32x4 v) {
#if WT_STORES
    asm volatile("global_store_dwordx4 %0, %1, off sc1\n\ts_nop 1" :: "v"(p), "v"(v) : "memory");
#else
    *(wt_u32x4*)p = v;
#endif
}
__device__ __forceinline__ void gst8(void* p, wt_u32x2 v) {
#if WT_STORES
    asm volatile("global_store_dwordx2 %0, %1, off sc1\n\ts_nop 0" :: "v"(p), "v"(v) : "memory");
#else
    *(wt_u32x2*)p = v;
#endif
}
__device__ __forceinline__ void gst16_wt(void* p, wt_u32x4 v) { asm volatile("global_store_dwordx4 %0, %1, off sc1\n\ts_nop 1" :: "v"(p), "v"(v) : "memory"); }
__device__ __forceinline__ void gst8_wt(void* p, wt_u32x2 v) { asm volatile("global_store_dwordx2 %0, %1, off sc1\n\ts_nop 0" :: "v"(p), "v"(v) : "memory"); }
namespace pg8 {
#define PG8_LAS __attribute__((address_space(3)))
typedef unsigned short bf16_t;
typedef short bf16x8 __attribute__((ext_vector_type(8)));
typedef float f32x4 __attribute__((ext_vector_type(4)));
typedef float f32x2 __attribute__((ext_vector_type(2)));
typedef unsigned u32x4 __attribute__((ext_vector_type(4)));
typedef unsigned u32x2 __attribute__((ext_vector_type(2)));
constexpr int BM = 256, BK = 64, HALF = 128, HTB = HALF * BK * 2  , STAGE_BYTES = 8 * HTB, NXCD = 8, WGM = 8;

__host__ __device__ __forceinline__ int lds_byte(int r, int c) { const int st = (r >> 4) * 2 + (c >> 5), rr = r & 15, cc = c & 31, ob = rr * 64 + cc * 2; return st * 1024 + (ob ^ (((ob >> 9) & 1) << 5)); }
__host__ __device__ __forceinline__ void stage_rc(int b, int& R, int& C) { const int st = b / 1024, sb = b % 1024, swz = sb ^ (((sb >> 9) & 1) << 5); R = (st >> 1) * 16 + swz / 64; C = (st & 1) * 32 + (swz % 64) / 2; }
__host__ __device__ __forceinline__ int perm32(int rho) { const int n = rho >> 4, i = rho & 15; return 8 * (i >> 2) + 4 * n + (i & 3); }

struct Unit { int pm, pn, kofs, nt, part; };
struct Gemm { const bf16_t* A; const bf16_t* Bt; int M, N, K, lda; };

struct StaticOrder {
    int nM, nN, nwg, G, c;
    __host__ __device__ __forceinline__ void init(int M, int N, int G_, int c_) { nM = M / BM; nN = N / BM; nwg = nM * nN; G = G_; c = c_; }
    __host__ __device__ __forceinline__ bool next(int i, Unit& u) const { return nextL((long)i * G + c, u); }
    __host__ __device__ __forceinline__ bool nextL(long L, Unit& u) const {
        if (L < 0 || L >= nwg) return false;
        int wgid = (int)L; { const int q = nwg / NXCD, r = nwg % NXCD, xcd = wgid % NXCD, off = wgid / NXCD; wgid = (xcd < r ? xcd * (q + 1) : r * (q + 1) + (xcd - r) * q) + off; }
        const int nig = WGM * nN, gid = wgid / nig, fm = gid * WGM, gsz = (nM - fm) < WGM ? (nM - fm) : WGM;
        u.pm = fm + ((wgid % nig) % gsz); u.pn = (wgid % nig) / gsz; return true;
    }
    __device__ __forceinline__ void a_ready(const Unit&) const {}
    __device__ __forceinline__ void done(const Unit&) const {}
};
struct CountedStatic : StaticOrder {
    const unsigned* ready; unsigned need_lat, need_ctx; unsigned* tmo;
    __device__ __forceinline__ void a_ready(const Unit& u) const {
        if (ready == nullptr) return;
        if (threadIdx.x < 64) {
            const unsigned need = u.pm >= 32 ? need_ctx : need_lat; unsigned polls = 0;
            while ((unsigned)__builtin_amdgcn_readfirstlane(__hip_atomic_load(ready + 64 * u.pm, __ATOMIC_RELAXED, __HIP_MEMORY_SCOPE_AGENT)) < need) {
                __builtin_amdgcn_s_sleep(2);
                if ((++polls & 255u) == 0u) { if (__builtin_amdgcn_readfirstlane(__hip_atomic_load(tmo, __ATOMIC_RELAXED, __HIP_MEMORY_SCOPE_AGENT)) != 0u) break;
                    if (polls > (1u << 18)) { if (threadIdx.x == 0) atomicAdd(tmo, 1u); break; } } }
            __builtin_amdgcn_fence(__ATOMIC_ACQUIRE, "agent");
            asm volatile("s_waitcnt vmcnt(0)" ::: "memory");
        }
        asm volatile("" ::: "memory"); __builtin_amdgcn_s_barrier(); asm volatile("" ::: "memory");
    }
};
struct F13Order {
    StaticOrder base; bool shifted;
    __host__ __device__ __forceinline__ bool next(int i, Unit& u) const {
        const int c = base.c;
        if (!shifted || base.G != 256) return base.next(i, u);
        if (c >= 240) return i < 3 ? base.nextL((long)i * 256 + c, u) : false;
        if (i < 5) return base.nextL((long)i * 256 + c, u);
        if (i == 5) { if (c < 128) return base.nextL(1280 + c, u); if (c < 160) { const int o = c - 128; return base.nextL((long)(3 + o / 16) * 256 + 240 + (o % 16), u); } }
        return false;
    }
    __device__ __forceinline__ void a_ready(const Unit&) const {}
    __device__ __forceinline__ void done(const Unit&) const {}
};
#ifndef TAIL_BY_PANEL
#define TAIL_BY_PANEL 1
#endif
struct SplitTailOrder {
    StaticOrder base; int npieces, piece_nt;
    __host__ __device__ __forceinline__ bool next(int i, Unit& u) const {
        if (i == 0) return base.next(0, u);
        if (i == 1 && npieces > 0) {
#if TAIL_BY_PANEL
            Unit u0{0, 0, 0, 0, 0}; base.next(0, u0); const int id = u0.pm * 8 + u0.pn;
#else
            const int id = base.c;
#endif
            if (id < 16 * npieces) { const int tile = id / npieces, piece = id % npieces; u.pm = 32 + tile / 8; u.pn = tile % 8; u.kofs = piece * piece_nt * BK; u.nt = piece_nt; u.part = piece; return true; } }
        return false;
    }
    __device__ __forceinline__ void a_ready(const Unit&) const {}
    __device__ __forceinline__ void done(const Unit&) const {}
};
struct InOrder {
    int M, G, c; unsigned* pan;
    __host__ __device__ __forceinline__ void init(int M_, int G_, int c_) { M = M_; G = G_; c = c_; }
    __host__ __device__ __forceinline__ bool next(int i, Unit& u) const {
        const int n1 = (M / BM) * 3; const long L = (long)i * G + c;
        StaticOrder s;
        if (L < n1) { s.init(M, 3 * BM, G, c); s.nextL(L, u); u.pn += 10; return true; }
        s.init(M, 11 * BM, G, c);
        if (!s.nextL(L - n1, u)) return false;
        if (u.pn >= 10) u.pn += 3;
        return true;
    }
    __device__ __forceinline__ void a_ready(const Unit&) const {}
    __device__ __forceinline__ void done(const Unit& u) const {
        if (u.pn >= 10 && u.pn <= 12) {
            asm volatile("s_waitcnt vmcnt(0)" ::: "memory"); __builtin_amdgcn_s_barrier(); asm volatile("" ::: "memory");
            if (threadIdx.x == 0) __hip_atomic_fetch_add(pan + 64 * u.pm, 1u, __ATOMIC_RELAXED, __HIP_MEMORY_SCOPE_AGENT);
        }
    }
};
struct PanelOrder {
    int pm, n;
    __device__ __forceinline__ bool next(int i, Unit& u) const { if (i < 0 || i >= n) return false;
        int p = pm; asm volatile("" : "+s"(p));
        u.pm = p; u.pn = i; return true; }
    __device__ __forceinline__ void a_ready(const Unit&) const {}
    __device__ __forceinline__ void done(const Unit&) const {}
};
struct OffsetOrder {
    int nN, nwg, L;
    __host__ __device__ __forceinline__ void init(int M, int N, int c, int off) { nN = N / BM; nwg = (M / BM) * nN; L = c - off; }
    __host__ __device__ __forceinline__ bool has() const { return L >= 0 && L < nwg; }
    __host__ __device__ __forceinline__ bool next(int i, Unit& u) const { if (i != 0 || !has()) return false; u.pm = L / nN; u.pn = L % nN; return true; }
    __device__ __forceinline__ void a_ready(const Unit&) const {}
    __device__ __forceinline__ void done(const Unit&) const {}
};

__device__ __forceinline__ unsigned cvt_pk_bf16(float lo, float hi) { unsigned r; asm volatile("v_cvt_pk_bf16_f32 %0, %1, %2" : "=v"(r) : "v"(lo), "v"(hi)); return r; }
__device__ __forceinline__ u32x4 pack8(const f32x4 v0, const f32x4 v1) { u32x4 w; w.x = cvt_pk_bf16(v0[0], v0[1]); w.y = cvt_pk_bf16(v0[2], v0[3]); w.z = cvt_pk_bf16(v1[0], v1[1]); w.w = cvt_pk_bf16(v1[2], v1[3]); return w; }

struct EpiPlain {
    static constexpr bool PERM = true;
    bf16_t* O; int ldc; bf16_t* Opart; size_t pstride; int pm_ctx; bool wt;
    __device__ __forceinline__ void operator()(const f32x4 (&acc)[2][2][4][2], const Unit& u, int wr, int wc, int fr, int fq) const {
        const bool cx = Opart != nullptr && u.pm >= pm_ctx;
        bf16_t* base = cx ? Opart + (size_t)u.part * pstride - (size_t)pm_ctx * BM * ldc : O;
        const int row0 = u.pm * BM + wr * 64 + fr, col0 = u.pn * BM + wc * 32 + 8 * fq;
#pragma unroll
        for (int ai = 0; ai < 2; ++ai)
#pragma unroll
            for (int m = 0; m < 4; ++m) { bf16_t* rowp = base + (size_t)(row0 + ai * HALF + m * 16) * ldc + col0;
#pragma unroll
                for (int bj = 0; bj < 2; ++bj) { const u32x4 w = pack8(acc[ai][bj][m][0], acc[ai][bj][m][1]); if (wt) gst16_wt(rowp + bj * HALF, w); else gst16(rowp + bj * HALF, w); } }
    }
};
#ifndef ROPE_EPI_A
#define ROPE_EPI_A 1
#endif
#ifndef ROPE_EPI_B
#define ROPE_EPI_B 1
#endif
#ifndef B_NORM_EPI
#define B_NORM_EPI 1
#endif
#ifndef ROPE_EPI_R
#define ROPE_EPI_R 1
#endif
__host__ __device__ __forceinline__ int perm64(int r) { const int n = r >> 5, i = r & 31; return 32 * (i >> 4) + 8 * ((i >> 2) & 3) + 4 * n + (i & 3); }
struct EpiIn {
    static constexpr bool PERM = true;
    bf16_t* O; int ldc; float* ssq; float* ssqb; const float* tab128; const float* tab64; const float* gq; const float* gk; PG8_LAS float* xs; bool wt;
    __device__ __forceinline__ void operator()(const f32x4 (&acc)[2][2][4][2], const Unit& u, int wr, int wc, int fr, int fq) const {
        const int pn = u.pn, row0 = u.pm * BM + wr * 64 + fr, col0 = pn * BM + wc * 32 + 8 * fq;
        const bool ropeA = ROPE_EPI_A && pn <= 3, normB = ROPE_EPI_B && pn >= 5 && pn <= 8, ropeR = ROPE_EPI_R && pn == 13;
        if (ropeA || normB) {
            const int half = wc >> 1, i0 = 16 * (wc & 1) + 4 * fq;
            f32x4 g0 = {1.f, 1.f, 1.f, 1.f}, g1 = g0;
            if (normB) { const float* g = pn == 8 ? gk : gq; g0 = *(const f32x4*)(g + 64 * half + i0); g1 = *(const f32x4*)(g + 64 * half + i0 + 32); }
            if (normB && B_NORM_EPI) {
#pragma unroll
                for (int ai = 0; ai < 2; ++ai)
#pragma unroll
                    for (int m = 0; m < 4; ++m)
#pragma unroll
                        for (int bj = 0; bj < 2; ++bj) { const f32x4 x1 = acc[ai][bj][m][0], x2 = acc[ai][bj][m][1];
                            float s = ((x1[0] * x1[0] + x1[1] * x1[1]) + (x1[2] * x1[2] + x1[3] * x1[3])) + ((x2[0] * x2[0] + x2[1] * x2[1]) + (x2[2] * x2[2] + x2[3] * x2[3]));
                            s += __shfl_xor(s, 16); s += __shfl_xor(s, 32);
                            if (fq == 0) xs[((ai * HALF + wr * 64 + m * 16 + fr) * 2 + bj) * 4 + wc] = s; }
                asm volatile("s_waitcnt lgkmcnt(0)" ::: "memory"); __builtin_amdgcn_s_barrier(); asm volatile("" ::: "memory");
            }
#pragma unroll
            for (int ai = 0; ai < 2; ++ai)
#pragma unroll
                for (int m = 0; m < 4; ++m) { const int row = row0 + ai * HALF + m * 16; const bool lat = row < 8192; const int t = row & 4095, pos = half ? (t & 63) : (t >> 6);
                    f32x4 cs = {1.f, 1.f, 1.f, 1.f}, sn = {0.f, 0.f, 0.f, 0.f};
                    if (lat) { const f32x4 t0 = *(const f32x4*)(tab128 + (size_t)(pos * 32 + i0) * 2), t1 = *(const f32x4*)(tab128 + (size_t)(pos * 32 + i0) * 2 + 4);
                        cs = (f32x4){t0[0], t0[2], t1[0], t1[2]}; sn = (f32x4){t0[1], t0[3], t1[1], t1[3]}; }
                    bf16_t* rowp = O + (size_t)row * ldc + col0;
#pragma unroll
                    for (int bj = 0; bj < 2; ++bj) { f32x4 x1 = acc[ai][bj][m][0], x2 = acc[ai][bj][m][1];
                        if (normB && B_NORM_EPI) { const f32x4 sq = *(const PG8_LAS f32x4*)(xs + ((ai * HALF + wr * 64 + m * 16 + fr) * 2 + bj) * 4);
                            const float rstd = rsqrtf(((sq[0] + sq[1]) + (sq[2] + sq[3])) * (1.f / 128.f) + 1e-6f);
                            x1 = x1 * g0 * rstd; x2 = x2 * g1 * rstd; }
                        else if (normB) { float s = ((x1[0] * x1[0] + x1[1] * x1[1]) + (x1[2] * x1[2] + x1[3] * x1[3])) + ((x2[0] * x2[0] + x2[1] * x2[1]) + (x2[2] * x2[2] + x2[3] * x2[3]));
                            s += __shfl_xor(s, 16); s += __shfl_xor(s, 32);
                            if (fq == 0) ssqb[(size_t)row * 32 + ((pn - 5) * 2 + bj) * 4 + wc] = s;
                            x1 = x1 * g0; x2 = x2 * g1; }
                        gst16(rowp + bj * HALF, pack8(x1 * cs - x2 * sn, x2 * cs + x1 * sn)); }
                    if (m & 1) asm volatile("" ::: "memory"); }
            return;
        }
#pragma unroll
        for (int ai = 0; ai < 2; ++ai)
#pragma unroll
            for (int m = 0; m < 4; ++m) { const int row = row0 + ai * HALF + m * 16; bf16_t* rowp = O + (size_t)row * ldc + col0;
                f32x4 v0 = acc[ai][0][m][0], v1 = acc[ai][0][m][1];
                if (ropeR && wc < 2) {
                    f32x4 p0, p1;
#pragma unroll
                    for (int j = 0; j < 4; ++j) { p0[j] = __shfl_xor(v0[j], 32); p1[j] = __shfl_xor(v1[j], 32); }
                    if (row < 8192) { const int t = row & 4095, pos = wc ? (t & 63) : (t >> 6), ib = 8 * (fq & 1);
                        const f32x4 a0 = *(const f32x4*)(tab64 + (size_t)(pos * 16 + ib) * 2), a1 = *(const f32x4*)(tab64 + (size_t)(pos * 16 + ib) * 2 + 4), a2 = *(const f32x4*)(tab64 + (size_t)(pos * 16 + ib) * 2 + 8), a3 = *(const f32x4*)(tab64 + (size_t)(pos * 16 + ib) * 2 + 12);
                        const f32x4 c0 = {a0[0], a0[2], a1[0], a1[2]}, s0 = {a0[1], a0[3], a1[1], a1[3]}, c1 = {a2[0], a2[2], a3[0], a3[2]}, s1 = {a2[1], a2[3], a3[1], a3[3]};
                        if (fq < 2) { v0 = v0 * c0 - p0 * s0; v1 = v1 * c1 - p1 * s1; } else { v0 = v0 * c0 + p0 * s0; v1 = v1 * c1 + p1 * s1; } }
                }
                if (wt && pn >= 10 && pn <= 12) { gst16_wt(rowp, pack8(v0, v1)); gst16_wt(rowp + HALF, pack8(acc[ai][1][m][0], acc[ai][1][m][1])); }
                else { gst16(rowp, pack8(v0, v1)); gst16(rowp + HALF, pack8(acc[ai][1][m][0], acc[ai][1][m][1])); } }
        if (pn >= 10 && pn <= 12) {
#pragma unroll
            for (int ai = 0; ai < 2; ++ai)
#pragma unroll
                for (int m = 0; m < 4; ++m) { float s = 0.f;
#pragma unroll
                    for (int bj = 0; bj < 2; ++bj)
#pragma unroll
                        for (int n = 0; n < 2; ++n) { const f32x4 x = acc[ai][bj][m][n]; s += (x[0] * x[0] + x[1] * x[1]) + (x[2] * x[2] + x[3] * x[3]); }
                    s += __shfl_xor(s, 16); s += __shfl_xor(s, 32);
                    if (fq == 0) __hip_atomic_store(ssq + (size_t)(row0 + ai * HALF + m * 16) * 12 + (pn - 10) * 4 + wc, s, __ATOMIC_RELAXED, __HIP_MEMORY_SCOPE_AGENT); }
        }
    }
};
#ifndef UQ_ROPE_ON
#define UQ_ROPE_ON 1
#endif
struct EpiUq {
    static constexpr bool PERM = false;
    bf16_t* O; const float* ssq; const float* tab64; int rabs;
    __device__ __forceinline__ void operator()(const f32x4 (&acc)[2][2][4][2], const Unit& u, int wr, int wc, int fr, int fq) const {
        float rs[2][4];
#pragma unroll
        for (int ai = 0; ai < 2; ++ai)
#pragma unroll
            for (int m = 0; m < 4; ++m) { const int row = u.pm * BM + ai * HALF + wr * 64 + m * 16 + fr;
                const f32x4 q0 = *(const f32x4*)(ssq + (size_t)row * 12), q1 = *(const f32x4*)(ssq + (size_t)row * 12 + 4);
                rs[ai][m] = rsqrtf(((q0[0] + q0[1]) + (q0[2] + q0[3]) + (q1[0] + q1[1]) + (q1[2] + q1[3])) * (1.f / 512.f) + 1e-6f);
                if (m & 1) asm volatile("" ::: "memory"); }
#pragma unroll
        for (int ai = 0; ai < 2; ++ai)
#pragma unroll
            for (int m = 0; m < 4; ++m) {
                const int row = u.pm * BM + ai * HALF + wr * 64 + m * 16 + fr; const float rstd = rs[ai][m];
                const bool lat = rabs + row < 8192; const int t = (rabs + row) & 4095, prow = t >> 6, pcol = t & 63;
#pragma unroll
                for (int bj = 0; bj < 2; ++bj) {
                    const int g6 = (8 * u.pn + 4 * bj + wc) % 6;
                    f32x4 v0 = acc[ai][bj][m][0] * rstd, v1 = acc[ai][bj][m][1] * rstd;
                    if (UQ_ROPE_ON && g6 >= 4 && lat) {
                        const int pos = g6 == 4 ? prow : pcol;
                        const f32x4 t0 = *(const f32x4*)(tab64 + (size_t)(pos * 16 + 4 * fq) * 2), t1 = *(const f32x4*)(tab64 + (size_t)(pos * 16 + 4 * fq) * 2 + 4);
                        const f32x4 cs = {t0[0], t0[2], t1[0], t1[2]}, sn = {t0[1], t0[3], t1[1], t1[3]};
                        const f32x4 o0 = v0 * cs - v1 * sn, o1 = v1 * cs + v0 * sn; v0 = o0; v1 = o1;
                    }
                    bf16_t* p = O + (size_t)row * 768 + u.pn * BM + bj * HALF + wc * 32 + 4 * fq;
                    u32x2 w0, w1; w0.x = cvt_pk_bf16(v0[0], v0[1]); w0.y = cvt_pk_bf16(v0[2], v0[3]); w1.x = cvt_pk_bf16(v1[0], v1[1]); w1.y = cvt_pk_bf16(v1[2], v1[3]);
                    gst8(p, w0); gst8(p + 16, w1);
                }
                asm volatile("" ::: "memory");
            }
    }
};
struct EpiUkv {
    static constexpr bool PERM = true;
    bf16_t* O; const float* ssq;
    __device__ __forceinline__ void operator()(const f32x4 (&acc)[2][2][4][2], const Unit& u, int wr, int wc, int fr, int fq) const {
        const int row0 = u.pm * BM + wr * 64 + fr, col0 = u.pn * BM + wc * 32 + 8 * fq;
        float rs[2][4];
#pragma unroll
        for (int ai = 0; ai < 2; ++ai)
#pragma unroll
            for (int m = 0; m < 4; ++m) { const int row = row0 + ai * HALF + m * 16;
                const f32x4 q0 = *(const f32x4*)(ssq + (size_t)row * 12 + 8);
                rs[ai][m] = rsqrtf(((q0[0] + q0[1]) + (q0[2] + q0[3])) * (1.f / 256.f) + 1e-6f);
                if (m & 1) asm volatile("" ::: "memory"); }
#pragma unroll
        for (int ai = 0; ai < 2; ++ai)
#pragma unroll
            for (int m = 0; m < 4; ++m) { const int row = row0 + ai * HALF + m * 16; const float rstd = rs[ai][m];
                bf16_t* rowp = O + (size_t)row * 1024 + col0;
#pragma unroll
                for (int bj = 0; bj < 2; ++bj) gst16(rowp + bj * HALF, pack8(acc[ai][bj][m][0] * rstd, acc[ai][bj][m][1] * rstd)); }
    }
};
struct EpiSwiglu {
    static constexpr bool PERM = true;
    bf16_t* O; int ldc;
    __device__ __forceinline__ void operator()(const f32x4 (&acc)[2][2][4][2], const Unit& u, int wr, int wc, int fr, int fq) const {
        const int row0 = u.pm * BM + wr * 64 + fr, col0 = u.pn * HALF + wc * 32 + 8 * fq;
#pragma unroll
        for (int ai = 0; ai < 2; ++ai)
#pragma unroll
            for (int m = 0; m < 4; ++m) { f32x4 r[2];
#pragma unroll
                for (int n = 0; n < 2; ++n) { const f32x4 g = acc[ai][0][m][n], up = acc[ai][1][m][n];
#pragma unroll
                    for (int j = 0; j < 4; ++j) { const float e = __builtin_amdgcn_exp2f(g[j] * -1.4426950408889634f); r[n][j] = g[j] * __builtin_amdgcn_rcpf(1.f + e) * up[j]; } }
                gst16(O + (size_t)(row0 + ai * HALF + m * 16) * ldc + col0, pack8(r[0], r[1])); }
    }
};

template <class Epi, class Sched, bool ALIGN_EPI>
__device__ __forceinline__ void gemm_phase(PG8_LAS unsigned char* lds, const Gemm g, const Sched& S, const Epi& E) {
    int tid_ = threadIdx.x; asm volatile("" : "+v"(tid_));
    const int tid = tid_, wid = __builtin_amdgcn_readfirstlane(tid >> 6), lane = tid & 63, wr = wid >> 2, wc = wid & 3, fr = lane & 15, fq = lane >> 4;
    int K_ = g.K; asm volatile("" : "+s"(K_));
    const int K = K_, nt = K / BK, lda = g.lda;
    unsigned voffA[2], voffB[2];
#pragma unroll
    for (int i = 0; i < 2; ++i) { int R, C; stage_rc(tid * 16 + i * 8192, R, C); const int Rb = Epi::PERM ? ((R & ~31) + perm32(R & 31)) : R;
        voffA[i] = (unsigned)(R * lda + C) * 2u; voffB[i] = (unsigned)(Rb * K + C) * 2u; }
    const size_t kstep = (size_t)(BK * 2);
    const size_t hstepA = (size_t)HALF * lda * 2, tstepA = 2 * hstepA, hstepB = (size_t)HALF * K * 2, tstepB = 2 * hstepB;
    const unsigned ldsw = (unsigned)wid * 1024u;
    const int aoff = lds_byte(wr * 64 + fr, fq * 8), boff = lds_byte(wc * 32 + fr, fq * 8);
#define PG8_SA(b, h) (((b) * 2 + (h)) * HTB)
#define PG8_SB(b, h) ((4 + (b) * 2 + (h)) * HTB)
#define PG8_STAGE(bufoff, gbase, voff) do { _Pragma("unroll") for (int _i = 0; _i < 2; ++_i) \
        __builtin_amdgcn_global_load_lds((const unsigned*)((const char*)(gbase) + (voff)[_i]), (PG8_LAS unsigned*)(lds + (bufoff) + ldsw + _i * 8192), 16, 0, 0); } while (0)
#define PG8_LDA(dst, b, h) do { _Pragma("unroll") for (int m = 0; m < 4; ++m) _Pragma("unroll") for (int k = 0; k < 2; ++k) dst[m][k] = *(const PG8_LAS bf16x8*)(lds + PG8_SA(b, h) + aoff + m * 2048 + k * 1024); } while (0)
#define PG8_LDB(dst, b, h) do { _Pragma("unroll") for (int n = 0; n < 2; ++n) _Pragma("unroll") for (int k = 0; k < 2; ++k) dst[n][k] = *(const PG8_LAS bf16x8*)(lds + PG8_SB(b, h) + boff + n * 2048 + k * 1024); } while (0)
#define PG8_MMA(ai, bj, At, Bt) do { __builtin_amdgcn_s_setprio(1); _Pragma("unroll") for (int m = 0; m < 4; ++m) _Pragma("unroll") for (int n = 0; n < 2; ++n) _Pragma("unroll") for (int k = 0; k < 2; ++k) \
        acc[ai][bj][m][n] = __builtin_amdgcn_mfma_f32_16x16x32_bf16(Bt[n][k], At[m][k], acc[ai][bj][m][n], 0, 0, 0); __builtin_amdgcn_s_setprio(0); } while (0)
#define PG8_WAIT_V(n) asm volatile("s_waitcnt vmcnt(" #n ")" ::: "memory")
#define PG8_WAIT_L(n) asm volatile("s_waitcnt lgkmcnt(" #n ")" ::: "memory")
#define PG8_BAR __builtin_amdgcn_s_barrier()
#define PG8_SCHED __builtin_amdgcn_sched_barrier(0)
    Unit cur{0, 0, 0, nt, 0}, nxt{0, 0, 0, nt, 0}; int ui = 0;
    if (!S.next(0, cur)) return;
    f32x4 acc[2][2][4][2];
#pragma unroll
    for (int a = 0; a < 2; ++a)
#pragma unroll
        for (int b = 0; b < 2; ++b)
#pragma unroll
            for (int m = 0; m < 4; ++m)
#pragma unroll
                for (int n = 0; n < 2; ++n) acc[a][b][m][n] = (f32x4){0.f, 0.f, 0.f, 0.f};
    bf16x8 At[4][2], B0[2][2], B1[2][2];
    const char* cA = (const char*)g.A + (size_t)cur.pm * tstepA + (size_t)cur.kofs * 2; const char* cB = (const char*)g.Bt + (size_t)cur.pn * tstepB + (size_t)cur.kofs * 2;
    S.a_ready(cur);
    PG8_STAGE(PG8_SB(0, 0), cB, voffB); PG8_STAGE(PG8_SB(0, 1), cB + hstepB, voffB); PG8_STAGE(PG8_SA(0, 0), cA, voffA); PG8_STAGE(PG8_SA(0, 1), cA + hstepA, voffA);
    if (wr == 1) PG8_BAR;
    PG8_WAIT_V(2); PG8_BAR;
    PG8_STAGE(PG8_SB(1, 0), cB + kstep, voffB); PG8_STAGE(PG8_SA(1, 0), cA + kstep, voffA); PG8_STAGE(PG8_SB(1, 1), cB + hstepB + kstep, voffB);
    PG8_WAIT_V(6); PG8_BAR;
    for (;;) {
        nxt.kofs = 0; nxt.nt = nt; nxt.part = 0;
        const bool has_next = S.next(ui + 1, nxt);
        const char* nA = has_next ? (const char*)g.A + (size_t)nxt.pm * tstepA + (size_t)nxt.kofs * 2 : cA; const char* nB = has_next ? (const char*)g.Bt + (size_t)nxt.pn * tstepB + (size_t)nxt.kofs * 2 : cB;
        const int ntc = cur.nt;
        for (int t = 0; t < ntc; t += 2) {
            const bool last = (t == ntc - 2);
            const char* a1 = cA + (size_t)(t + 1) * kstep;
            const char* a2 = last ? nA : cA + (size_t)(t + 2) * kstep; const char* b2 = last ? nB : cB + (size_t)(t + 2) * kstep;
            const char* a3 = a2 + kstep; const char* b3 = b2 + kstep;
            if (last && has_next) S.a_ready(nxt);
            PG8_LDB(B0, 0, 0); PG8_LDB(B1, 0, 1); PG8_SCHED; PG8_LDA(At, 0, 0); PG8_STAGE(PG8_SA(1, 1), a1 + hstepA, voffA);
            PG8_WAIT_V(8); PG8_WAIT_L(0); PG8_BAR; PG8_MMA(0, 0, At, B0); PG8_MMA(0, 1, At, B1); PG8_BAR; PG8_SCHED;
            PG8_LDA(At, 0, 1); PG8_STAGE(PG8_SB(0, 0), b2, voffB); PG8_STAGE(PG8_SB(0, 1), b2 + hstepB, voffB); PG8_STAGE(PG8_SA(0, 0), a2, voffA);
            PG8_WAIT_V(8); PG8_WAIT_L(0); PG8_BAR; PG8_MMA(1, 0, At, B0); PG8_MMA(1, 1, At, B1); PG8_BAR; PG8_SCHED;
            PG8_LDB(B0, 1, 0); PG8_LDB(B1, 1, 1); PG8_SCHED; PG8_LDA(At, 1, 0); PG8_STAGE(PG8_SA(0, 1), a2 + hstepA, voffA);
            PG8_WAIT_V(8); PG8_WAIT_L(0); PG8_BAR; PG8_MMA(0, 0, At, B0); PG8_MMA(0, 1, At, B1); PG8_BAR; PG8_SCHED;
            PG8_LDA(At, 1, 1); PG8_STAGE(PG8_SB(1, 0), b3, voffB); PG8_STAGE(PG8_SB(1, 1), b3 + hstepB, voffB); PG8_STAGE(PG8_SA(1, 0), a3, voffA);
            PG8_WAIT_V(8); PG8_WAIT_L(0); PG8_BAR; PG8_MMA(1, 0, At, B0); PG8_MMA(1, 1, At, B1); PG8_BAR; PG8_SCHED;
        }
        if constexpr (ALIGN_EPI) { if (wr == 0) PG8_BAR; }
        E(acc, cur, wr, wc, fr, fq); S.done(cur);
        if (!has_next) break;
#pragma unroll
        for (int a = 0; a < 2; ++a)
#pragma unroll
            for (int b = 0; b < 2; ++b)
#pragma unroll
                for (int m = 0; m < 4; ++m)
#pragma unroll
                    for (int n = 0; n < 2; ++n) acc[a][b][m][n] = (f32x4){0.f, 0.f, 0.f, 0.f};
        cur = nxt; cA = nA; cB = nB; ++ui;
        if constexpr (ALIGN_EPI) { if (wr == 1) PG8_BAR; }
    }
    PG8_WAIT_V(0);
    if constexpr (!ALIGN_EPI) { if (wr == 0) PG8_BAR; }
    PG8_BAR;
#undef PG8_SA
#undef PG8_SB
#undef PG8_STAGE
#undef PG8_LDA
#undef PG8_LDB
#undef PG8_MMA
#undef PG8_WAIT_V
#undef PG8_WAIT_L
#undef PG8_BAR
#undef PG8_SCHED
}
}

#ifndef ATTN_PRIO
#define ATTN_PRIO 0
#endif
namespace at {
using bf16_t = unsigned short;
using bf16x8 = __attribute__((ext_vector_type(8))) short;
using s16x4  = __attribute__((ext_vector_type(4))) short;
using f32x16 = __attribute__((ext_vector_type(16))) float;
using u32x4  = __attribute__((ext_vector_type(4))) unsigned;
constexpr int NW = 8, QBLK = 32, KVBLK = 64;
constexpr int SHM_V = 16384, SHM_K = 16384, SHM_K2 = 8192;
constexpr int OFF_V = 0, OFF_K = 2 * SHM_V, OFF_K2 = OFF_K + 2 * SHM_K, OFF_WS = OFF_K2 + 2 * SHM_K2, OFF_Q2 = OFF_WS + NW * 64 * 4, OFF_FLG = OFF_Q2 + NW * 6144, ATT_LDS = OFF_FLG + 16;
constexpr float THR = 8.f;
constexpr int DUMP_FLOATS = NW * 66 * 64;
#define KSWZ(row, colB) ((row) * 256 + ((colB) ^ (((row) & 7) << 4)))
#define KSWZ2(row, colB) ((row) * 128 + ((colB) ^ (((row) & 7) << 4)))
#define SBAR() __builtin_amdgcn_sched_barrier(0)
__device__ __forceinline__ int crow(int r, int hi) { return (r & 3) + 8 * (r >> 2) + 4 * hi; }
__device__ __forceinline__ unsigned cvtpk(float lo, float hi) { unsigned r; asm volatile("v_cvt_pk_bf16_f32 %0, %1, %2" : "=v"(r) : "v"(lo), "v"(hi)); return r; }

struct AUnit {
    const bf16_t* Q; const bf16_t* KV; const bf16_t* K2; bf16_t* O;
    long kc, kl, vc, vl, k2c, k2l;
    int ldq, ldk, ldv, ldk2, ldo;
    int nct, ntl;
    float* part_own; const float* part_oth; unsigned* cnt;
    int qk_off;
    float sink;
};

template <int DK>
__device__ __forceinline__ void partialSM(f32x16& p0, f32x16& p1, float& m_reg, float& mn, float& alpha) {
    constexpr float SCALE = DK == 128 ? 0.08838834764831845f : 0.07216878364870323f, C = SCALE * 1.4426950408889634f;
    float pmax = p0[0];
#pragma unroll
    for (int r = 1; r < 16; ++r) pmax = fmaxf(pmax, p0[r]);
#pragma unroll
    for (int r = 0; r < 16; ++r) pmax = fmaxf(pmax, p1[r]);
    { auto rr = __builtin_amdgcn_permlane32_swap(__float_as_uint(pmax), __float_as_uint(pmax), false, false);
      pmax = fmaxf(__uint_as_float(rr[0]), __uint_as_float(rr[1])); }
    if (__builtin_expect(__all(pmax - m_reg <= THR / SCALE), 1)) { mn = m_reg; alpha = 1.f; }
    else { mn = fmaxf(m_reg, pmax); alpha = __builtin_amdgcn_exp2f((m_reg - mn) * C); m_reg = mn; }
    const float mnC = -mn * C;
#pragma unroll
    for (int r = 0; r < 16; ++r) p0[r] = fmaf(p0[r], C, mnC);
#pragma unroll
    for (int r = 0; r < 16; ++r) p1[r] = fmaf(p1[r], C, mnC);
#pragma unroll
    for (int r = 0; r < 16; ++r) p0[r] = __builtin_amdgcn_exp2f(p0[r]);
}
__device__ __forceinline__ void finishSM(f32x16& p0, f32x16& p1, float alpha, float& l_reg, bf16x8& pa0, bf16x8& pa1, bf16x8& pa2, bf16x8& pa3) {
#pragma unroll
    for (int r = 0; r < 16; ++r) p1[r] = __builtin_amdgcn_exp2f(p1[r]);
    float ps = 0;
#pragma unroll
    for (int r = 0; r < 16; ++r) ps += p0[r];
#pragma unroll
    for (int r = 0; r < 16; ++r) ps += p1[r];
    { auto rr = __builtin_amdgcn_permlane32_swap(__float_as_uint(ps), __float_as_uint(ps), false, false);
      ps = __uint_as_float(rr[0]) + __uint_as_float(rr[1]); }
    l_reg = l_reg * alpha + ps;
#define PK4(P, BASE, OUT) do { unsigned a0 = cvtpk(P[BASE + 0], P[BASE + 1]), a1 = cvtpk(P[BASE + 2], P[BASE + 3]);   \
    unsigned b0 = cvtpk(P[BASE + 4], P[BASE + 5]), b1 = cvtpk(P[BASE + 6], P[BASE + 7]);                              \
    auto r0 = __builtin_amdgcn_permlane32_swap(a0, b0, false, false); auto r1 = __builtin_amdgcn_permlane32_swap(a1, b1, false, false); \
    u32x4 w = {r0[0], r1[0], r0[1], r1[1]}; OUT = *reinterpret_cast<bf16x8*>(&w); } while (0)
    PK4(p0, 0, pa0); PK4(p0, 8, pa1); PK4(p1, 0, pa2); PK4(p1, 8, pa3);
#undef PK4
}
template <int DK>
__device__ __forceinline__ void qkt(f32x16& p0, f32x16& p1, const char* Ks, const char* K2s, const bf16x8* qr, const char* q2, int r32, int hi) {
    constexpr int NQR = 8;
    p0 = f32x16{}; p1 = f32x16{};
#pragma unroll
    for (int d0 = 0; d0 < 8; ++d0) { const int cb = (d0 * 16 + hi * 8) * 2;
        const bf16x8 b0 = *reinterpret_cast<const bf16x8*>(Ks + KSWZ(r32, cb));
        const bf16x8 b1 = *reinterpret_cast<const bf16x8*>(Ks + KSWZ(32 + r32, cb));
        bf16x8 qf; if (d0 < NQR) qf = qr[d0 < NQR ? d0 : 0]; else qf = *reinterpret_cast<const bf16x8*>(q2 + (d0 - 8) * 1024);
        p0 = __builtin_amdgcn_mfma_f32_32x32x16_bf16(b0, qf, p0, 0, 0, 0);
        p1 = __builtin_amdgcn_mfma_f32_32x32x16_bf16(b1, qf, p1, 0, 0, 0); }
    if constexpr (DK == 192) {
#pragma unroll
        for (int d0 = 0; d0 < 4; ++d0) { const int cb = (d0 * 16 + hi * 8) * 2;
            const bf16x8 b0 = *reinterpret_cast<const bf16x8*>(K2s + KSWZ2(r32, cb));
            const bf16x8 b1 = *reinterpret_cast<const bf16x8*>(K2s + KSWZ2(32 + r32, cb));
            const bf16x8 qf = *reinterpret_cast<const bf16x8*>(q2 + d0 * 1024);
            p0 = __builtin_amdgcn_mfma_f32_32x32x16_bf16(b0, qf, p0, 0, 0, 0);
            p1 = __builtin_amdgcn_mfma_f32_32x32x16_bf16(b1, qf, p1, 0, 0, 0); }
    }
}
__device__ __forceinline__ int v_st(int k, int c) { const int kk = (k & ~0xC) | ((k & 4) << 1) | ((k & 8) >> 1); return ((kk >> 3) * 4 + (c >> 5)) * 512 + ((kk & 7) * 32 + (c & 31)) * 2; }
__device__ __forceinline__ int v_rd_base(int lane) { return ((lane & 3) << 3) | (((lane >> 2) & 3) << 6) | (((lane >> 4) & 1) << 5) | (((lane >> 5) & 1) << 8); }
constexpr int v_rd_off(int d0, int ks, int half) { return d0 * 512 + ks * 4096 + half * 2048; }
template <int OFF> __device__ __forceinline__ s16x4 tr_read(int vb) {
    s16x4 r; asm volatile("ds_read_b64_tr_b16 %0, %1 offset:%2" : "=&v"(r) : "v"(vb), "i"(OFF) : "memory"); return r;
}
struct VFrag { s16x4 l0, h0, l1, h1, l2, h2, l3, h3; };
template <int D0> __device__ __forceinline__ void v_load(VFrag& f, int vb) {
    f.l0 = tr_read<v_rd_off(D0, 0, 0)>(vb); f.h0 = tr_read<v_rd_off(D0, 0, 1)>(vb); f.l1 = tr_read<v_rd_off(D0, 1, 0)>(vb); f.h1 = tr_read<v_rd_off(D0, 1, 1)>(vb);
    f.l2 = tr_read<v_rd_off(D0, 2, 0)>(vb); f.h2 = tr_read<v_rd_off(D0, 2, 1)>(vb); f.l3 = tr_read<v_rd_off(D0, 3, 0)>(vb); f.h3 = tr_read<v_rd_off(D0, 3, 1)>(vb);
}
__device__ __forceinline__ void v_mma(f32x16& od, const VFrag& f, bf16x8 pa0, bf16x8 pa1, bf16x8 pa2, bf16x8 pa3) {
#define PK(L, H) (bf16x8){L[0], L[1], L[2], L[3], H[0], H[1], H[2], H[3]}
    od = __builtin_amdgcn_mfma_f32_32x32x16_bf16(pa0, PK(f.l0, f.h0), od, 0, 0, 0);
    od = __builtin_amdgcn_mfma_f32_32x32x16_bf16(pa1, PK(f.l1, f.h1), od, 0, 0, 0);
    od = __builtin_amdgcn_mfma_f32_32x32x16_bf16(pa2, PK(f.l2, f.h2), od, 0, 0, 0);
    od = __builtin_amdgcn_mfma_f32_32x32x16_bf16(pa3, PK(f.l3, f.h3), od, 0, 0, 0);
#undef PK
}
template <int D0> __device__ __forceinline__ void pv_one(f32x16& od, int vb, bf16x8 pa0, bf16x8 pa1, bf16x8 pa2, bf16x8 pa3) {
    VFrag f; v_load<D0>(f, vb);
    asm volatile("s_waitcnt lgkmcnt(0)" ::: "memory"); SBAR();
    v_mma(od, f, pa0, pa1, pa2, pa3);
}
template <bool PIPE> __device__ __forceinline__ void pv_d0(f32x16* o, int vb, bf16x8 pa0, bf16x8 pa1, bf16x8 pa2, bf16x8 pa3) {
    if constexpr (!PIPE) { pv_one<0>(o[0], vb, pa0, pa1, pa2, pa3); pv_one<1>(o[1], vb, pa0, pa1, pa2, pa3); pv_one<2>(o[2], vb, pa0, pa1, pa2, pa3); pv_one<3>(o[3], vb, pa0, pa1, pa2, pa3); return; }
    VFrag fa, fb;
    v_load<0>(fa, vb); v_load<1>(fb, vb);
    asm volatile("s_waitcnt lgkmcnt(8)" ::: "memory"); SBAR(); v_mma(o[0], fa, pa0, pa1, pa2, pa3); SBAR();
    v_load<2>(fa, vb);
    asm volatile("s_waitcnt lgkmcnt(8)" ::: "memory"); SBAR(); v_mma(o[1], fb, pa0, pa1, pa2, pa3); SBAR();
    v_load<3>(fb, vb);
    asm volatile("s_waitcnt lgkmcnt(8)" ::: "memory"); SBAR(); v_mma(o[2], fa, pa0, pa1, pa2, pa3); SBAR();
    asm volatile("s_waitcnt lgkmcnt(0)" ::: "memory"); SBAR(); v_mma(o[3], fb, pa0, pa1, pa2, pa3);
}
__device__ __forceinline__ void wmask(f32x16& p0, f32x16& p1, int base, int hi) {
#pragma unroll
    for (int r = 0; r < 16; ++r) { const int d0 = base + (r & 3) + 8 * (r >> 2) + 4 * hi, d1 = d0 + 32;
        if (d0 > 128 || d0 < -128) p0[r] = -1e30f; if (d1 > 128 || d1 < -128) p1[r] = -1e30f; }
}

template <int DK, bool WINDOW, bool SPLIT = false, int SD = 1>
__device__ __forceinline__ void attn_unit(const AUnit U, char* lds) {
    constexpr int ND0 = DK / 16;
    constexpr float SCALE = DK == 128 ? 0.08838834764831845f : 0.07216878364870323f, C = SCALE * 1.4426950408889634f;
    int tid_ = threadIdx.x; asm volatile("" : "+v"(tid_));
    const int tid = tid_, wid = __builtin_amdgcn_readfirstlane(tid >> 6), lane = tid & 63, r32 = lane & 31, hi = lane >> 5;
    char* V_lds = lds + OFF_V; char* K_lds = lds + OFF_K; char* K2_lds = lds + OFF_K2;
    float* ws = (float*)(lds + OFF_WS) + wid * 64; float* li_l = ws; float* al_l = ws + 32;
    float m_reg = -1e30f, l_reg = 0; f32x16 o[4] = {}; bf16x8 qr[8];
    char* q2 = lds + OFF_Q2 + wid * 6144 + lane * 16;
    const bf16_t* Qw = U.Q + (size_t)(wid * QBLK + r32) * U.ldq + hi * 8;
#pragma unroll
    for (int d0 = 0; d0 < 8; ++d0) qr[d0] = *reinterpret_cast<const bf16x8*>(Qw + d0 * 16);
    if constexpr (DK == 192) {
#pragma unroll
        for (int d0 = 8; d0 < 12; ++d0) *reinterpret_cast<bf16x8*>(q2 + (d0 - 8) * 1024) = *reinterpret_cast<const bf16x8*>(Qw + d0 * 16);
    }
    const int sr = tid >> 4, sc = (tid & 15) * 8, vst0 = v_st(sr, sc), vst1 = v_st(32 + sr, sc);
    const int sr2 = tid >> 3, sc2 = (tid & 7) * 8;
    const int vb0 = (int)(uintptr_t)V_lds + v_rd_base(lane);
    bf16x8 vsE0, vsE1, ksE0, ksE1, k2E, vsO0, vsO1, ksO0, ksO1, k2O;
    const int NT = U.nct + U.ntl, nct = U.nct;
#define SLOAD(S, t) do { const int t_ = (t); const bool cx_ = t_ < nct; const long ro_ = (long)((cx_ ? t_ : t_ - nct) * KVBLK); \
    const bf16_t* kb_ = U.KV + ((cx_ ? U.kc : U.kl) + ro_ * U.ldk); const bf16_t* vb_ = U.KV + ((cx_ ? U.vc : U.vl) + ro_ * U.ldv); \
    vs##S##0 = *reinterpret_cast<const bf16x8*>(vb_ + (long)sr * U.ldv + sc); vs##S##1 = *reinterpret_cast<const bf16x8*>(vb_ + (long)(32 + sr) * U.ldv + sc); \
    ks##S##0 = *reinterpret_cast<const bf16x8*>(kb_ + (long)sr * U.ldk + sc); ks##S##1 = *reinterpret_cast<const bf16x8*>(kb_ + (long)(32 + sr) * U.ldk + sc); \
    if constexpr (DK == 192) { const bf16_t* k2_ = U.K2 + ((cx_ ? U.k2c : U.k2l) + ro_ * U.ldk2); k2##S = *reinterpret_cast<const bf16x8*>(k2_ + (long)sr2 * U.ldk2 + sc2); } } while (0)
#define SWRITE(b, S) do { *(bf16x8*)(V_lds + (b) * SHM_V + vst0) = vs##S##0; *(bf16x8*)(V_lds + (b) * SHM_V + vst1) = vs##S##1; const int kc_ = sc * 2; \
    *(bf16x8*)(K_lds + (b) * SHM_K + KSWZ(sr, kc_)) = ks##S##0; *(bf16x8*)(K_lds + (b) * SHM_K + KSWZ(32 + sr, kc_)) = ks##S##1; \
    if constexpr (DK == 192) { *(bf16x8*)(K2_lds + (b) * SHM_K2 + KSWZ2(sr2, sc2 * 2)) = k2##S; } } while (0)
#define RESC(a) do { if (__any((a) < 1.f)) { if (hi == 0) al_l[r32] = (a); asm volatile("s_waitcnt lgkmcnt(0)" ::: "memory"); \
    _Pragma("unroll") for (int d = 0; d < 4; ++d) _Pragma("unroll") for (int r = 0; r < 16; ++r) o[d][r] *= al_l[crow(r, hi)]; } } while (0)
#define WMASK(P0, P1, t) do { if constexpr (WINDOW) { if ((t) >= 4) wmask(P0, P1, U.qk_off + ((t) - 4) * KVBLK - wid * QBLK - r32, hi); } } while (0)
    f32x16 pA0, pA1, pB0, pB1; float mnA, mnB, alA, alB; bf16x8 pa0, pa1, pa2, pa3;
    SLOAD(E, 0); SWRITE(0, E); __syncthreads();
    qkt<DK>(pA0, pA1, K_lds, K2_lds, qr, q2, r32, hi); partialSM<DK>(pA0, pA1, m_reg, mnA, alA);
    if constexpr (SD == 2) { SLOAD(O, 1); SLOAD(E, 2); SWRITE(1, O); } else { SLOAD(E, 1); SWRITE(1, E); }
    __syncthreads();
#if ATTN_PRIO
    if (wid >= 4) __builtin_amdgcn_s_setprio(ATTN_PRIO);
#endif
    for (int j = 1; j + 1 < NT; j += 2) {
        SBAR(); qkt<DK>(pB0, pB1, K_lds + SHM_K, K2_lds + SHM_K2, qr, q2, r32, hi); WMASK(pB0, pB1, j);
        finishSM(pA0, pA1, alA, l_reg, pa0, pa1, pa2, pa3); SBAR();
        if constexpr (SD == 2) SLOAD(O, j + 2); else SLOAD(E, j + 1);
        SBAR();
        pv_d0<false>(o, vb0, pa0, pa1, pa2, pa3); partialSM<DK>(pB0, pB1, m_reg, mnB, alB);
        __syncthreads(); SWRITE(0, E);
        RESC(alB); __syncthreads();
        SBAR(); qkt<DK>(pA0, pA1, K_lds, K2_lds, qr, q2, r32, hi); WMASK(pA0, pA1, j + 1);
        finishSM(pB0, pB1, alB, l_reg, pa0, pa1, pa2, pa3); SBAR();
        if constexpr (SD == 2) { if (j + 3 < NT) SLOAD(E, j + 3); } else SLOAD(E, j + 2);
        SBAR();
        pv_d0<false>(o, vb0 + SHM_V, pa0, pa1, pa2, pa3); partialSM<DK>(pA0, pA1, m_reg, mnA, alA);
        __syncthreads();
        if constexpr (SD == 2) SWRITE(1, O); else SWRITE(1, E);
        RESC(alA); __syncthreads();
    }
    SBAR(); qkt<DK>(pB0, pB1, K_lds + SHM_K, K2_lds + SHM_K2, qr, q2, r32, hi); WMASK(pB0, pB1, NT - 1);
    finishSM(pA0, pA1, alA, l_reg, pa0, pa1, pa2, pa3); SBAR();
    pv_d0<false>(o, vb0, pa0, pa1, pa2, pa3); partialSM<DK>(pB0, pB1, m_reg, mnB, alB);
    __syncthreads(); RESC(alB);
    finishSM(pB0, pB1, alB, l_reg, pa0, pa1, pa2, pa3); SBAR();
    pv_d0<false>(o, vb0 + SHM_V, pa0, pa1, pa2, pa3);
#if ATTN_PRIO
    __builtin_amdgcn_s_setprio(0);
#endif
    if constexpr (SPLIT) {
        float* dmp = U.part_own + (size_t)(wid * 66) * 64 + lane;
#pragma unroll
        for (int d = 0; d < 4; ++d)
#pragma unroll
            for (int r = 0; r < 16; ++r) dmp[(d * 16 + r) * 64] = o[d][r];
        dmp[64 * 64] = m_reg; dmp[65 * 64] = l_reg;
        asm volatile("s_waitcnt vmcnt(0)" ::: "memory"); __syncthreads();
        volatile unsigned* flg = (volatile unsigned*)(lds + OFF_FLG);
        if (tid == 0) {
            __builtin_amdgcn_fence(__ATOMIC_RELEASE, "agent"); asm volatile("s_waitcnt vmcnt(0)" ::: "memory");
            const unsigned old = __hip_atomic_fetch_add(U.cnt, 1u, __ATOMIC_RELAXED, __HIP_MEMORY_SCOPE_AGENT);
            if (old != 0u) { __builtin_amdgcn_fence(__ATOMIC_ACQUIRE, "agent"); asm volatile("s_waitcnt vmcnt(0)" ::: "memory"); }
            flg[0] = old;
        }
        __syncthreads();
        if (flg[0] == 0u) { __syncthreads(); return; }
        const float* oth = U.part_oth + (size_t)(wid * 66) * 64 + lane;
        const float m2 = oth[64 * 64], l2 = oth[65 * 64];
        const float mm = fmaxf(m_reg, m2), w1 = __builtin_amdgcn_exp2f((m_reg - mm) * C), w2 = __builtin_amdgcn_exp2f((m2 - mm) * C);
        l_reg = l_reg * w1 + l2 * w2; m_reg = mm;
        if (hi == 0) { li_l[r32] = w1; al_l[r32] = w2; }
        asm volatile("s_waitcnt lgkmcnt(0)" ::: "memory");
#pragma unroll
        for (int d = 0; d < 4; ++d)
#pragma unroll
            for (int r = 0; r < 16; ++r) o[d][r] = o[d][r] * li_l[crow(r, hi)] + oth[(d * 16 + r) * 64] * al_l[crow(r, hi)];
        asm volatile("s_waitcnt lgkmcnt(0)" ::: "memory");
    }
    l_reg += __builtin_amdgcn_exp2f(U.sink * 1.4426950408889634f - m_reg * C);
    if (hi == 0) li_l[r32] = l_reg; asm volatile("s_waitcnt lgkmcnt(0)" ::: "memory");
    float rli[16];
#pragma unroll
    for (int r = 0; r < 16; ++r) rli[r] = __builtin_amdgcn_rcpf(li_l[crow(r, hi)]);
    __syncthreads();
    bf16_t* stg = (bf16_t*)(lds + wid * 8192);
#pragma unroll
    for (int r = 0; r < 16; ++r) { const int orow = crow(r, hi);
#pragma unroll
        for (int d0 = 0; d0 < 4; ++d0) { const float v = o[d0][r] * rli[r]; stg[orow * 128 + d0 * 32 + r32] = (bf16_t)(cvtpk(v, v) & 0xffffu); } }
    asm volatile("s_waitcnt lgkmcnt(0)" ::: "memory");
    bf16_t* Ow = U.O + (size_t)(wid * QBLK) * U.ldo;
#pragma unroll
    for (int i = 0; i < 8; ++i) { const int row = i * 4 + (lane >> 4), ch = lane & 15; const u32x4 v = *(const u32x4*)(stg + row * 128 + ch * 8); gst16(Ow + (size_t)row * U.ldo + ch * 8, v); }
    __syncthreads();
#undef SLOAD
#undef SWRITE
#undef RESC
#undef WMASK
}
#undef KSWZ
#undef KSWZ2
#undef SBAR
}

#ifndef MERGE_POST
#define MERGE_POST 1
#endif
#ifndef COUNTED_NEXT
#define COUNTED_NEXT 0
#endif
#ifndef MERGE_THIN
#define MERGE_THIN 1
#endif
namespace mk {
constexpr int NWAVES = 8;
constexpr int D = 2048, SEQ = 4096, LCTX = 256, NL = 8192, NC = 512, NR = 8704, DEPTH = 4;
constexpr int DIN = 3392, NIN = 3584  , DFF = 5632;
constexpr int O_AQ = 0, O_AK = 768, O_AV = 1024, O_BQ = 1280, O_BK = 2048, O_BV = 2304, O_CQ = 2560, O_CKV = 3072, O_CKR = 3328;
constexpr float EPS = 1e-6f;
typedef unsigned short bf16;
typedef float f32x4 __attribute__((ext_vector_type(4)));
typedef float f32x2 __attribute__((ext_vector_type(2)));
typedef unsigned u32x4v __attribute__((ext_vector_type(4)));
typedef unsigned u32x2v __attribute__((ext_vector_type(2)));

constexpr size_t MiB = 1u << 20;
constexpr size_t WS_CTL = 0, CTL_ZERO_BYTES = 1 * MiB;
constexpr size_t WS_MODV = 2 * MiB;
constexpr size_t WS_COMB = 3 * MiB;
constexpr size_t WS_TAB128 = 4 * MiB, WS_TAB64 = 4 * MiB + 16384;
constexpr size_t WS_SSQ = 5 * MiB;
constexpr size_t WS_SSQB = 6 * MiB;
constexpr size_t WS_W = 8 * MiB;
constexpr size_t W_IN = 0, W_UQ = W_IN + (size_t)NIN * D * 2, W_UKV = W_UQ + (size_t)768 * 512 * 2, W_OUT = W_UKV + (size_t)1024 * 256 * 2,
                 W_13 = W_OUT + (size_t)D * D * 2, W_2 = W_13 + (size_t)2 * DFF * D * 2, W_LAYER = W_2 + (size_t)D * DFF * 2;
constexpr size_t WS_X = WS_W + DEPTH * W_LAYER;
constexpr size_t WS_H = WS_X + (size_t)NR * D * 4;
constexpr size_t WS_P = WS_H + (size_t)NR * D * 2;
constexpr size_t WS_QC = WS_P + (size_t)NR * NIN * 2;
constexpr size_t WS_KVC = WS_QC + (size_t)NR * 768 * 2;
constexpr size_t WS_CAT = WS_KVC + (size_t)NR * 1024 * 2;
constexpr size_t WS_OF = WS_CAT + (size_t)NR * D * 2;
constexpr size_t WS_U = WS_OF + (size_t)NR * D * 2;
constexpr size_t WS_OFP = WS_U + (size_t)NR * DFF * 2;
#ifndef PROBE_C
#define PROBE_C 0
#endif
#ifndef PROBE_D
#define PROBE_D 0
#endif
#ifndef CONV_CI_A
#define CONV_CI_A 2
#endif
#ifndef CONV_CI_B
#define CONV_CI_B 0
#endif
#ifndef CONV_CF
#define CONV_CF 0
#endif
#ifndef IN_CQ_FIRST
#define IN_CQ_FIRST 0
#endif
constexpr int NP_OUT = 8, NP_F2 = 11;
constexpr size_t WS_PART = WS_OFP + (size_t)NP_F2 * NC * D * 2;
constexpr size_t WS_END = WS_PART + (size_t)64 * 2 * 33792 * 4;
static_assert(W_LAYER % 256 == 0 && WS_X % 256 == 0, "alignment");
constexpr int CW_BAR = 4096;
constexpr int CW_CONVQ = 8192;
constexpr int CW_ATTQ = 8192 + 64;
constexpr int CW_PAN = 40960;
constexpr int CW_SPLIT = 16384;

constexpr int RING_BYTES = 139264  , LDSCTL_OFF = RING_BYTES, MISC_OFF = LDSCTL_OFF + 320, LDS_BYTES = 147456;

#define GAS __attribute__((address_space(1)))
#define LAS __attribute__((address_space(3)))
#define LDS_WAIT() asm volatile("s_waitcnt lgkmcnt(0)" ::: "memory")
#define VM_WAIT() asm volatile("s_waitcnt vmcnt(0)" ::: "memory")
__device__ __forceinline__ unsigned cvtpk(float lo, float hi) { unsigned r; asm volatile("v_cvt_pk_bf16_f32 %0, %1, %2" : "=v"(r) : "v"(lo), "v"(hi)); return r; }
__device__ __forceinline__ float bf_lo(unsigned w) { return __uint_as_float(w << 16); }
__device__ __forceinline__ float bf_hi(unsigned w) { return __uint_as_float(w & 0xffff0000u); }

#define XB_TMO      128
#define XB_XCNT(j)  (256  + 64 * (j))
#define XB_XSUB(j)  (1280 + 64 * (j))
#define XB_XGEN(j)  (2304 + 64 * (j))
#define XB_TOP      3328
#define XB_TOPGEN   3392
#define XCD_BAR_WORDS 3456
#define XB_SPIN_CAP (1u << 18)
__device__ __forceinline__ unsigned xb_ld(unsigned* p)              { return __hip_atomic_load(p, __ATOMIC_RELAXED, __HIP_MEMORY_SCOPE_AGENT); }
__device__ __forceinline__ unsigned xb_add(unsigned* p, unsigned v) { return __hip_atomic_fetch_add(p, v, __ATOMIC_RELAXED, __HIP_MEMORY_SCOPE_AGENT); }
__device__ __forceinline__ unsigned xb_xcc_id() { return (unsigned)__builtin_amdgcn_s_getreg((3 << 11) | 20) & 0xFu; }
#define XB_SPIN(cond, bar) do { unsigned _sp = 0; while (cond) { __builtin_amdgcn_s_sleep(1); \
    if ((++_sp & 255u) == 0u) { if (xb_ld(&(bar)[XB_TMO])) break; if (_sp > XB_SPIN_CAP) { atomicAdd(&(bar)[XB_TMO], 1u); break; } } } } while (0)
struct XcdBarrier { unsigned* bar; unsigned x; volatile LAS unsigned* st; };
__device__ __forceinline__ XcdBarrier xcd_barrier_post(unsigned* bar, volatile LAS unsigned* st) {
    XcdBarrier b; b.bar = bar; b.x = xb_xcc_id(); b.st = st;
    if (threadIdx.x == 0) (void)xb_add(&bar[XB_XCNT(b.x)], 1u);
    return b;
}
__device__ __forceinline__ void xcd_barrier_complete(unsigned* bar, unsigned x, unsigned& nloc, unsigned& nx) {
    const unsigned G = gridDim.x * gridDim.y * gridDim.z;
    unsigned sum, cnt, mine, sp = 0u;
    for (;;) {
        sum = 0u; cnt = 0u; mine = 0u;
#pragma unroll
        for (unsigned j = 0; j < 16; ++j) { const unsigned c = xb_ld(&bar[XB_XCNT(j)]); sum += c; cnt += (c > 0u) ? 1u : 0u; mine = (j == x) ? c : mine; }
        if (sum == G) break;
        __builtin_amdgcn_s_sleep(1);
        if ((++sp & 255u) == 0u) { if (xb_ld(&bar[XB_TMO])) break; if (sp > XB_SPIN_CAP) { atomicAdd(&bar[XB_TMO], 1u); break; } }
    }
    nloc = mine > 0u ? mine : 1u; nx = cnt > 0u ? cnt : 1u;
}
__device__ __forceinline__ void xcd_barrier(const XcdBarrier& b) {
    asm volatile("s_waitcnt vmcnt(0)" ::: "memory");
    __syncthreads();
    if (threadIdx.x == 0) {
        unsigned* bar = b.bar;
        __builtin_amdgcn_s_waitcnt(0);
        unsigned nloc = b.st[0], nx = b.st[1];
        if (nloc == 0u) { xcd_barrier_complete(bar, b.x, nloc, nx); b.st[0] = nloc; b.st[1] = nx; }
        const unsigned old = xb_add(&bar[XB_XSUB(b.x)], 1u);
        const unsigned gen = old / nloc;
        if (old + 1u == (gen + 1u) * nloc) {
            __builtin_amdgcn_fence(__ATOMIC_RELEASE, "agent");
            asm volatile("s_waitcnt vmcnt(0)" ::: "memory");
            const unsigned og = xb_add(&bar[XB_TOP], 1u);
            const unsigned tg = og / nx;
            if (og + 1u == (tg + 1u) * nx) xb_add(&bar[XB_TOPGEN], 1u);
            else XB_SPIN(xb_ld(&bar[XB_TOPGEN]) == tg, bar);
            __builtin_amdgcn_fence(__ATOMIC_ACQUIRE, "agent");
            xb_add(&bar[XB_XGEN(b.x)], 1u);
            asm volatile("s_waitcnt vmcnt(0)" ::: "memory");
        } else {
            XB_SPIN(xb_ld(&bar[XB_XGEN(b.x)]) == gen, bar);
            __builtin_amdgcn_fence(__ATOMIC_ACQUIRE, "agent");
            asm volatile("s_waitcnt vmcnt(0)" ::: "memory");
        }
    }
    __syncthreads();
}

struct Args { const float* in[22]; float* out; unsigned char* ws; int ph_lo, ph_hi; };
enum { I_X = 0, I_C, I_CTX, I_CCTX, I_WMOD, I_BMOD, I_GMIXPRE, I_GMIXPOST, I_GFFNPRE, I_GFFNPOST, I_WIN, I_SINK, I_GQN, I_GKN, I_GCQ, I_WUQ, I_GCKV, I_WUKV, I_WOUT, I_W1, I_W3, I_W2 };

__device__ __forceinline__ float wave_sum(float v) {
#pragma unroll
    for (int o = 1; o < 64; o <<= 1) v += __shfl_xor(v, o);
    return v;
}
__device__ __forceinline__ int row_s(int r) { return r < NL ? (r >> 12) : 2; }

__device__ __forceinline__ void transpose_item(const float* W, int N, int k0, int n0, bf16* WTrow0, int ldt, const float* kgain, LAS float* scr, int lane, bool permute = false) {
    f32x4 v[16];
    const float* src = W + (size_t)(k0 + (lane >> 4)) * N + n0 + 4 * (lane & 15);
#pragma unroll
    for (int i = 0; i < 16; ++i) v[i] = *(const f32x4*)(src + (size_t)(4 * i) * N);
#pragma unroll
    for (int i = 0; i < 16; ++i) { const int kk = 4 * i + (lane >> 4); const float g = kgain ? kgain[k0 + kk] : 1.f; LAS float* d = scr + kk * 65 + 4 * (lane & 15);
        d[0] = v[i][0] * g; d[1] = v[i][1] * g; d[2] = v[i][2] * g; d[3] = v[i][3] * g; }
    LDS_WAIT(); asm volatile("" ::: "memory");
    const int c = lane & 7;
#pragma unroll
    for (int j = 0; j < 8; ++j) { const int n = (lane >> 3) + 8 * j; const LAS float* s = scr + (8 * c) * 65 + n;
        u32x4v o; o.x = cvtpk(s[0 * 65], s[1 * 65]); o.y = cvtpk(s[2 * 65], s[3 * 65]); o.z = cvtpk(s[4 * 65], s[5 * 65]); o.w = cvtpk(s[6 * 65], s[7 * 65]);
        gst16(WTrow0 + (size_t)(permute ? pg8::perm64(n) : n) * ldt + k0 + 8 * c, o); }
    LDS_WAIT(); asm volatile("" ::: "memory");
}
constexpr int IT_IN = (D / 64) * (DIN / 64), IT_UQ = (512 / 64) * (768 / 64), IT_UKV = (256 / 64) * (1024 / 64), IT_OUT = (D / 64) * (D / 64), IT_1 = (D / 64) * (DFF / 64), IT_2 = (DFF / 64) * (D / 64);
constexpr int IT_LAYER = IT_IN + IT_UQ + IT_UKV + IT_OUT + 2 * IT_1 + IT_2, IT_ALL = DEPTH * IT_LAYER, CONV_CHUNKS = (IT_LAYER + 47) / 48;
static_assert(CONV_CHUNKS == 236, "the attention queue's entry map is written for 236 conversion chunks");
constexpr int NA_CONV = CONV_CHUNKS - 18 * (CONV_CI_A + CONV_CI_B) - 40 * CONV_CF;
static_assert(NA_CONV >= 0, "more idle-slot chunks than chunks");
__device__ __forceinline__ void conv_item(const Args& a, int it, LAS float* scr, int lane) {
    const int l = it / IT_LAYER; int r = it % IT_LAYER;
    unsigned char* wl = a.ws + WS_W + (size_t)l * W_LAYER;
    if (r < IT_IN)  { const int nb = DIN / 64, kb = r / nb, n0 = (r % nb) * 64; const bool pm_ = (ROPE_EPI_A && n0 < O_AV) || (ROPE_EPI_B && n0 >= O_BQ && n0 < O_BV);
        transpose_item(a.in[I_WIN] + (size_t)l * D * DIN, DIN, kb * 64, n0, (bf16*)(wl + W_IN) + (size_t)n0 * D, D, nullptr, scr, lane, pm_); return; } r -= IT_IN;
    if (r < IT_UQ)  { const int nb = 768 / 64, kb = r / nb, n0 = (r % nb) * 64; transpose_item(a.in[I_WUQ] + (size_t)l * 512 * 768, 768, kb * 64, n0, (bf16*)(wl + W_UQ) + (size_t)n0 * 512, 512, a.in[I_GCQ] + l * 512, scr, lane); return; } r -= IT_UQ;
    if (r < IT_UKV) { const int nb = 1024 / 64, kb = r / nb, n0 = (r % nb) * 64; transpose_item(a.in[I_WUKV] + (size_t)l * 256 * 1024, 1024, kb * 64, n0, (bf16*)(wl + W_UKV) + (size_t)n0 * 256, 256, a.in[I_GCKV] + l * 256, scr, lane); return; } r -= IT_UKV;
    if (r < IT_OUT) { const int nb = D / 64, kb = r / nb, n0 = (r % nb) * 64; transpose_item(a.in[I_WOUT] + (size_t)l * D * D, D, kb * 64, n0, (bf16*)(wl + W_OUT) + (size_t)n0 * D, D, nullptr, scr, lane); return; } r -= IT_OUT;
    if (r < 2 * IT_1) { const int which = r / IT_1; r %= IT_1; const int nb = DFF / 64, kb = r / nb, n0 = (r % nb) * 64;
        const int drow = (n0 / 128) * 256 + which * 128 + (n0 % 128);
        transpose_item(a.in[which ? I_W3 : I_W1] + (size_t)l * D * DFF, DFF, kb * 64, n0, (bf16*)(wl + W_13) + (size_t)drow * D, D, nullptr, scr, lane); return; } r -= 2 * IT_1;
    { const int nb = D / 64, kb = r / nb, n0 = (r % nb) * 64; transpose_item(a.in[I_W2] + (size_t)l * DFF * D, D, kb * 64, n0, (bf16*)(wl + W_2) + (size_t)n0 * DFF, DFF, nullptr, scr, lane); }
}
__device__ __forceinline__ void mod_unit(const Args& a, int u, LAS unsigned char* lds, int tid, int wave, int lane) {
    const int l = u / 48, nc = u % 48;
    LAS float* sc = (LAS float*)lds;
    LAS float* red = (LAS float*)(lds + 24576);
    for (int i = tid; i < 3 * D; i += NWAVES * 64) { const int s = i / D, k = i % D; const float v = s < 2 ? a.in[I_C][s * D + k] : a.in[I_CCTX][k]; sc[i] = v / (1.f + expf(-v)); }
    LDS_WAIT(); __syncthreads();
    const float* w = a.in[I_WMOD] + (size_t)l * D * 6 * D + (size_t)(wave * 256) * 6 * D + nc * 256 + lane * 4;
    f32x4 a0 = {0.f, 0.f, 0.f, 0.f}, a1 = a0, a2 = a0;
    for (int k = 0; k < 256; k += 8) {
        f32x4 wv[8];
#pragma unroll
        for (int j = 0; j < 8; ++j) wv[j] = *(const f32x4*)(w + (size_t)(k + j) * 6 * D);
#pragma unroll
        for (int j = 0; j < 8; ++j) { const int kk = wave * 256 + k + j; a0 += wv[j] * sc[kk]; a1 += wv[j] * sc[D + kk]; a2 += wv[j] * sc[2 * D + kk]; }
    }
    *(LAS f32x4*)(red + (wave * 3 + 0) * 256 + lane * 4) = a0; *(LAS f32x4*)(red + (wave * 3 + 1) * 256 + lane * 4) = a1; *(LAS f32x4*)(red + (wave * 3 + 2) * 256 + lane * 4) = a2;
    LDS_WAIT(); __syncthreads();
    for (int i = tid; i < 768; i += NWAVES * 64) { const int s = i >> 8, cidx = i & 255; float v = 0.f;
#pragma unroll
        for (int wv = 0; wv < 8; ++wv) v += red[(wv * 3 + s) * 256 + cidx];
        ((float*)(a.ws + WS_MODV))[(size_t)(l * 3 + s) * 6 * D + nc * 256 + cidx] = v + a.in[I_BMOD][l * 6 * D + nc * 256 + cidx]; }
    LDS_WAIT(); __syncthreads();
}

struct RowF { f32x4 v[8]; };
__device__ __forceinline__ void ld_row_f32(RowF& r, const float* p, int lane) {
#pragma unroll
    for (int j = 0; j < 8; ++j) r.v[j] = *(const f32x4*)(p + 4 * lane + 256 * j);
}
__device__ __forceinline__ void ld_row_bf16(RowF& r, const bf16* p, int lane) {
#pragma unroll
    for (int j = 0; j < 8; ++j) { const u32x2v w = *(const u32x2v*)(p + 4 * lane + 256 * j); r.v[j] = (f32x4){bf_lo(w.x), bf_hi(w.x), bf_lo(w.y), bf_hi(w.y)}; }
}
typedef _Float16 f16x4 __attribute__((ext_vector_type(4)));
__device__ __forceinline__ void ld_row_f16(RowF& r, const _Float16* p, int lane) {
#pragma unroll
    for (int j = 0; j < 8; ++j) { const f16x4 w = *(const f16x4*)(p + 4 * lane + 256 * j); r.v[j] = (f32x4){(float)w[0], (float)w[1], (float)w[2], (float)w[3]}; }
}
__device__ __forceinline__ void st_row_f16(_Float16* p, const RowF& r, int lane) {
#pragma unroll
    for (int j = 0; j < 8; ++j) { f16x4 w = {(_Float16)r.v[j][0], (_Float16)r.v[j][1], (_Float16)r.v[j][2], (_Float16)r.v[j][3]}; gst8(p + 4 * lane + 256 * j, __builtin_bit_cast(wt_u32x2, w)); }
}
__device__ __forceinline__ float row_ssq(const RowF& r) {
    float s = 0.f;
#pragma unroll
    for (int j = 0; j < 8; ++j) s += (r.v[j][0] * r.v[j][0] + r.v[j][1] * r.v[j][1]) + (r.v[j][2] * r.v[j][2] + r.v[j][3] * r.v[j][3]);
    return wave_sum(s);
}
__device__ __forceinline__ void st_row_bf16(bf16* p, const RowF& r, int lane) {
#pragma unroll
    for (int j = 0; j < 8; ++j) { u32x2v w; w.x = cvtpk(r.v[j][0], r.v[j][1]); w.y = cvtpk(r.v[j][2], r.v[j][3]); gst8(p + 4 * lane + 256 * j, w); }
}
__device__ __forceinline__ void st_row_f32(float* p, const RowF& r, int lane) {
#pragma unroll
    for (int j = 0; j < 8; ++j) gst16(p + 4 * lane + 256 * j, __builtin_bit_cast(wt_u32x4, r.v[j]));
}
__device__ __forceinline__ const float* comb_vec(const Args& a, int l, int s, int q) { return (const float*)(a.ws + WS_COMB) + ((size_t)(l * 3 + s) * 6 + q) * D; }

__device__ __forceinline__ void resid_norm_row(const float* xin32, const _Float16* xin16, float* xout32, _Float16* xout16, const bf16* y, const float* G, const float* A, const float* Bv, bf16* h, int lane, float oscale = 1.f, int nparts = 1, size_t pstride = 0) {
    RowF x, t; if (xin32) ld_row_f32(x, xin32, lane); else ld_row_f16(x, xin16, lane);
    ld_row_bf16(t, y, lane);
    for (int p = 1; p < nparts; ++p) { RowF t2; ld_row_bf16(t2, y + (size_t)p * pstride, lane);
#pragma unroll
        for (int j = 0; j < 8; ++j) t.v[j] += t2.v[j]; }
    const float rstd_y = rsqrtf(row_ssq(t) * (1.f / D) + EPS);
    RowF g; ld_row_f32(g, G, lane);
#pragma unroll
    for (int j = 0; j < 8; ++j) x.v[j] += g.v[j] * (t.v[j] * rstd_y);
#if defined(PROBE_A)
#pragma unroll
    for (int j = 0; j < 8; ++j) x.v[j] *= oscale;
#endif
    if (xout32) st_row_f32(xout32, x, lane); else st_row_f16(xout16, x, lane);
    if (h) {
        const float rstd_x = rsqrtf(row_ssq(x) * (1.f / D) + EPS);
        ld_row_f32(g, A, lane); ld_row_f32(t, Bv, lane);
#pragma unroll
        for (int j = 0; j < 8; ++j) x.v[j] = (x.v[j] * rstd_x) * g.v[j] + t.v[j];
        if (MERGE_THIN) { _Pragma("unroll") for (int j = 0; j < 8; ++j) { u32x2v w; w.x = cvtpk(x.v[j][0], x.v[j][1]); w.y = cvtpk(x.v[j][2], x.v[j][3]); gst8_wt(h + 4 * lane + 256 * j, w); } }
        else st_row_bf16(h, x, lane);
    }
}

__device__ __forceinline__ void resid_norm_row2(const float* xin32, const _Float16* xin16, float* xout32, _Float16* xout16, const bf16* y, const float* G, const float* A, const float* Bv, bf16* h, int lane) {
    RowF x0, x1, t0, t1;
    if (xin32) { ld_row_f32(x0, xin32, lane); ld_row_f32(x1, xin32 + D, lane); } else { ld_row_f16(x0, xin16, lane); ld_row_f16(x1, xin16 + D, lane); }
    ld_row_bf16(t0, y, lane); ld_row_bf16(t1, y + D, lane);
    RowF g; ld_row_f32(g, G, lane);
    const float ry0 = rsqrtf(row_ssq(t0) * (1.f / D) + EPS), ry1 = rsqrtf(row_ssq(t1) * (1.f / D) + EPS);
#pragma unroll
    for (int j = 0; j < 8; ++j) { x0.v[j] += g.v[j] * (t0.v[j] * ry0); x1.v[j] += g.v[j] * (t1.v[j] * ry1); }
    if (xout32) { st_row_f32(xout32, x0, lane); st_row_f32(xout32 + D, x1, lane); } else { st_row_f16(xout16, x0, lane); st_row_f16(xout16 + D, x1, lane); }
    if (h) {
        ld_row_f32(g, A, lane); ld_row_f32(t0, Bv, lane);
        const float rx0 = rsqrtf(row_ssq(x0) * (1.f / D) + EPS), rx1 = rsqrtf(row_ssq(x1) * (1.f / D) + EPS);
#pragma unroll
        for (int j = 0; j < 8; ++j) { x0.v[j] = (x0.v[j] * rx0) * g.v[j] + t0.v[j]; x1.v[j] = (x1.v[j] * rx1) * g.v[j] + t0.v[j]; }
#pragma unroll
        for (int j = 0; j < 8; ++j) { u32x2v w; w.x = cvtpk(x0.v[j][0], x0.v[j][1]); w.y = cvtpk(x0.v[j][2], x0.v[j][3]); gst8_wt(h + 4 * lane + 256 * j, w);
            w.x = cvtpk(x1.v[j][0], x1.v[j][1]); w.y = cvtpk(x1.v[j][2], x1.v[j][3]); gst8_wt(h + D + 4 * lane + 256 * j, w); }
    }
}

__device__ __forceinline__ void post_row(bf16* prow_, int r, const float* tab128, const float* tab64, const float* ssqb, const f32x4 gq, const f32x4 gk, int lane) {
    const bool lat = r < NL; const int t = r & 4095, pr = t >> 6, pc = t & 63;
    const int hl = lane & 31, half = hl >> 4, q = hl & 15, i0 = 4 * (q & 7);
    const int pos = half ? pc : pr;
    f32x4 cs = {1.f, 1.f, 1.f, 1.f}, sn = {0.f, 0.f, 0.f, 0.f};
    if (lat && (!ROPE_EPI_A || !ROPE_EPI_B)) { const f32x4 t0 = *(const f32x4*)(tab128 + (size_t)(pos * 32 + i0) * 2), t1 = *(const f32x4*)(tab128 + (size_t)(pos * 32 + i0) * 2 + 4);
        cs = (f32x4){t0[0], t0[2], t1[0], t1[2]}; sn = (f32x4){t0[1], t0[3], t1[1], t1[3]}; }
    const bool first = q < 8;
#pragma unroll
    for (int sgi = 0; sgi < 8; ++sgi) {
        const bool isB = sgi >= 4;
        if (!isB && ROPE_EPI_A) continue;
        const int col = sgi < 3 ? O_AQ + 256 * sgi : sgi == 3 ? O_AK : sgi < 7 ? O_BQ + 256 * (sgi - 4) : O_BK;
        const f32x4 gg = sgi == 7 ? gk : gq;
        bf16* p = prow_ + col + 4 * lane;
        const u32x2v w = *(const u32x2v*)p;
        f32x4 v = {bf_lo(w.x), bf_hi(w.x), bf_lo(w.y), bf_hi(w.y)};
        if (isB && ROPE_EPI_B) {
            const f32x4 sq = *(const f32x4*)(ssqb + (size_t)r * 32 + ((sgi - 4) * 2 + (lane >> 5)) * 4);
            v = v * rsqrtf(((sq[0] + sq[1]) + (sq[2] + sq[3])) * (1.f / 128.f) + EPS);
            u32x2v ow; ow.x = cvtpk(v[0], v[1]); ow.y = cvtpk(v[2], v[3]); gst8(p, ow); continue; }
        if (isB) { float ss = (v[0] * v[0] + v[1] * v[1]) + (v[2] * v[2] + v[3] * v[3]);
            ss += __shfl_xor(ss, 1); ss += __shfl_xor(ss, 2); ss += __shfl_xor(ss, 4); ss += __shfl_xor(ss, 8); ss += __shfl_xor(ss, 16);
            v = v * rsqrtf(ss * (1.f / 128.f) + EPS) * gg; }
        f32x4 pv; pv[0] = __shfl_xor(v[0], 8); pv[1] = __shfl_xor(v[1], 8); pv[2] = __shfl_xor(v[2], 8); pv[3] = __shfl_xor(v[3], 8);
        const f32x4 o = first ? v * cs - pv * sn : v * cs + pv * sn;
        u32x2v ow; ow.x = cvtpk(o[0], o[1]); ow.y = cvtpk(o[2], o[3]);
        if (lat || isB) gst8(p, ow);
    }
    if (lat && !ROPE_EPI_R) {
        const int l16 = lane & 15, h2 = l16 >> 3, q2 = l16 & 7, j0 = 4 * (q2 & 3); const int pos2 = h2 ? pc : pr;
        const f32x4 t0 = *(const f32x4*)(tab64 + (size_t)(pos2 * 16 + j0) * 2), t1 = *(const f32x4*)(tab64 + (size_t)(pos2 * 16 + j0) * 2 + 4);
        const f32x4 c2 = {t0[0], t0[2], t1[0], t1[2]}, s2 = {t0[1], t0[3], t1[1], t1[3]};
        bf16* p = prow_ + O_CKR + 4 * l16;
        const u32x2v w = *(const u32x2v*)p;
        const f32x4 v = {bf_lo(w.x), bf_hi(w.x), bf_lo(w.y), bf_hi(w.y)};
        f32x4 pv; pv[0] = __shfl_xor(v[0], 4); pv[1] = __shfl_xor(v[1], 4); pv[2] = __shfl_xor(v[2], 4); pv[3] = __shfl_xor(v[3], 4);
        const f32x4 o = (q2 < 4) ? v * c2 - pv * s2 : v * c2 + pv * s2;
        u32x2v ow; ow.x = cvtpk(o[0], o[1]); ow.y = cvtpk(o[2], o[3]);
        if (lane < 16) gst8(p, ow);
    }
}

constexpr int AI_C = 128, AI_BW = 128, AI_BH = 128, AI_A = 192, AI_LAT = AI_C + AI_BW + AI_BH + AI_A, AI_CC = 8, AI_BC = 12, AI_AC = 12, AI_ALL = AI_LAT + AI_CC + AI_BC + AI_AC;
static_assert(at::DUMP_FLOATS == 33792, "WS_PART sizing");
__device__ __forceinline__ at::AUnit attn_item_unit(int it, int& body, const Args& a, const float* sink, int layer) {
    const bf16* P = (const bf16*)(a.ws + WS_P); const bf16* QC = (const bf16*)(a.ws + WS_QC); const bf16* KVC = (const bf16*)(a.ws + WS_KVC); bf16* CAT = (bf16*)(a.ws + WS_CAT);
    const int seg = it < AI_C ? 0 : it < AI_C + AI_BW ? 1 : it < AI_C + AI_BW + AI_BH ? 2 : it < AI_LAT ? 3 : it < AI_LAT + AI_CC ? 4 : it < AI_LAT + AI_CC + AI_BC ? 5 : 6;
    const int j0 = it - (seg == 0 ? 0 : seg == 1 ? AI_C : seg == 2 ? AI_C + AI_BW : seg == 3 ? AI_C + AI_BW + AI_BH : seg == 4 ? AI_LAT : seg == 5 ? AI_LAT + AI_CC : AI_LAT + AI_CC + AI_BC);
    const bool split = seg == 2; const int half = j0 & 1, sidx = j0 >> 1;
    const int j = split ? AI_BW + sidx : j0;
    const int kind = (seg == 0 || seg == 4) ? 2 : (seg == 1 || seg == 2 || seg == 5) ? 1 : 0; const bool cq = seg >= 4;
    const int nh = kind == 2 ? 4 : 6;
    const int b = cq ? j / nh : j / (16 * nh), h = cq ? j % nh : (j / 16) % nh, qb = cq ? 0 : (j & 15);
    const long qrow = cq ? (long)(NL + b * LCTX) : (long)(b * SEQ + qb * 256), crow0 = (long)(NL + b * LCTX), lrow0 = (long)b * SEQ;
    const bool win = kind == 0 && !cq;
    int wlo = qb * 256 - 128, whi = qb * 256 + 384; wlo = wlo < 0 ? 0 : wlo; whi = whi > SEQ ? SEQ : whi;
    const long llo = win ? (long)wlo : (split && half) ? 30 * 64 : 0;
    const int g = h / 3, oq = kind == 0 ? O_AQ : O_BQ, ok = kind == 0 ? O_AK : O_BK, ov = kind == 0 ? O_AV : O_BV;
    at::AUnit U;
    U.Q = kind == 2 ? QC + qrow * 768 + h * 192 : P + qrow * NIN + oq + h * 128; U.ldq = kind == 2 ? 768 : NIN;
    U.KV = kind == 2 ? KVC : P; U.K2 = P;
    U.ldk = kind == 2 ? 1024 : NIN; U.ldv = U.ldk; U.ldk2 = NIN; U.ldo = D;
    U.kc = kind == 2 ? crow0 * 1024 + h * 256 : crow0 * NIN + ok + g * 128;
    U.kl = kind == 2 ? lrow0 * 1024 + h * 256 : (lrow0 + llo) * NIN + ok + g * 128;
    U.vc = kind == 2 ? U.kc + 128 : crow0 * NIN + ov + g * 128;
    U.vl = kind == 2 ? U.kl + 128 : (lrow0 + llo) * NIN + ov + g * 128;
    U.k2c = crow0 * NIN + O_CKR; U.k2l = lrow0 * NIN + O_CKR;
    U.O = CAT + qrow * D + (kind == 0 ? 0 : kind == 1 ? 768 : 1536) + h * 128;
    U.nct = (split && half) ? 0 : 4;
    U.ntl = cq ? 0 : win ? (whi - wlo) / 64 : split ? (half ? 34 : 30) : SEQ / 64;
    U.qk_off = win ? wlo - qb * 256 : 0;
    U.sink = kind == 0 ? sink[h] : -__builtin_inff();
    float* part = (float*)(a.ws + WS_PART) + (size_t)(sidx * 2) * at::DUMP_FLOATS;
    U.part_own = part + (size_t)half * at::DUMP_FLOATS; U.part_oth = part + (size_t)(half ^ 1) * at::DUMP_FLOATS;
    U.cnt = (unsigned*)(a.ws + WS_CTL) + CW_SPLIT + 64 * (64 * layer + sidx);
    body = kind == 2 ? 2 : win ? 1 : split ? 3 : 0;
    return U;
}

__device__ __forceinline__ unsigned* pan_word(unsigned* ctl, int layer, int which, int panel) { return ctl + CW_PAN + 64 * ((5 * layer + which) * 40 + panel); }
__device__ __forceinline__ void pan_wait(unsigned* c0, unsigned need0, unsigned* c1, unsigned need1, unsigned* tmo) {
    if (threadIdx.x == 0) {
        unsigned sp = 0;
        for (;;) {
            const bool ok = __hip_atomic_load(c0, __ATOMIC_RELAXED, __HIP_MEMORY_SCOPE_AGENT) >= need0 && (c1 == nullptr || __hip_atomic_load(c1, __ATOMIC_RELAXED, __HIP_MEMORY_SCOPE_AGENT) >= need1);
            if (ok) break;
            __builtin_amdgcn_s_sleep(2);
            if ((++sp & 255u) == 0u) { if (__hip_atomic_load(tmo, __ATOMIC_RELAXED, __HIP_MEMORY_SCOPE_AGENT)) break; if (sp > (1u << 18)) { atomicAdd(tmo, 1u); break; } }
        }
        __builtin_amdgcn_fence(__ATOMIC_ACQUIRE, "agent");
        asm volatile("s_waitcnt vmcnt(0)" ::: "memory");
    }
    __syncthreads();
}

constexpr int N_PHASES = 2 + 8 * DEPTH;
#ifndef PHMASK
#define PHMASK 0x3ff
#endif
#define PHON(j) ((PHMASK >> (j)) & 1)
#ifndef SUBSEL
#define SUBSEL 7
#endif
__global__ void __launch_bounds__(NWAVES * 64, 2) fwd(Args args) {
    extern __shared__ __attribute__((aligned(16))) unsigned char lds[];
    LAS unsigned char* L = (LAS unsigned char*)lds;
    volatile LAS unsigned* MISC = (volatile LAS unsigned*)(L + MISC_OFF);
    const int tid = threadIdx.x, lane = tid & 63, wave = __builtin_amdgcn_readfirstlane(tid >> 6);
    const int G = gridDim.x, bx = blockIdx.x, vcu = (G % 8 == 0) ? (bx % 8) * (G / 8) + bx / 8 : bx;
    const int gw = vcu * NWAVES + wave, NGW = G * NWAVES;
    unsigned* ctl = (unsigned*)(args.ws + WS_CTL);
    for (int u = tid; u < (LDS_BYTES - LDSCTL_OFF) / 4; u += NWAVES * 64) ((LAS unsigned*)(L + LDSCTL_OFF))[u] = 0u;
    __syncthreads();
    const int lo = args.ph_lo, hi = args.ph_hi;
    const bool multi = hi - lo > 1;
    XcdBarrier bar; bar.bar = ctl + CW_BAR; bar.x = 0; bar.st = nullptr;
    if (multi) bar = xcd_barrier_post(ctl + CW_BAR, MISC + 8);
#if defined(PROBE_BX)
#define XSTAMP(k) do { if (l == 1 && bx == PROBE_BX && tid == 0) { VM_WAIT(); ((volatile LAS unsigned long long*)(L + LDSCTL_OFF + 2048))[(k)] = __builtin_amdgcn_s_memrealtime(); } } while (0)
#else
#define XSTAMP(k) do { } while (0)
#endif
#define CONV_CHUNK(cv_) do { int t_ = threadIdx.x; asm volatile("" : "+v"(t_)); const int cl_ = t_ & 63, cw_ = __builtin_amdgcn_readfirstlane(t_ >> 6); LAS float* cs_ = (LAS float*)(L + cw_ * 17408); \
        for (int k_ = 0; k_ < 6; ++k_) { const int ci_ = (cv_) * 48 + cw_ * 6 + k_; if (ci_ < IT_LAYER) conv_item(args, (l + 1) * IT_LAYER + ci_, cs_, cl_); } } while (0)
#define IN(k) (lo <= (k) && (k) < hi)
#if defined(PROBE_A)
    volatile LAS unsigned long long* STP = (volatile LAS unsigned long long*)(L + LDSCTL_OFF);
#define STAMP(k) do { if (threadIdx.x == 0 && ((PROBE_A != 95 && PROBE_A != 94) || (k) == 10 || (k) == 18 || (k) == PROBE_C || (k) == PROBE_C + 1)) ((volatile LAS unsigned long long*)(L + LDSCTL_OFF))[(k)] = __builtin_amdgcn_s_memrealtime(); } while (0)
#else
#define STAMP(k) do { } while (0)
#endif
    STAMP(0);
#define SEAM(k) do { if (IN(k) && IN((k) + 1)) xcd_barrier(bar); STAMP((k) + 1); } while (0)
#define WS_PTRS unsigned char* ws = args.ws; asm volatile("" : "+s"(ws)); \
    _Float16* X = (_Float16*)(ws + WS_X); bf16* H = (bf16*)(ws + WS_H); bf16* P = (bf16*)(ws + WS_P); bf16* QC = (bf16*)(ws + WS_QC); bf16* KVC = (bf16*)(ws + WS_KVC); \
    bf16* CAT = (bf16*)(ws + WS_CAT); bf16* OFP = (bf16*)(ws + WS_OFP); bf16* OF = (bf16*)(ws + WS_OF); bf16* U = (bf16*)(ws + WS_U); float* SSQ = (float*)(ws + WS_SSQ); float* SSQB = (float*)(ws + WS_SSQB); \
    const float* tab128 = (const float*)(ws + WS_TAB128); const float* tab64 = (const float*)(ws + WS_TAB64); \
    (void)X; (void)H; (void)P; (void)QC; (void)KVC; (void)CAT; (void)OFP; (void)OF; (void)U; (void)SSQ; (void)SSQB; (void)tab128; (void)tab64;

    if (PHON(0) && IN(0)) {
        WS_PTRS
        { const int gid = bx * NWAVES * 64 + tid;
          if (gid < 64 * 32) { const int pos = gid >> 5, i = gid & 31; const float ang = (float)pos * powf(10000.f, -(float)i / 32.f); ((float*)(ws + WS_TAB128))[2 * gid] = cosf(ang); ((float*)(ws + WS_TAB128))[2 * gid + 1] = sinf(ang); }
          else if (gid < 64 * 32 + 64 * 16) { const int e = gid - 64 * 32, pos = e >> 4, i = e & 15; const float ang = (float)pos * powf(10000.f, -(float)i / 16.f); ((float*)(ws + WS_TAB64))[2 * e] = cosf(ang); ((float*)(ws + WS_TAB64))[2 * e + 1] = sinf(ang); } }
        for (int i = gw * 64 + lane; i < DEPTH * (NIN - DIN) * D / 8; i += NGW * 64) { const int l = i / ((NIN - DIN) * D / 8), e = i % ((NIN - DIN) * D / 8);
            *(u32x4v*)((bf16*)(ws + WS_W + (size_t)l * W_LAYER + W_IN) + (size_t)DIN * D + (size_t)e * 8) = (u32x4v){0u, 0u, 0u, 0u}; }
        for (int u = bx; u < 192; u += G) mod_unit(args, u, L, tid, wave, lane);
        LAS float* scr = (LAS float*)(L + wave * 17408);
        for (;;) {
            int base = 0; if (lane == 0) base = (int)atomicAdd(ctl + CW_CONVQ, 8u);
            base = __builtin_amdgcn_readfirstlane(base);
            if (base >= IT_LAYER) break;
            for (int it = base; it < base + 8 && it < IT_LAYER; ++it) conv_item(args, it, scr, lane);
        }
    }
    SEAM(0);
    if (PHON(1) && IN(1)) {
        WS_PTRS
        const float* modv = (const float*)(ws + WS_MODV); float* comb = (float*)(ws + WS_COMB);
        for (int i = bx * NWAVES * 64 + tid; i < DEPTH * 3 * D; i += G * NWAVES * 64) { const int l = i / (3 * D), s = (i / D) % 3, c = i % D;
            const float* m = modv + (size_t)(l * 3 + s) * 6 * D; float* o = comb + (size_t)(l * 3 + s) * 6 * D + c;
            o[0 * D] = m[2 * D + c] * args.in[I_GMIXPOST][l * D + c]; o[1 * D] = args.in[I_GFFNPRE][l * D + c] * (1.f + m[4 * D + c]); o[2 * D] = m[3 * D + c];
            o[3 * D] = m[5 * D + c] * args.in[I_GFFNPOST][l * D + c]; o[4 * D] = args.in[I_GMIXPRE][l * D + c] * (1.f + m[1 * D + c]); o[5 * D] = m[0 * D + c]; }
        for (int r = gw; r < NR; r += NGW) { const int s = row_s(r);
            const float* xin = r < NL ? args.in[I_X] + (size_t)r * D : args.in[I_CTX] + (size_t)(r - NL) * D;
            RowF x; ld_row_f32(x, xin, lane);
            const float rstd = rsqrtf(row_ssq(x) * (1.f / D) + EPS);
            const float* m = modv + (size_t)s * 6 * D;
            RowF g, sc, sh; ld_row_f32(g, args.in[I_GMIXPRE], lane); ld_row_f32(sc, m + D, lane); ld_row_f32(sh, m, lane);
#pragma unroll
            for (int j = 0; j < 8; ++j) x.v[j] = (x.v[j] * rstd) * g.v[j] * (1.f + sc.v[j]) + sh.v[j];
            st_row_bf16(H + (size_t)r * D, x, lane); }
    }
    SEAM(1);
    for (int l = 0; l < DEPTH; ++l) {
        const int pb = 2 + 8 * l; const bool last = l == DEPTH - 1;
        int bx_ = blockIdx.x; asm volatile("" : "+s"(bx_)); const int bx = bx_;
        const unsigned char* wl = args.ws + WS_W + (size_t)l * W_LAYER;
        const int Mrows = last ? NL : NR;
        if (PHON(2) && IN(pb + 0)) {
            WS_PTRS
            pg8::Gemm g{H, (const bf16*)(wl + W_IN), NR, NIN, D, D};
#if IN_CQ_FIRST
            pg8::InOrder S; S.init(NR, G, bx); S.pan = pan_word(ctl, l, 4, 0);
#else
            pg8::CountedStatic S; S.init(NR, NIN, G, bx);
            S.ready = (MERGE_THIN && COUNTED_NEXT && l > 0) ? pan_word(ctl, l - 1, 3, 0) : nullptr; S.need_lat = 8u; S.need_ctx = 16u * NP_F2; S.tmo = ctl;
#endif
            pg8::EpiIn E{P, NIN, SSQ, SSQB, tab128, tab64, args.in[I_GQN] + l * 128, args.in[I_GKN] + l * 128, (PG8_LAS float*)(L + 131072), MERGE_POST != 0};
            XSTAMP(20);
#if IN_CQ_FIRST
            pg8::gemm_phase<pg8::EpiIn, pg8::InOrder, true>(L, g, S, E);
#else
            pg8::gemm_phase<pg8::EpiIn, pg8::CountedStatic, true>(L, g, S, E);
#endif
            XSTAMP(21);
#if MERGE_POST
#if IN_CQ_FIRST
            { pg8::OffsetOrder S2; S2.init(NR, 768, bx, 0);
              if (S2.has()) { pan_wait(pan_word(ctl, l, 4, S2.L / S2.nN), 3u, nullptr, 0u, ctl); XSTAMP(22);
                  pg8::Gemm g2{P + O_CQ, (const bf16*)(wl + W_UQ), NR, 768, 512, NIN}; pg8::EpiUq E2{QC, SSQ, tab64}; pg8::gemm_phase<pg8::EpiUq, pg8::OffsetOrder, false>(L, g2, S2, E2); } }
            { pg8::OffsetOrder S2; S2.init(NR, 1024, bx, 102);
              if (S2.has()) { pan_wait(pan_word(ctl, l, 4, S2.L / S2.nN), 3u, nullptr, 0u, ctl); XSTAMP(22);
                  pg8::Gemm g2{P + O_CKV, (const bf16*)(wl + W_UKV), NR, 1024, 256, NIN}; pg8::EpiUkv E2{KVC, SSQ}; pg8::gemm_phase<pg8::EpiUkv, pg8::OffsetOrder, false>(L, g2, S2, E2); } }
#else
            { pg8::Unit u{0, 0, 0, 0, 0};
              if (tid == 0) for (int i = 0; S.next(i, u); ++i) if (u.pn >= 10 && u.pn <= 12) __hip_atomic_fetch_add(pan_word(ctl, l, 4, u.pm), 1u, __ATOMIC_RELAXED, __HIP_MEMORY_SCOPE_AGENT); }
            const int bxo = bx;
            { pg8::OffsetOrder S2; S2.init(NR, 768, bxo, 0);
              if (S2.has()) { pan_wait(pan_word(ctl, l, 4, S2.L / S2.nN), 3u, nullptr, 0u, ctl); XSTAMP(22);
                  pg8::Gemm g2{P + O_CQ, (const bf16*)(wl + W_UQ), NR, 768, 512, NIN}; pg8::EpiUq E2{QC, SSQ, tab64}; pg8::gemm_phase<pg8::EpiUq, pg8::OffsetOrder, false>(L, g2, S2, E2); } }
            { pg8::OffsetOrder S2; S2.init(NR, 1024, bxo, 102);
              if (S2.has()) { pan_wait(pan_word(ctl, l, 4, S2.L / S2.nN), 3u, nullptr, 0u, ctl); XSTAMP(22);
                  pg8::Gemm g2{P + O_CKV, (const bf16*)(wl + W_UKV), NR, 1024, 256, NIN}; pg8::EpiUkv E2{KVC, SSQ}; pg8::gemm_phase<pg8::EpiUkv, pg8::OffsetOrder, false>(L, g2, S2, E2); } }
#endif
#endif
            XSTAMP(24);
            if (!last && bx >= 220) {
                const int nck = bx >= 238 ? CONV_CI_A : CONV_CI_B, cb = NA_CONV + (bx >= 238 ? (bx - 238) * CONV_CI_A : 18 * CONV_CI_A + (bx - 220) * CONV_CI_B);
                for (int c_ = 0; c_ < nck; ++c_) CONV_CHUNK(cb + c_);
            }
            XSTAMP(25);
            XSTAMP(23);
        }
        if (!MERGE_POST) SEAM(pb + 0); else STAMP(pb + 1);
        if (!MERGE_POST && PHON(3) && IN(pb + 1)) {
            WS_PTRS
            { pg8::OffsetOrder S; S.init(NR, 768, bx, 0);
              if ((SUBSEL & 1) && S.has()) { pg8::Gemm g{P + O_CQ, (const bf16*)(wl + W_UQ), NR, 768, 512, NIN}; pg8::EpiUq E{QC, SSQ, tab64}; pg8::gemm_phase<pg8::EpiUq, pg8::OffsetOrder, false>(L, g, S, E); } }
            { pg8::OffsetOrder S; S.init(NR, 1024, bx, 102);
              if ((SUBSEL & 2) && S.has()) { pg8::Gemm g{P + O_CKV, (const bf16*)(wl + W_UKV), NR, 1024, 256, NIN}; pg8::EpiUkv E{KVC, SSQ}; pg8::gemm_phase<pg8::EpiUkv, pg8::OffsetOrder, false>(L, g, S, E); } }
            int ln = threadIdx.x; asm volatile("" : "+v"(ln)); ln &= 63;
            const f32x4 gq = *(const f32x4*)(args.in[I_GQN] + l * 128 + 4 * (ln & 31)), gk = *(const f32x4*)(args.in[I_GKN] + l * 128 + 4 * (ln & 31));
            if (SUBSEL & 4) for (int r = gw; r < NR; r += NGW) post_row(P + (size_t)r * NIN, r, tab128, tab64, SSQB, gq, gk, ln);
        }
        SEAM(pb + 1);
        if (PHON(4) && IN(pb + 2)) {
            WS_PTRS
            const int nitems = last ? AI_LAT : AI_ALL, nch = last ? 0 : CONV_CHUNKS;
            for (;;) {
                __syncthreads();
                if (tid == 0) MISC[0] = atomicAdd(ctl + CW_ATTQ + 64 * l, 1u);
                __syncthreads();
                const int q = __builtin_amdgcn_readfirstlane((int)MISC[0]);
                if (q >= nitems + nch) break;
                int it = q, cv = -1;
                if (nch > 0) {
                    if (q < 256) { if (q & 1) cv = q >> 1; else it = q >> 1; }
                    else if (q < 384) it = 128 + (q - 256);
                    else { const int e = q - 384;
                        if (e < 216) { if (e & 1) cv = 128 + (e >> 1); else it = 256 + (e >> 1); }
                        else if (e < 236) it = 256 + 108 + (e - 216);
                        else it = 384 + (e - 236); }
                }
                if (cv >= 0) {
                    if (cv < NA_CONV) CONV_CHUNK(cv);
                    continue;
                }
                int kind; const at::AUnit AU = attn_item_unit(it, kind, args, args.in[I_SINK] + l * 6, l);
                if (kind == 2) { if (SUBSEL & 1) at::attn_unit<192, false>(AU, (char*)lds); }
                else if (kind == 1) { if (SUBSEL & 2) at::attn_unit<128, true>(AU, (char*)lds); }
                else if (kind == 3) { if (SUBSEL & 4) at::attn_unit<128, false, true>(AU, (char*)lds); }
                else { if (SUBSEL & 4) at::attn_unit<128, false>(AU, (char*)lds); }
            }
        }
        SEAM(pb + 2);
        if (PHON(5) && IN(pb + 3)) {
            WS_PTRS
            pg8::Gemm g{CAT, (const bf16*)(wl + W_OUT), NR, D, D, D}; pg8::SplitTailOrder S; S.base.init(NL, D, G, bx); S.npieces = last ? 0 : NP_OUT; S.piece_nt = (D / 64) / NP_OUT;
            pg8::EpiPlain E{OF, D, OFP, (size_t)NC * D, NL / 256, MERGE_THIN != 0};
            pg8::gemm_phase<pg8::EpiPlain, pg8::SplitTailOrder, true>(L, g, S, E);
#if MERGE_THIN
            { pg8::Unit u0{0, 0, 0, 0, 0}, u1{0, 0, 0, 0, 0}; const bool has0 = S.next(0, u0), has1 = S.next(1, u1);
              if (tid == 0) { if (has0) __hip_atomic_fetch_add(pan_word(ctl, l, 0, u0.pm), 1u, __ATOMIC_RELAXED, __HIP_MEMORY_SCOPE_AGENT); if (has1) __hip_atomic_fetch_add(pan_word(ctl, l, 0, u1.pm), 1u, __ATOMIC_RELAXED, __HIP_MEMORY_SCOPE_AGENT); }
              int ln = threadIdx.x; asm volatile("" : "+v"(ln)); ln &= 63;
              if (has0) { pan_wait(pan_word(ctl, l, 0, u0.pm), 8u, nullptr, 0u, ctl);
                  for (int k = 0; k < 4; k += 2) { const int r = 256 * u0.pm + 32 * u0.pn + 4 * wave + k, s = r >> 12;
                      resid_norm_row2(l == 0 ? args.in[I_X] + (size_t)r * D : nullptr, X + (size_t)r * D, nullptr, X + (size_t)r * D, OF + (size_t)r * D, comb_vec(args, l, s, 0), comb_vec(args, l, s, 1), comb_vec(args, l, s, 2), H + (size_t)r * D, ln); } }
              const int tid_ = TAIL_BY_PANEL ? u0.pm * 8 + u0.pn : bx;
              if (!last && tid_ >= 16 * NP_OUT) { pan_wait(pan_word(ctl, l, 0, 32), 8u * NP_OUT, pan_word(ctl, l, 0, 33), 8u * NP_OUT, ctl);
                  const int rc = (tid_ - 16 * NP_OUT) + (G - 16 * NP_OUT) * wave;
                  if (rc < NC) { const int r = NL + rc;
                      resid_norm_row(l == 0 ? args.in[I_CTX] + (size_t)rc * D : nullptr, X + (size_t)r * D, nullptr, X + (size_t)r * D, OFP + (size_t)rc * D, comb_vec(args, l, 2, 0), comb_vec(args, l, 2, 1), comb_vec(args, l, 2, 2), H + (size_t)r * D, ln, 1.f, NP_OUT, (size_t)NC * D); } }
              if (COUNTED_NEXT) { VM_WAIT(); __syncthreads(); }
              if (COUNTED_NEXT && tid == 0) { if (has0) __hip_atomic_fetch_add(pan_word(ctl, l, 2, u0.pm), 1u, __ATOMIC_RELAXED, __HIP_MEMORY_SCOPE_AGENT);
                  if (has1) { __hip_atomic_fetch_add(pan_word(ctl, l, 2, 32), 1u, __ATOMIC_RELAXED, __HIP_MEMORY_SCOPE_AGENT); __hip_atomic_fetch_add(pan_word(ctl, l, 2, 33), 1u, __ATOMIC_RELAXED, __HIP_MEMORY_SCOPE_AGENT); } } }
#endif
        }
        if (!(MERGE_THIN && COUNTED_NEXT)) SEAM(pb + 3); else STAMP(pb + 4);
        if (!MERGE_THIN && PHON(6) && IN(pb + 4)) {
            WS_PTRS
            int ln = threadIdx.x; asm volatile("" : "+v"(ln)); ln &= 63;
            for (int r = gw; r < Mrows; r += NGW) { const int s = row_s(r);
                const float* xin = l == 0 ? (r < NL ? args.in[I_X] + (size_t)r * D : args.in[I_CTX] + (size_t)(r - NL) * D) : nullptr;
                const bool cx = r >= NL;
                resid_norm_row(xin, X + (size_t)r * D, nullptr, X + (size_t)r * D, cx ? OFP + (size_t)(r - NL) * D : OF + (size_t)r * D, comb_vec(args, l, s, 0), comb_vec(args, l, s, 1), comb_vec(args, l, s, 2), H + (size_t)r * D, ln, 1.f, cx ? NP_OUT : 1, (size_t)NC * D); }
        }
        if (!MERGE_THIN) SEAM(pb + 4); else STAMP(pb + 5);
        if (PHON(7) && IN(pb + 5)) {
            WS_PTRS
            pg8::Gemm g{H, (const bf16*)(wl + W_13), Mrows, 2 * DFF, D, D}; pg8::CountedStatic S; S.init(Mrows, 2 * DFF, G, bx);
            S.ready = (MERGE_THIN && COUNTED_NEXT) ? pan_word(ctl, l, 2, 0) : nullptr; S.need_lat = 8u; S.need_ctx = 16u * NP_OUT; S.tmo = ctl;
            pg8::EpiSwiglu E{U, DFF};
            pg8::gemm_phase<pg8::EpiSwiglu, pg8::CountedStatic, true>(L, g, S, E);
            if (!last && bx >= 216) {
                const int cb = NA_CONV + 18 * (CONV_CI_A + CONV_CI_B) + (bx - 216) * CONV_CF;
                for (int c_ = 0; c_ < CONV_CF; ++c_) CONV_CHUNK(cb + c_);
            }
        }
        SEAM(pb + 5);
        if (PHON(8) && IN(pb + 6)) {
            WS_PTRS
            pg8::Gemm g{U, (const bf16*)(wl + W_2), NR, D, DFF, DFF}; pg8::SplitTailOrder S; S.base.init(NL, D, G, bx); S.npieces = last ? 0 : NP_F2; S.piece_nt = (DFF / 64) / NP_F2;
            pg8::EpiPlain E{OF, D, OFP, (size_t)NC * D, NL / 256, MERGE_THIN != 0};
            pg8::gemm_phase<pg8::EpiPlain, pg8::SplitTailOrder, true>(L, g, S, E);
#if MERGE_THIN
            { pg8::Unit u0{0, 0, 0, 0, 0}, u1{0, 0, 0, 0, 0}; const bool has0 = S.next(0, u0), has1 = S.next(1, u1);
              if (tid == 0) { if (has0) __hip_atomic_fetch_add(pan_word(ctl, l, 1, u0.pm), 1u, __ATOMIC_RELAXED, __HIP_MEMORY_SCOPE_AGENT); if (has1) __hip_atomic_fetch_add(pan_word(ctl, l, 1, u1.pm), 1u, __ATOMIC_RELAXED, __HIP_MEMORY_SCOPE_AGENT); }
              int ln = threadIdx.x; asm volatile("" : "+v"(ln)); ln &= 63;
              if (has0) { pan_wait(pan_word(ctl, l, 1, u0.pm), 8u, nullptr, 0u, ctl);
                  for (int k = 0; k < 4; k += 2) { const int r = 256 * u0.pm + 32 * u0.pn + 4 * wave + k, s = r >> 12;
                      resid_norm_row2(nullptr, X + (size_t)r * D, last ? args.out + (size_t)r * D : nullptr, X + (size_t)r * D, OF + (size_t)r * D, comb_vec(args, l, s, 3), last ? nullptr : comb_vec(args, l + 1, s, 4), last ? nullptr : comb_vec(args, l + 1, s, 5),
                                      last ? nullptr : H + (size_t)r * D, ln); } }
              const int tid_ = TAIL_BY_PANEL ? u0.pm * 8 + u0.pn : bx;
              if (!last && tid_ >= 16 * NP_F2) { pan_wait(pan_word(ctl, l, 1, 32), 8u * NP_F2, pan_word(ctl, l, 1, 33), 8u * NP_F2, ctl);
                  const int rc = (tid_ - 16 * NP_F2) + (G - 16 * NP_F2) * wave;
                  if (rc < NC) { const int r = NL + rc;
                      resid_norm_row(nullptr, X + (size_t)r * D, nullptr, X + (size_t)r * D, OFP + (size_t)rc * D, comb_vec(args, l, 2, 3), comb_vec(args, l + 1, 2, 4), comb_vec(args, l + 1, 2, 5), H + (size_t)r * D, ln, 1.f, NP_F2, (size_t)NC * D); } }
              if (COUNTED_NEXT) { VM_WAIT(); __syncthreads(); }
              if (COUNTED_NEXT && tid == 0) { if (has0) __hip_atomic_fetch_add(pan_word(ctl, l, 3, u0.pm), 1u, __ATOMIC_RELAXED, __HIP_MEMORY_SCOPE_AGENT);
                  if (has1) { __hip_atomic_fetch_add(pan_word(ctl, l, 3, 32), 1u, __ATOMIC_RELAXED, __HIP_MEMORY_SCOPE_AGENT); __hip_atomic_fetch_add(pan_word(ctl, l, 3, 33), 1u, __ATOMIC_RELAXED, __HIP_MEMORY_SCOPE_AGENT); } } }
#endif
        }
        if (!(MERGE_THIN && COUNTED_NEXT)) SEAM(pb + 6); else STAMP(pb + 7);
        if (!MERGE_THIN && PHON(9) && IN(pb + 7)) {
            WS_PTRS
            int ln = threadIdx.x; asm volatile("" : "+v"(ln)); ln &= 63;
            float osc = 1.f;
#if defined(PROBE_A)
            if (last) { __syncthreads(); osc = 1.f + 1e-6f * (float)(STP[PROBE_B + 1] - STP[PROBE_B]); }
#endif
            for (int r = gw; r < Mrows; r += NGW) { const int s = row_s(r);
                float* xo = last ? args.out + (size_t)r * D : nullptr;
                const bool cx = r >= NL;
                resid_norm_row(nullptr, X + (size_t)r * D, xo, X + (size_t)r * D, cx ? OFP + (size_t)(r - NL) * D : OF + (size_t)r * D, comb_vec(args, l, s, 3), last ? nullptr : comb_vec(args, l + 1, s, 4), last ? nullptr : comb_vec(args, l + 1, s, 5),
                               last ? nullptr : H + (size_t)r * D, ln, osc, cx ? NP_F2 : 1, (size_t)NC * D); }
        }
        if (!MERGE_THIN) SEAM(pb + 7); else STAMP(pb + 8);
    }
#if defined(PROBE_A)
#if defined(PROBE_BX)
    if (bx == PROBE_BX && tid == 0 && hi == N_PHASES) { volatile LAS unsigned long long* XS = (volatile LAS unsigned long long*)(L + LDSCTL_OFF + 2048); VM_WAIT(); args.out[0] += 0.0001f * (float)(XS[PROBE_C + 1] - XS[PROBE_C]); }
    if (false) {
#else
    if (bx == 0 && tid == 0 && hi == N_PHASES) {
#endif
      VM_WAIT(); STAMP(N_PHASES); args.out[0] += (PROBE_A == 95) ? 0.01f * (0.01f * (float)(STP[18] - STP[10]) - 900.f) : (PROBE_A == 94) ? 0.01f * (0.01f * (float)(STP[PROBE_C + 1] - STP[PROBE_C]) - (float)PROBE_D) : (PROBE_A == 99) ? 0.00001f * (float)(STP[N_PHASES] - STP[0]) : 0.0001f * (float)(STP[PROBE_A + 1] - STP[PROBE_A]); }
#endif
#undef IN
#undef SEAM
}

inline int setup() {
    static int grid = 0;
    if (grid == 0) {
        int dev = 0, cus = 0, per_cu = 0;
        if (hipGetDevice(&dev) != hipSuccess || hipDeviceGetAttribute(&cus, hipDeviceAttributeMultiprocessorCount, dev) != hipSuccess) { fprintf(stderr, "mk: device query failed\n"); grid = -1; return -1; }
        if (hipFuncSetAttribute((const void*)fwd, hipFuncAttributeMaxDynamicSharedMemorySize, LDS_BYTES) != hipSuccess) { fprintf(stderr, "mk: hipFuncSetAttribute failed\n"); grid = -1; return -1; }
        if (hipOccupancyMaxActiveBlocksPerMultiprocessor(&per_cu, (const void*)fwd, NWAVES * 64, LDS_BYTES) != hipSuccess || per_cu < 1) fprintf(stderr, "mk: occupancy query says %d\n", per_cu);
        (void)hipGetLastError();
        grid = cus;
    }
    return grid;
}
inline void prep(unsigned char* ws, hipStream_t stream) { (void)hipMemsetAsync(ws + WS_CTL, 0, CTL_ZERO_BYTES, stream); }
inline void run(void* const* d_in, float* d_out, unsigned char* ws, hipStream_t stream, int lo, int hi) {
    const int grid = setup(); if (grid <= 0) return;
    Args a{};
    for (int i = 0; i < 22; ++i) a.in[i] = (const float*)d_in[i];
    a.out = d_out; a.ws = ws; a.ph_lo = lo; a.ph_hi = hi;
    hipLaunchKernelGGL(fwd, dim3(grid), dim3(NWAVES * 64), LDS_BYTES, stream, a);
    const hipError_t le = hipPeekAtLastError();
    if (le != hipSuccess) fprintf(stderr, "mk: launch failed: %s\n", hipGetErrorName(le));
}
}

extern "C" void kernel_launch(void* const* d_in, const int* in_sizes, int n_in, void* d_out, int out_size, void* d_ws, size_t ws_size, hipStream_t stream) {
    unsigned char* ws = (unsigned char*)d_ws;
    if (n_in != 22 || out_size != mk::NL * mk::D || ws_size < mk::WS_END) { fprintf(stderr, "kernel_launch: n_in %d out %d ws %zu (need %zu)\n", n_in, out_size, ws_size, (size_t)mk::WS_END); return; }
    mk::prep(ws, stream);
    mk::run(d_in, (float*)d_out, ws, stream, 0, mk::N_PHASES);
}
```
